# Optimizing an MI355X kernel written in HIP

```python
import jax, jax.numpy as jnp
from jax import lax
import numpy as np

D_MODEL = 4096
BATCH = 16
SEQ = 256
DEPTH = 1
DEC_BATCH = 8
DEC_SEQ = 4096
PAST_LEN = 256

GRID_W = 64
BLOCK = 128
WINDOW = 128
MLA_HEADS = 16
MLA_NOPE = 128
MLA_ROPE = 64
MLA_QK = MLA_NOPE + MLA_ROPE
MLA_V = 128
Q_RANK = 1024
KV_RANK = 512
GQA_HEADS = 16
GQA_KV_HEADS = 4
GQA_GROUP = GQA_HEADS // GQA_KV_HEADS
GQA_HD = 128
MIX_WIDTH = MLA_HEADS * MLA_V + GQA_HEADS * GQA_HD
D_FF = 11008
CONV_W = 3
ROPE_BASE = 10000.0
EPS = 1e-6
NEG = -1e30
MLA_SCALE = MLA_QK ** -0.5
GQA_SCALE = GQA_HD ** -0.5
SPLIT_Q = Q_RANK
SPLIT_KV = SPLIT_Q + KV_RANK
SPLIT_PE = SPLIT_KV + MLA_ROPE
SPLIT_GQ = SPLIT_PE + GQA_HEADS * GQA_HD
SPLIT_GK = SPLIT_GQ + GQA_KV_HEADS * GQA_HD
IN_COLS = SPLIT_GK + GQA_KV_HEADS * GQA_HD

kernel_name = "hybrid_mla_swa_convffn_prefix_dit_step"


def rmsnorm(x, g):
    xf = x.astype(jnp.float32)
    r = lax.rsqrt(jnp.mean(xf * xf, axis=-1, keepdims=True) + EPS)
    return (xf * r).astype(x.dtype) * g


def modulation(cvec, w_ada, b_ada):
    m = jax.nn.silu(cvec) @ w_ada + b_ada
    return jnp.split(m[:, None, :], 6, axis=-1)


def modulate(h, shift, scale):
    return h * (1 + scale) + shift


def rope_1d(x, pos):
    half = x.shape[-1] // 2
    inv = ROPE_BASE ** (-jnp.arange(half, dtype=jnp.float32) / half)
    ang = pos.astype(jnp.float32)[:, None] * inv[None, :]
    cos = jnp.cos(ang)[:, None, :]
    sin = jnp.sin(ang)[:, None, :]
    xf = x.astype(jnp.float32)
    x1, x2 = xf[..., :half], xf[..., half:]
    return jnp.concatenate([x1 * cos - x2 * sin, x1 * sin + x2 * cos], axis=-1).astype(x.dtype)


def rope_2d(x, row, col):
    half = x.shape[-1] // 2
    return jnp.concatenate([rope_1d(x[..., :half], row), rope_1d(x[..., half:], col)], axis=-1)


def query_blocks(t):
    b, s = t.shape[:2]
    return jnp.moveaxis(t.reshape(b, s // BLOCK, BLOCK, *t.shape[2:]), 1, 0)


def merge_blocks(o):
    o = jnp.moveaxis(o, 0, 1)
    return o.reshape(o.shape[0], o.shape[1] * o.shape[2], *o.shape[3:])


def sink_softmax(s_list, sink):
    m = sink
    for s in s_list:
        m = jnp.maximum(m, jnp.max(s, axis=-1, keepdims=True))
    es = [jnp.exp(s - m) for s in s_list]
    den = jnp.exp(sink - m)
    for e in es:
        den = den + jnp.sum(e, axis=-1, keepdims=True)
    return [e / den for e in es]


def mixer_inputs(h, w_in, g_q_lat, w_q_up, g_kv_lat):
    b, s, _ = h.shape
    z = h @ w_in
    q_lat, kv_lat, k_pe, gq, gk, gv = jnp.split(z, [SPLIT_Q, SPLIT_KV, SPLIT_PE, SPLIT_GQ, SPLIT_GK], axis=-1)
    q_mla = (rmsnorm(q_lat, g_q_lat) @ w_q_up).reshape(b, s, MLA_HEADS, MLA_QK)
    c_kv = rmsnorm(kv_lat, g_kv_lat)
    gq = gq.reshape(b, s, GQA_HEADS, GQA_HD)
    gk = gk.reshape(b, s, GQA_KV_HEADS, GQA_HD)
    gv = gv.reshape(b, s, GQA_KV_HEADS, GQA_HD)
    return q_mla, c_kv, k_pe, gq, gk, gv


def mla_keys_values(c_kv, k_pe, w_kv_up, g_k):
    b, s, _ = c_kv.shape
    kv = (c_kv @ w_kv_up).reshape(b, s, MLA_HEADS, MLA_NOPE + MLA_V)
    k_nope, v = kv[..., :MLA_NOPE], kv[..., MLA_NOPE:]
    k = jnp.concatenate([k_nope, jnp.broadcast_to(k_pe[:, :, None, :], (b, s, MLA_HEADS, MLA_ROPE))], axis=-1)
    return rmsnorm(k, g_k), v


def mla_attend(q, k, v):
    def one(qb):
        s = jnp.einsum("bqhd,bkhd->bhqk", qb, k, preferred_element_type=jnp.float32) * MLA_SCALE
        p = jax.nn.softmax(s, axis=-1).astype(v.dtype)
        return jnp.einsum("bhqk,bkhd->bqhd", p, v)
    o = merge_blocks(lax.map(one, query_blocks(q)))
    return o.reshape(o.shape[0], o.shape[1], MLA_HEADS * MLA_V)


def gqa_ctx_attend(q, k, v, sink):
    b, s = q.shape[:2]
    q5 = q.reshape(b, s, GQA_KV_HEADS, GQA_GROUP, GQA_HD)
    sink5 = sink.astype(jnp.float32).reshape(1, GQA_KV_HEADS, GQA_GROUP, 1, 1)

    def one(qb):
        sc = jnp.einsum("bqngd,bknd->bngqk", qb, k, preferred_element_type=jnp.float32) * GQA_SCALE
        (p,) = sink_softmax([sc], sink5)
        return jnp.einsum("bngqk,bknd->bqngd", p.astype(v.dtype), v)
    o = merge_blocks(lax.map(one, query_blocks(q5)))
    return o.reshape(b, s, GQA_HEADS * GQA_HD)


def gqa_latent_attend(q, k, v, k_ctx, v_ctx, sink):
    b, s = q.shape[:2]
    nb = s // BLOCK
    qb = q.reshape(b, nb, BLOCK, GQA_KV_HEADS, GQA_GROUP, GQA_HD)

    def band(t):
        tp = jnp.pad(t, ((0, 0), (BLOCK, BLOCK), (0, 0), (0, 0))).reshape(b, nb + 2, BLOCK, GQA_KV_HEADS, GQA_HD)
        return jnp.concatenate([tp[:, :-2], tp[:, 1:-1], tp[:, 2:]], axis=2)
    kb, vb = band(k), band(v)
    blk = jnp.arange(nb)[:, None, None] * BLOCK
    qi = blk + jnp.arange(BLOCK)[None, :, None]
    kj = blk - BLOCK + jnp.arange(3 * BLOCK)[None, None, :]
    mask = (jnp.abs(qi - kj) <= WINDOW) & (kj >= 0) & (kj < s)
    s_band = jnp.einsum("bcqngd,bcknd->bcngqk", qb, kb, preferred_element_type=jnp.float32) * GQA_SCALE
    s_band = jnp.where(mask[None, :, None, None], s_band, NEG)
    s_ctx = jnp.einsum("bcqngd,bknd->bcngqk", qb, k_ctx, preferred_element_type=jnp.float32) * GQA_SCALE
    sink6 = sink.astype(jnp.float32).reshape(1, 1, GQA_KV_HEADS, GQA_GROUP, 1, 1)
    p_ctx, p_band = sink_softmax([s_ctx, s_band], sink6)
    o = (jnp.einsum("bcngqk,bknd->bcqngd", p_ctx.astype(v.dtype), v_ctx)
         + jnp.einsum("bcngqk,bcknd->bcqngd", p_band.astype(v.dtype), vb))
    return o.reshape(b, s, GQA_HEADS * GQA_HD)


def conv_ffn(h, w_up, conv_w, conv_b, w_down):
    s = h.shape[1]
    u = h @ w_up
    up = jnp.pad(u, ((0, 0), (1, 1), (0, 0)))
    u = conv_w[0] * up[:, :s] + conv_w[1] * up[:, 1:s + 1] + conv_w[2] * up[:, 2:] + conv_b
    gate, val = u[..., :D_FF], u[..., D_FF:]
    return (jax.nn.silu(gate) * val) @ w_down


def context_layer(x, c_ctx, lp):
    sa, ca, ga, sf, cf, gf = modulation(c_ctx[None, :], lp["w_ada"], lp["b_ada"])
    h = modulate(rmsnorm(x, lp["g_attn"]), sa, ca)
    q_mla, c_kv, k_pe, gq, gk, gv = mixer_inputs(h, lp["w_in"], lp["g_q_lat"], lp["w_q_up"], lp["g_kv_lat"])
    k_mla, v_mla = mla_keys_values(c_kv, k_pe, lp["w_kv_up"], lp["g_mla_k"])
    q_mla = rmsnorm(q_mla, lp["g_mla_q"])
    o_a = mla_attend(q_mla, k_mla, v_mla)
    gq = rmsnorm(gq, lp["g_gqa_q"])
    gk = rmsnorm(gk, lp["g_gqa_k"])
    o_b = gqa_ctx_attend(gq, gk, gv, lp["sink"])
    x = x + ga * (jnp.concatenate([o_a, o_b], axis=-1) @ lp["w_out"])
    h = modulate(rmsnorm(x, lp["g_ffn"]), sf, cf)
    x = x + gf * conv_ffn(h, lp["w_up"], lp["conv_w"], lp["conv_b"], lp["w_down"])
    return x, c_kv, k_pe, gk, gv


def latent_layer(x, c, ckv_ctx, kpe_ctx, gk_ctx, gv_ctx, row, col, lp):
    sa, ca, ga, sf, cf, gf = modulation(c, lp["w_ada"], lp["b_ada"])
    h = modulate(rmsnorm(x, lp["g_attn"]), sa, ca)
    q_mla, c_kv, k_pe, gq, gk, gv = mixer_inputs(h, lp["w_in"], lp["g_q_lat"], lp["w_q_up"], lp["g_kv_lat"])
    k_lat, v_lat = mla_keys_values(c_kv, k_pe, lp["w_kv_up"], lp["g_mla_k"])
    k_lat = jnp.concatenate([k_lat[..., :MLA_NOPE], rope_2d(k_lat[..., MLA_NOPE:], row, col)], axis=-1)
    k_ctx, v_ctx = mla_keys_values(ckv_ctx, kpe_ctx, lp["w_kv_up"], lp["g_mla_k"])
    q_mla = rmsnorm(q_mla, lp["g_mla_q"])
    q_mla = jnp.concatenate([q_mla[..., :MLA_NOPE], rope_2d(q_mla[..., MLA_NOPE:], row, col)], axis=-1)
    o_a = mla_attend(q_mla, jnp.concatenate([k_ctx, k_lat], axis=1), jnp.concatenate([v_ctx, v_lat], axis=1))
    gq = rope_2d(rmsnorm(gq, lp["g_gqa_q"]), row, col)
    gk = rope_2d(rmsnorm(gk, lp["g_gqa_k"]), row, col)
    o_b = gqa_latent_attend(gq, gk, gv, gk_ctx, gv_ctx, lp["sink"])
    x = x + ga * (jnp.concatenate([o_a, o_b], axis=-1) @ lp["w_out"])
    h = modulate(rmsnorm(x, lp["g_ffn"]), sf, cf)
    x = x + gf * conv_ffn(h, lp["w_up"], lp["conv_w"], lp["conv_b"], lp["w_down"])
    return x


def setup_inputs(seed: int = 0) -> dict:
    key = jax.random.key(seed)
    ks = jax.random.split(key, 32)
    f32 = jnp.float32

    def nrm(k, shape, scale=1.0):
        return jax.random.normal(k, shape, f32) * scale

    def gain(k, shape):
        return 1.0 + 0.05 * jax.random.normal(k, shape, f32)

    return {
        "x_prompt": nrm(ks[0], (BATCH, SEQ, D_MODEL)),
        "x_sample": nrm(ks[1], (DEC_BATCH, DEC_SEQ, D_MODEL)),
        "cache_mla_ckv": nrm(ks[2], (DEC_BATCH, DEPTH, PAST_LEN, KV_RANK)),
        "cache_mla_kpe": nrm(ks[3], (DEC_BATCH, DEPTH, PAST_LEN, MLA_ROPE)),
        "cache_gqa_k": nrm(ks[4], (DEC_BATCH, DEPTH, PAST_LEN, GQA_KV_HEADS, GQA_HD)),
        "cache_gqa_v": nrm(ks[5], (DEC_BATCH, DEPTH, PAST_LEN, GQA_KV_HEADS, GQA_HD)),
        "c": nrm(ks[6], (DEC_BATCH, D_MODEL)),
        "c_ctx": nrm(ks[7], (D_MODEL,)),
        "g_attn": gain(ks[8], (DEPTH, D_MODEL)),
        "g_ffn": gain(ks[9], (DEPTH, D_MODEL)),
        "w_ada": nrm(ks[10], (DEPTH, D_MODEL, 6 * D_MODEL), 0.5 * D_MODEL ** -0.5),
        "b_ada": nrm(ks[11], (DEPTH, 6 * D_MODEL), 0.02),
        "w_in": nrm(ks[12], (DEPTH, D_MODEL, IN_COLS), D_MODEL ** -0.5),
        "g_q_lat": gain(ks[13], (DEPTH, Q_RANK)),
        "w_q_up": nrm(ks[14], (DEPTH, Q_RANK, MLA_HEADS * MLA_QK), Q_RANK ** -0.5),
        "g_kv_lat": gain(ks[15], (DEPTH, KV_RANK)),
        "w_kv_up": nrm(ks[16], (DEPTH, KV_RANK, MLA_HEADS * (MLA_NOPE + MLA_V)), KV_RANK ** -0.5),
        "g_mla_q": gain(ks[17], (DEPTH, MLA_QK)),
        "g_mla_k": gain(ks[18], (DEPTH, MLA_QK)),
        "g_gqa_q": gain(ks[19], (DEPTH, GQA_HD)),
        "g_gqa_k": gain(ks[20], (DEPTH, GQA_HD)),
        "sink": nrm(ks[21], (DEPTH, GQA_HEADS), 0.5),
        "w_out": nrm(ks[22], (DEPTH, MIX_WIDTH, D_MODEL), MIX_WIDTH ** -0.5),
        "w_up": nrm(ks[23], (DEPTH, D_MODEL, 2 * D_FF), D_MODEL ** -0.5),
        "conv_w": nrm(ks[24], (DEPTH, CONV_W, 2 * D_FF), CONV_W ** -0.5),
        "conv_b": nrm(ks[25], (DEPTH, 2 * D_FF), 0.02),
        "w_down": nrm(ks[26], (DEPTH, D_FF, D_MODEL), D_FF ** -0.5),
    }


def reference(x_prompt, x_sample, cache_mla_ckv, cache_mla_kpe, cache_gqa_k, cache_gqa_v, c,
              c_ctx, g_attn, g_ffn, w_ada, b_ada, w_in, g_q_lat, w_q_up, g_kv_lat, w_kv_up,
              g_mla_q, g_mla_k, g_gqa_q, g_gqa_k, sink, w_out, w_up, conv_w, conv_b, w_down):
    n_tok = x_sample.shape[1]
    n_rows = n_tok // GRID_W
    row = jnp.repeat(jnp.arange(n_rows), GRID_W)
    col = jnp.tile(jnp.arange(GRID_W), n_rows)

    xp = x_prompt
    xs = x_sample
    ckv_l, kpe_l, gk_l, gv_l = [], [], [], []
    for l in range(DEPTH):
        lp = {
            "g_attn": g_attn[l], "g_ffn": g_ffn[l], "w_ada": w_ada[l], "b_ada": b_ada[l],
            "w_in": w_in[l], "g_q_lat": g_q_lat[l], "w_q_up": w_q_up[l], "g_kv_lat": g_kv_lat[l],
            "w_kv_up": w_kv_up[l], "g_mla_q": g_mla_q[l], "g_mla_k": g_mla_k[l],
            "g_gqa_q": g_gqa_q[l], "g_gqa_k": g_gqa_k[l], "sink": sink[l], "w_out": w_out[l],
            "w_up": w_up[l], "conv_w": conv_w[l], "conv_b": conv_b[l], "w_down": w_down[l],
        }
        xp, ckv, kpe, gk, gv = context_layer(xp, c_ctx, lp)
        ckv_l.append(ckv)
        kpe_l.append(kpe)
        gk_l.append(gk)
        gv_l.append(gv)
        xs = latent_layer(xs, c, cache_mla_ckv[:, l], cache_mla_kpe[:, l], cache_gqa_k[:, l],
                          cache_gqa_v[:, l], row, col, lp)
    new_mla_ckv = jnp.stack(ckv_l, axis=1)
    new_mla_kpe = jnp.stack(kpe_l, axis=1)
    new_gqa_k = jnp.stack(gk_l, axis=1)
    new_gqa_v = jnp.stack(gv_l, axis=1)
    return (xp, xs, new_mla_ckv, new_mla_kpe, new_gqa_k, new_gqa_v)
```

```cpp
#include <hip/hip_runtime.h>
#include <cstdio>
#include <cstdint>
__device__ __forceinline__ int cvt_pk_fp8_sat(float a, float b, int old, bool hi) { a = __builtin_amdgcn_fmed3f(a, -448.f, 448.f); b = __builtin_amdgcn_fmed3f(b, -448.f, 448.f); return hi ? __builtin_amdgcn_cvt_pk_fp8_f32(a, b, old, true) : __builtin_amdgcn_cvt_pk_fp8_f32(a, b, old, false); }
#ifndef PG8_WGM
#define PG8_WGM 8
#endif
namespace pg8 {
#define PG8_LAS __attribute__((address_space(3)))
typedef unsigned short bf16_t;
typedef short bf16x8 __attribute__((ext_vector_type(8)));
typedef float f32x4 __attribute__((ext_vector_type(4)));
typedef unsigned u32x4 __attribute__((ext_vector_type(4)));
constexpr int BM = 256, BK = 64, HALF = 128, HTB = HALF * BK * 2  , STAGE_BYTES = 8 * HTB, NXCD = 8, WGM = PG8_WGM;

__host__ __device__ __forceinline__ int lds_byte(int r, int c) { const int st = (r >> 4) * 2 + (c >> 5), rr = r & 15, cc = c & 31, ob = rr * 64 + cc * 2; return st * 1024 + (ob ^ (((ob >> 9) & 1) << 5)); }
__host__ __device__ __forceinline__ void stage_rc(int b, int& R, int& C) { const int st = b / 1024, sb = b % 1024, swz = sb ^ (((sb >> 9) & 1) << 5); R = (st >> 1) * 16 + swz / 64; C = (st & 1) * 32 + (swz % 64) / 2; }
__host__ __device__ __forceinline__ int perm32(int rho) { const int n = rho >> 4, i = rho & 15; return 8 * (i >> 2) + 4 * n + (i & 3); }

struct Unit { int pm, pn, slot; };
struct Gemm { const bf16_t* A; const bf16_t* Bt; int M, N, K; };

struct StaticOrder {
    int nM, nN, nwg, G, c, wgm;
    __host__ __device__ void init(int M, int N, int G_, int c_, int wgm_ = WGM) { nM = M / BM; nN = N / BM; nwg = nM * nN; G = G_; c = c_; wgm = wgm_; }
    __host__ __device__ bool next(int i, Unit& u) const {
        const long L = (long)i * G + c; if (L >= nwg) return false;
        int wgid = (int)L; { const int q = nwg / NXCD, r = nwg % NXCD, xcd = wgid % NXCD, off = wgid / NXCD; wgid = (xcd < r ? xcd * (q + 1) : r * (q + 1) + (xcd - r) * q) + off; }
        const int nig = wgm * nN, gid = wgid / nig, fm = gid * wgm, gsz = (nM - fm) < wgm ? (nM - fm) : wgm;
        u.pm = fm + ((wgid % nig) % gsz); u.pn = (wgid % nig) / gsz; return true;
    }
    __device__ __forceinline__ void a_ready(const Unit&) const {}
    __device__ __forceinline__ void done(const Unit&) const {}
};

__device__ __forceinline__ unsigned cvt_pk_bf16(float lo, float hi) { unsigned r; asm volatile("v_cvt_pk_bf16_f32 %0, %1, %2" : "=v"(r) : "v"(lo), "v"(hi)); return r; }
#ifndef PROBE_QPERMA
#define PROBE_QPERMA false
#endif
template <bool F8, bool I8_ = false> struct EpiBf16T {
    static constexpr bool PERM = true, AFTER_DRAIN = false, PERMA = I8_ && PROBE_QPERMA, FP8 = F8; static constexpr int NT8 = 0; static constexpr bool I8 = I8_;
    bf16_t* O; int ldc; float scale;
    __device__ __forceinline__ void operator()(const f32x4 (&acc)[2][2][4][2], const Unit& u, int wr, int wc, int fr, int fq) const {
        const int row0 = u.pm * BM + wr * 64, col0 = u.pn * BM + wc * 32 + 8 * fq;
#pragma unroll
        for (int ai = 0; ai < 2; ++ai)
#pragma unroll
            for (int m = 0; m < 4; ++m) { bf16_t* rowp = O + (size_t)(row0 + ai * HALF + (PERMA ? 4 * fr + m : m * 16 + fr)) * ldc + col0;
#pragma unroll
                for (int bj = 0; bj < 2; ++bj) { f32x4 v0, v1;
                    if constexpr (I8) { typedef int i32x4_ __attribute__((ext_vector_type(4))); v0 = __builtin_convertvector(__builtin_bit_cast(i32x4_, acc[ai][bj][m][0]), f32x4) * scale; v1 = __builtin_convertvector(__builtin_bit_cast(i32x4_, acc[ai][bj][m][1]), f32x4) * scale; }
                    else { v0 = acc[ai][bj][m][0] * scale; v1 = acc[ai][bj][m][1] * scale; }
                    u32x4 w; w.x = cvt_pk_bf16(v0[0], v0[1]); w.y = cvt_pk_bf16(v0[2], v0[3]); w.z = cvt_pk_bf16(v1[0], v1[1]); w.w = cvt_pk_bf16(v1[2], v1[3]);
                    *(u32x4*)(rowp + bj * HALF) = w; } }
    }
};
typedef EpiBf16T<false> EpiBf16;
template <bool VIMG, bool F8 = false, bool I8_ = false> struct EpiKVT {
    static constexpr bool PERM = true, AFTER_DRAIN = false, PERMA = VIMG, FP8 = F8; static constexpr int NT8 = 0; static constexpr bool I8 = I8_;
    bf16_t* Kb; bf16_t* Vb; unsigned char* Vt8; const float* rowscale; const float* colscale;
    __device__ __forceinline__ void operator()(const f32x4 (&accr)[2][2][4][2], const Unit& u, int wr, int wc, int fr, int fq) const {
        const int col0 = wc * 32 + 8 * fq;
        f32x4 acc[2][2][4][2];
        if constexpr (I8) { typedef int i32x4_ __attribute__((ext_vector_type(4))); f32x4 cs[2][2];
#pragma unroll
            for (int bj = 0; bj < 2; ++bj)
#pragma unroll
                for (int n = 0; n < 2; ++n) cs[bj][n] = *(const f32x4*)(colscale + u.pn * 256 + bj * 128 + col0 + 4 * n);
#pragma unroll
            for (int ai = 0; ai < 2; ++ai)
#pragma unroll
                for (int m = 0; m < 4; ++m) { const float rs = rowscale[(size_t)(u.pm * BM + ai * HALF + wr * 64 + (VIMG ? 4 * fr + m : 16 * m + fr))];
#pragma unroll
                    for (int bj = 0; bj < 2; ++bj)
#pragma unroll
                        for (int n = 0; n < 2; ++n) acc[ai][bj][m][n] = __builtin_convertvector(__builtin_bit_cast(i32x4_, accr[ai][bj][m][n]), f32x4) * (cs[bj][n] * rs); } }
        else {
#pragma unroll
            for (int ai = 0; ai < 2; ++ai)
#pragma unroll
                for (int bj = 0; bj < 2; ++bj)
#pragma unroll
                    for (int m = 0; m < 4; ++m)
#pragma unroll
                        for (int n = 0; n < 2; ++n) acc[ai][bj][m][n] = accr[ai][bj][m][n]; }
#pragma unroll
        for (int ai = 0; ai < 2; ++ai) {
#pragma unroll
            for (int m = 0; m < 4; ++m) { const size_t row = (size_t)(u.pm * BM + ai * HALF + wr * 64 + (VIMG ? 4 * fr + m : 16 * m + fr));
                { const f32x4 v0 = acc[ai][0][m][0] * (F8 ? 1.0f / 4096.0f : 1.0f), v1 = acc[ai][0][m][1] * (F8 ? 1.0f / 4096.0f : 1.0f); u32x4 w; w.x = cvt_pk_bf16(v0[0], v0[1]); w.y = cvt_pk_bf16(v0[2], v0[3]); w.z = cvt_pk_bf16(v1[0], v1[1]); w.w = cvt_pk_bf16(v1[2], v1[3]);
                  *(u32x4*)(Kb + row * 3072 + u.pn * 192 + col0) = w; }
                if constexpr (!VIMG) { const f32x4 v0 = acc[ai][1][m][0] * (F8 ? 1.0f / 4096.0f : 1.0f), v1 = acc[ai][1][m][1] * (F8 ? 1.0f / 4096.0f : 1.0f); u32x4 w; w.x = cvt_pk_bf16(v0[0], v0[1]); w.y = cvt_pk_bf16(v0[2], v0[3]); w.z = cvt_pk_bf16(v1[0], v1[1]); w.w = cvt_pk_bf16(v1[2], v1[3]);
                  *(u32x4*)(Vb + row * 2048 + u.pn * 128 + col0) = w; } }
            if constexpr (VIMG) { const int T = u.pm * 4 + ai * 2 + wr;
                unsigned char* img = Vt8 + ((size_t)T * 20 + u.pn) * 10240 + (fr & 1) * 32 + (fr >> 3) * 16 + ((fr >> 1) & 3) * 4;
#pragma unroll
                for (int n = 0; n < 2; ++n)
#pragma unroll
                    for (int j = 0; j < 4; ++j) { int t = 0; constexpr float vs = F8 ? 32.f / 4096.f : 32.f; t = cvt_pk_fp8_sat(acc[ai][1][0][n][j] * vs, acc[ai][1][1][n][j] * vs, t, false); t = cvt_pk_fp8_sat(acc[ai][1][2][n][j] * vs, acc[ai][1][3][n][j] * vs, t, true);
                        *(unsigned*)(img + (col0 + 4 * n + j) * 80) = (unsigned)t; } }
        }
    }
};
template <size_t O_K8, size_t O_VT8, size_t O_ROWSC, size_t O_COLSC, size_t O_KPESS, size_t O_KPER>
struct EpiKVFuse {
    static constexpr bool PERM = true, AFTER_DRAIN = false, PERMA = true, FP8 = false; static constexpr int NT8 = 0; static constexpr bool I8 = true;
    unsigned char* wsb; const float* gk; PG8_LAS float* part; float ks8;
    static constexpr bool PREFETCH = true;
    __device__ __forceinline__ void prefetch(const Unit& u, int wid, int lane) const {
        if (wid < 4) { const float* src = wid == 0 ? (const float*)(wsb + O_ROWSC) + u.pm * BM + lane * 4 : (wid == 1 ? (const float*)(wsb + O_COLSC) + u.pn * 256 + lane * 4 : (wid == 2 ? (const float*)(wsb + O_KPESS) + u.pm * BM + lane * 4 : gk + (lane & 31) * 4));
            __builtin_amdgcn_global_load_lds((const unsigned*)src, (PG8_LAS unsigned*)(part + 1024 + u.slot * 1024 + wid * 256), 16, 0, 0); }
    }
    __device__ __forceinline__ void operator()(const f32x4 (&accr)[2][2][4][2], const Unit& u, int wr, int wc, int fr, int fq) const {
        typedef int i32x4_ __attribute__((ext_vector_type(4))); typedef unsigned u32x2k __attribute__((ext_vector_type(2)));
        unsigned char* K8 = wsb + O_K8; unsigned char* Vt8 = wsb + O_VT8; const PG8_LAS float* P = part + 1024 + u.slot * 1024;
        const bf16_t* kper = (const bf16_t*)(wsb + O_KPER);
        const int col0 = wc * 32 + 8 * fq;
        f32x4 cs[2][2]; float rsv[2][4];
#pragma unroll
        for (int bj = 0; bj < 2; ++bj)
#pragma unroll
            for (int n = 0; n < 2; ++n) cs[bj][n] = *(const PG8_LAS f32x4*)(P + 256 + bj * 128 + col0 + 4 * n);
#pragma unroll
        for (int ai = 0; ai < 2; ++ai)
#pragma unroll
            for (int m = 0; m < 4; ++m) rsv[ai][m] = P[ai * HALF + wr * 64 + 4 * fr + m];
#pragma unroll
        for (int ai = 0; ai < 2; ++ai) { const int T = u.pm * 4 + ai * 2 + wr;
            unsigned char* img = Vt8 + ((size_t)T * 20 + u.pn) * 10240 + (fr & 1) * 32 + (fr >> 3) * 16 + ((fr >> 1) & 3) * 4;
#pragma unroll
            for (int n = 0; n < 2; ++n) { f32x4 vv[4];
#pragma unroll
                for (int m = 0; m < 4; ++m) vv[m] = __builtin_convertvector(__builtin_bit_cast(i32x4_, accr[ai][1][m][n]), f32x4) * (cs[1][n] * (rsv[ai][m] * 32.f));
#pragma unroll
                for (int j = 0; j < 4; ++j) { int t = 0; t = cvt_pk_fp8_sat(vv[0][j], vv[1][j], t, false); t = cvt_pk_fp8_sat(vv[2][j], vv[3][j], t, true);
                    *(unsigned*)(img + (col0 + 4 * n + j) * 80) = (unsigned)t; } } }
        f32x4 kf[2][4][2]; float ssq[2][4];
#pragma unroll
        for (int ai = 0; ai < 2; ++ai)
#pragma unroll
            for (int m = 0; m < 4; ++m) { float s_ = 0.f;
#pragma unroll
                for (int n = 0; n < 2; ++n) { const f32x4 k4 = __builtin_convertvector(__builtin_bit_cast(i32x4_, accr[ai][0][m][n]), f32x4) * (cs[0][n] * rsv[ai][m]); kf[ai][m][n] = k4;
                    s_ += (k4[0] * k4[0] + k4[1] * k4[1]) + (k4[2] * k4[2] + k4[3] * k4[3]); }
                s_ += __shfl_xor(s_, 16); s_ += __shfl_xor(s_, 32); ssq[ai][m] = s_; }
        if (fq == 0) {
#pragma unroll
            for (int ai = 0; ai < 2; ++ai)
#pragma unroll
                for (int m = 0; m < 4; ++m) part[((wr * 2 + ai) * 64 + 4 * fr + m) * 4 + wc] = ssq[ai][m]; }
        u32x2k kw[2][4];
#pragma unroll
        for (int ai = 0; ai < 2; ++ai)
#pragma unroll
            for (int m = 0; m < 4; ++m) kw[ai][m] = *(const u32x2k*)(kper + (size_t)(u.pm * BM + ai * HALF + wr * 64 + 4 * fr + m) * 64 + wc * 16 + fq * 4);
        asm volatile("s_waitcnt lgkmcnt(0)" ::: "memory"); __builtin_amdgcn_s_barrier(); asm volatile("" ::: "memory");
        const f32x4 g0 = *(const PG8_LAS f32x4*)(P + 768 + col0), g1 = *(const PG8_LAS f32x4*)(P + 768 + col0 + 4);
#pragma unroll
        for (int ai = 0; ai < 2; ++ai)
#pragma unroll
            for (int m = 0; m < 4; ++m) { const size_t row = (size_t)(u.pm * BM + ai * HALF + wr * 64 + 4 * fr + m);
                const f32x4 pp = *(const PG8_LAS f32x4*)(part + ((wr * 2 + ai) * 64 + 4 * fr + m) * 4);
                const float ss = ((pp[0] + pp[1]) + (pp[2] + pp[3])) + P[512 + ai * HALF + wr * 64 + 4 * fr + m]; const float r = ks8 / sqrtf(ss * (1.0f / 192.0f) + 1e-6f);
                unsigned char* kd = K8 + (row * 16 + u.pn) * 192;
                const f32x4 v0 = kf[ai][m][0] * (g0 * r), v1 = kf[ai][m][1] * (g1 * r); int t0 = 0, t1 = 0;
                t0 = cvt_pk_fp8_sat(v0[0], v0[1], t0, false); t0 = cvt_pk_fp8_sat(v0[2], v0[3], t0, true); t1 = cvt_pk_fp8_sat(v1[0], v1[1], t1, false); t1 = cvt_pk_fp8_sat(v1[2], v1[3], t1, true);
                *(u32x2k*)(kd + col0) = (u32x2k){(unsigned)t0, (unsigned)t1};
                const u32x2k w = kw[ai][m]; int t2 = 0;
                t2 = cvt_pk_fp8_sat(__uint_as_float(w.x << 16) * r, __uint_as_float(w.x & 0xffff0000u) * r, t2, false); t2 = cvt_pk_fp8_sat(__uint_as_float(w.y << 16) * r, __uint_as_float(w.y & 0xffff0000u) * r, t2, true);
                *(unsigned*)(kd + 128 + wc * 16 + fq * 4) = (unsigned)t2; }
    }
};
template <bool F8, bool BB, bool OB, int NT8_ = 0> struct EpiResT {
    static constexpr bool PERM = true, AFTER_DRAIN = false, PERMA = false, FP8 = F8; static constexpr int NT8 = NT8_; static constexpr bool I8 = false;
    __device__ __forceinline__ float mix_rescale() const { return mixrs; }
    const void* base_p; const void* base_s; void* out; const float* gate; float gscale; float mixrs;
    __device__ __forceinline__ void operator()(const f32x4 (&acc)[2][2][4][2], const Unit& u, int wr, int wc, int fr, int fq) const {
        const int mr = u.pm < 16 ? 8 : ((u.pm - 16) >> 4);
        const int col0 = u.pn * BM + wc * 32 + 8 * fq;
        const float* gp = gate + (size_t)mr * 24576 + col0;
        f32x4 gv[2][2];
#pragma unroll
        for (int bj = 0; bj < 2; ++bj)
#pragma unroll
            for (int n = 0; n < 2; ++n) gv[bj][n] = *(const f32x4*)(gp + bj * HALF + n * 4) * gscale;
        const int rt = u.pm * BM + wr * 64 + fr;
        const size_t rb = (u.pm < 16) ? (size_t)rt : (size_t)(rt - 4096);
        const char* bb = (const char*)((u.pm < 16) ? base_p : base_s) + rb * 4096 * (BB ? 2 : 4);
        char* ob = (char*)out + (size_t)rt * 4096 * (OB ? 2 : 4);
        constexpr int MB = BB ? 4 : 2;
#pragma unroll
        for (int ai = 0; ai < 2; ++ai)
#pragma unroll
            for (int mp = 0; mp < 4 / MB; ++mp) {
            u32x4 bw[MB][2]; f32x4 bs[MB][2][2];
#pragma unroll
            for (int mm = 0; mm < MB; ++mm) { const int m = mp * MB + mm; const size_t off = (size_t)(ai * HALF + m * 16) * 4096 + col0;
#pragma unroll
                for (int bj = 0; bj < 2; ++bj) {
                    if constexpr (BB) bw[mm][bj] = *(const u32x4*)(bb + (off + bj * HALF) * 2);
                    else { bs[mm][bj][0] = *(const f32x4*)(bb + (off + bj * HALF) * 4); bs[mm][bj][1] = *(const f32x4*)(bb + (off + bj * HALF) * 4 + 16); } } }
#pragma unroll
            for (int mm = 0; mm < MB; ++mm) { const int m = mp * MB + mm; const size_t off = (size_t)(ai * HALF + m * 16) * 4096 + col0;
#pragma unroll
                for (int bj = 0; bj < 2; ++bj) { f32x4 b0, b1;
                    if constexpr (BB) { const u32x4 w = bw[mm][bj];
                        b0 = (f32x4){__uint_as_float(w.x << 16), __uint_as_float(w.x & 0xffff0000u), __uint_as_float(w.y << 16), __uint_as_float(w.y & 0xffff0000u)};
                        b1 = (f32x4){__uint_as_float(w.z << 16), __uint_as_float(w.z & 0xffff0000u), __uint_as_float(w.w << 16), __uint_as_float(w.w & 0xffff0000u)}; }
                    else { b0 = bs[mm][bj][0]; b1 = bs[mm][bj][1]; }
                    const f32x4 o0 = b0 + gv[bj][0] * acc[ai][bj][m][0], o1 = b1 + gv[bj][1] * acc[ai][bj][m][1];
                    if constexpr (OB) { u32x4 w; w.x = cvt_pk_bf16(o0[0], o0[1]); w.y = cvt_pk_bf16(o0[2], o0[3]); w.z = cvt_pk_bf16(o1[0], o1[1]); w.w = cvt_pk_bf16(o1[2], o1[3]); *(u32x4*)(ob + (off + bj * HALF) * 2) = w; }
                    else { *(f32x4*)(ob + (off + bj * HALF) * 4) = o0; *(f32x4*)(ob + (off + bj * HALF) * 4 + 16) = o1; } } }
            asm volatile("" ::: "memory"); }
    }
};
__device__ __forceinline__ float dpp_from_prev_lane(float v) { return __builtin_bit_cast(float, __builtin_amdgcn_update_dpp(0, __builtin_bit_cast(int, v), 0x111, 0xf, 0xf, true)); }
__device__ __forceinline__ float dpp_from_next_lane(float v) { return __builtin_bit_cast(float, __builtin_amdgcn_update_dpp(0, __builtin_bit_cast(int, v), 0x101, 0xf, 0xf, true)); }
#ifndef PROBE_UPF8
#define PROBE_UPF8 false
#endif
template <bool I8_, bool FOLD = false> struct EpiUpT {
    static constexpr bool PERM = true, AFTER_DRAIN = false, PERMA = true, FP8 = PROBE_UPF8; static constexpr int NT8 = 0; static constexpr bool I8 = I8_;
    static constexpr bool PREFETCH = true;
    PG8_LAS float* prm;
    __device__ __forceinline__ void prefetch(const Unit& u, int wid, int lane) const {
        if (wid < (I8 ? 6 : 4)) { const int ci = (lane < 32) ? u.pn * 128 + lane * 4 : 11008 + u.pn * 128 + (lane - 32) * 4;
            const float* src = wid < 3 ? cw + wid * 22016 + ci : (wid == 3 ? cb + ci : (wid == 4 ? colscale + u.pn * 256 + lane * 4 : rowscale + u.pm * BM + lane * 4));
            __builtin_amdgcn_global_load_lds((const unsigned*)src, (PG8_LAS unsigned*)(prm + u.slot * 1536 + wid * 256), 16, 0, 0); }
    }
    unsigned char* G; const float* cw; const float* cb; float* edge; int k8; int gpb; float sg; const float* rowscale; const float* colscale;
    __device__ __forceinline__ void operator()(const f32x4 (&acc)[2][2][4][2], const Unit& u, int wr, int wc, int fr, int fq) const {
        const int colg = u.pn * 128 + wc * 32 + 8 * fq;
        const bool g8 = u.pn * 128 < k8;
        unsigned gw[2][4][4]; int gw8[2][4][2];
        f32x4 rs4[2] = {(f32x4){1.f, 1.f, 1.f, 1.f}, (f32x4){1.f, 1.f, 1.f, 1.f}};
        const PG8_LAS float* P = prm + u.slot * 1536;
        if constexpr (I8) { rs4[0] = *(const PG8_LAS f32x4*)(P + 1280 + wr * 64 + 4 * fr); rs4[1] = *(const PG8_LAS f32x4*)(P + 1280 + HALF + wr * 64 + 4 * fr); }
#pragma unroll
        for (int n = 0; n < 2; ++n) {
            f32x4 W0[2], W1[2], W2[2], Bv[2], cs4[2];
#pragma unroll
            for (int bj = 0; bj < 2; ++bj) { const int uc = bj * 11008 + colg + 4 * n;
                const int pe = bj * 128 + wc * 32 + 8 * fq + 4 * n;
                W0[bj] = *(const PG8_LAS f32x4*)(P + pe); W1[bj] = *(const PG8_LAS f32x4*)(P + 256 + pe); W2[bj] = *(const PG8_LAS f32x4*)(P + 512 + pe); Bv[bj] = *(const PG8_LAS f32x4*)(P + 768 + pe);
                cs4[bj] = (f32x4){1.f, 1.f, 1.f, 1.f};
                if constexpr (I8) { cs4[bj] = *(const PG8_LAS f32x4*)(P + 1024 + pe); W0[bj] *= cs4[bj]; W1[bj] *= cs4[bj]; W2[bj] *= cs4[bj]; } }
#pragma unroll
            for (int ai = 0; ai < 2; ++ai) {
                const int rho = u.pm * 4 + ai * 2 + wr;
                float* e0 = edge + ((size_t)rho * 4 + 0) * 22016;
                f32x4 Pf[2], Pl[2], Uf[2], Ul[2];
                f32x4 uv[2][4];
#pragma unroll
                for (int bj = 0; bj < 2; ++bj)
#pragma unroll
                    for (int m = 0; m < 4; ++m) {
                        if constexpr (I8) { typedef int i32x4_ __attribute__((ext_vector_type(4))); uv[bj][m] = __builtin_convertvector(__builtin_bit_cast(i32x4_, acc[ai][bj][m][n]), f32x4) * rs4[ai][m]; }
                        else uv[bj][m] = acc[ai][bj][m][n] * (FP8 ? (1.0f / 4096.0f) : 1.0f); }
                f32x4 Cc[2][4];
#pragma unroll
                for (int bj = 0; bj < 2; ++bj) {
                    const f32x4 U0 = uv[bj][0], U1 = uv[bj][1], U2 = uv[bj][2], U3 = uv[bj][3];
                    f32x4 pv, nx;
#pragma unroll
                    for (int j = 0; j < 4; ++j) { pv[j] = dpp_from_prev_lane(U3[j]); nx[j] = dpp_from_next_lane(U0[j]); }
                    Uf[bj] = U0; Ul[bj] = U3;
                    Cc[bj][0] = W1[bj] * U0 + (W0[bj] * pv + (W2[bj] * U1 + Bv[bj]));
                    Cc[bj][1] = W1[bj] * U1 + (W0[bj] * U0 + (W2[bj] * U2 + Bv[bj]));
                    Cc[bj][2] = W1[bj] * U2 + (W0[bj] * U1 + (W2[bj] * U3 + Bv[bj]));
                    Cc[bj][3] = W1[bj] * U3 + (W0[bj] * U2 + (W2[bj] * nx + Bv[bj]));
                    Pf[bj] = Cc[bj][0]; Pl[bj] = Cc[bj][3];
                }
#pragma unroll
                for (int m = 0; m < 4; ++m) { const f32x4 av = Cc[0][m], bv = Cc[1][m]; const f32x4 ea = FOLD ? av : av * (-1.4426950408889634f); f32x4 sv;
#pragma unroll
                    for (int j = 0; j < 4; ++j) sv[j] = __builtin_amdgcn_rcpf(1.0f + __builtin_amdgcn_exp2f(ea[j]));
                    const f32x4 gv4 = (av * sv) * bv;
                    if (g8) { const f32x4 gs = FOLD ? gv4 : gv4 * sg; int t = 0; t = cvt_pk_fp8_sat(gs[0], gs[1], t, false); t = cvt_pk_fp8_sat(gs[2], gs[3], t, true); gw8[ai][m][n] = t; }
                    else { gw[ai][m][n * 2] = cvt_pk_bf16(gv4[0], gv4[1]); gw[ai][m][n * 2 + 1] = cvt_pk_bf16(gv4[2], gv4[3]); } }
                if (fr == 0) {
#pragma unroll
                    for (int bj = 0; bj < 2; ++bj) { const int uc = bj * 11008 + colg + 4 * n; *(f32x4*)(e0 + uc) = Pf[bj]; *(f32x4*)(e0 + 22016 + uc) = Uf[bj] * cs4[bj]; } }
                if (fr == 15) {
#pragma unroll
                    for (int bj = 0; bj < 2; ++bj) { const int uc = bj * 11008 + colg + 4 * n; *(f32x4*)(e0 + 2 * 22016 + uc) = Pl[bj]; *(f32x4*)(e0 + 3 * 22016 + uc) = Ul[bj] * cs4[bj]; } }
            }
        }
#pragma unroll
        for (int ai = 0; ai < 2; ++ai) {
            const int row0 = u.pm * BM + ai * HALF + wr * 64 + 4 * fr;
#pragma unroll
            for (int m = 0; m < 4; ++m) { unsigned char* grow = G + (size_t)(row0 + m) * gpb;
                if (g8) { typedef unsigned u32x2 __attribute__((ext_vector_type(2))); *(u32x2*)(grow + colg) = (u32x2){(unsigned)gw8[ai][m][0], (unsigned)gw8[ai][m][1]}; }
                else { u32x4 w; w.x = gw[ai][m][0]; w.y = gw[ai][m][1]; w.z = gw[ai][m][2]; w.w = gw[ai][m][3]; *(u32x4*)(grow + k8 + (size_t)(colg - k8) * 2) = w; } }
        }
    }
};

typedef int pg8_v8i __attribute__((ext_vector_type(8)));
__device__ __forceinline__ pg8_v8i pg8_cat(bf16x8 a, bf16x8 b) { typedef short s16 __attribute__((ext_vector_type(16))); const s16 c = __builtin_shufflevector(a, b, 0, 1, 2, 3, 4, 5, 6, 7, 8, 9, 10, 11, 12, 13, 14, 15); return __builtin_bit_cast(pg8_v8i, c); }
__device__ __forceinline__ bf16x8 pg8_lo(pg8_v8i v) { typedef int v4i_ __attribute__((ext_vector_type(4))); return __builtin_bit_cast(bf16x8, (v4i_)__builtin_shufflevector(v, v, 0, 1, 2, 3)); }
__device__ __forceinline__ bf16x8 pg8_hi(pg8_v8i v) { typedef int v4i_ __attribute__((ext_vector_type(4))); return __builtin_bit_cast(bf16x8, (v4i_)__builtin_shufflevector(v, v, 4, 5, 6, 7)); }
template <class T, class = void> struct pg8_has_prefetch { static constexpr bool value = false; };
template <class T> struct pg8_has_prefetch<T, decltype((void)T::PREFETCH)> { static constexpr bool value = true; };
template <class Epi> __device__ __forceinline__ void pg8_prefetch(const Epi& E, const Unit& u, int wid, int lane) { if constexpr (pg8_has_prefetch<Epi>::value) E.prefetch(u, wid, lane); }
template <class Epi, class Sched, bool ALIGN_EPI = false, bool SP2 = false>
__device__ __forceinline__ void gemm_phase(PG8_LAS unsigned char* lds, const Gemm g, const Sched& S, const Epi& E) {
    const int tid = threadIdx.x, wid = __builtin_amdgcn_readfirstlane(tid >> 6), lane = tid & 63, wr = wid >> 2, wc = wid & 3, fr = lane & 15, fq = lane >> 4;
    const int K = g.K, nt = K / BK;
    unsigned voffA[2], voffB[2];
#pragma unroll
    for (int i = 0; i < 2; ++i) { int R, C; stage_rc(tid * 16 + i * 8192, R, C); const int Rb = Epi::PERM ? ((R & ~31) + perm32(R & 31)) : R;
        const int Ra = Epi::PERMA ? ((R & ~63) | ((R & 15) << 2) | ((R >> 4) & 3)) : R;
        voffA[i] = (unsigned)(Ra * K + C) * 2u; voffB[i] = (unsigned)(Rb * K + C) * 2u; }
    const size_t kstep = (size_t)(BK * 2);
    const size_t hstep = (size_t)HALF * K * 2;
    const size_t tstep = 2 * hstep;
    const unsigned ldsw = (unsigned)wid * 1024u;
    const int aoff = lds_byte(wr * 64 + fr, fq * 8), boff = lds_byte(wc * 32 + fr, fq * 8);
#define PG8_SA(b, h) (((b) * 2 + (h)) * HTB)
#define PG8_SB(b, h) ((4 + (b) * 2 + (h)) * HTB)
#define PG8_STAGE(bufoff, gbase, voff) do { _Pragma("unroll") for (int _i = 0; _i < 2; ++_i) \
        __builtin_amdgcn_global_load_lds((const unsigned*)((const char*)(gbase) + (voff)[_i]), (PG8_LAS unsigned*)(lds + (bufoff) + ldsw + _i * 8192), 16, 0, 0); } while (0)
#define PG8_LDA(dst, b, h) do { if constexpr (Epi::FP8 || Epi::NT8 > 0) { _Pragma("unroll") for (int m = 0; m < 4; ++m) dst##8[m] = pg8_cat(*(const PG8_LAS bf16x8*)(lds + PG8_SA(b, h) + aoff + m * 2048), *(const PG8_LAS bf16x8*)(lds + PG8_SA(b, h) + aoff + m * 2048 + 1024)); } \
        else { _Pragma("unroll") for (int m = 0; m < 4; ++m) _Pragma("unroll") for (int k = 0; k < 2; ++k) dst[m][k] = *(const PG8_LAS bf16x8*)(lds + PG8_SA(b, h) + aoff + m * 2048 + k * 1024); } } while (0)
#define PG8_LDB(dst, b, h) do { if constexpr (Epi::FP8 || Epi::NT8 > 0) { _Pragma("unroll") for (int n = 0; n < 2; ++n) dst##8[n] = pg8_cat(*(const PG8_LAS bf16x8*)(lds + PG8_SB(b, h) + boff + n * 2048), *(const PG8_LAS bf16x8*)(lds + PG8_SB(b, h) + boff + n * 2048 + 1024)); } \
        else { _Pragma("unroll") for (int n = 0; n < 2; ++n) _Pragma("unroll") for (int k = 0; k < 2; ++k) dst[n][k] = *(const PG8_LAS bf16x8*)(lds + PG8_SB(b, h) + boff + n * 2048 + k * 1024); } } while (0)
#define PG8_MMA8(ai, bj, At, Bt) do { _Pragma("unroll") for (int m = 0; m < 4; ++m) _Pragma("unroll") for (int n = 0; n < 2; ++n) \
        asm volatile("v_mfma_f32_16x16x128_f8f6f4 %0, %1, %2, %0" : "+v"(acc[ai][bj][m][n]) : "v"(Bt##8[n]), "v"(At##8[m])); } while (0)
#ifndef PG8_PRIO
#define PG8_PRIO 1
#endif
#ifndef PG8_PRIO_MMA
#define PG8_PRIO_MMA 1
#endif
#ifndef PG8_PRIO_AFTER
#define PG8_PRIO_AFTER 3
#endif
#define PG8_MMA(ai, bj, At, Bt) do { if (PG8_PRIO) __builtin_amdgcn_s_setprio(PG8_PRIO_MMA); if constexpr (Epi::FP8) { PG8_MMA8(ai, bj, At, Bt); } \
        else if constexpr (Epi::NT8 > 0) { if constexpr (f8now) { PG8_MMA8(ai, bj, At, Bt); } else { _Pragma("unroll") for (int m = 0; m < 4; ++m) _Pragma("unroll") for (int n = 0; n < 2; ++n) { \
            asm volatile("v_mfma_f32_16x16x32_bf16 %0, %1, %2, %0" : "+v"(acc[ai][bj][m][n]) : "v"(pg8_lo(Bt##8[n])), "v"(pg8_lo(At##8[m]))); \
            asm volatile("v_mfma_f32_16x16x32_bf16 %0, %1, %2, %0" : "+v"(acc[ai][bj][m][n]) : "v"(pg8_hi(Bt##8[n])), "v"(pg8_hi(At##8[m]))); } } } \
        else if constexpr (Epi::I8) { _Pragma("unroll") for (int m = 0; m < 4; ++m) _Pragma("unroll") for (int n = 0; n < 2; ++n) _Pragma("unroll") for (int k = 0; k < 2; ++k) \
        asm volatile("v_mfma_i32_16x16x64_i8 %0, %1, %2, %0" : "+v"(acc[ai][bj][m][n]) : "v"(Bt[n][k]), "v"(At[m][k])); } \
        else { _Pragma("unroll") for (int m = 0; m < 4; ++m) _Pragma("unroll") for (int n = 0; n < 2; ++n) _Pragma("unroll") for (int k = 0; k < 2; ++k) \
        acc[ai][bj][m][n] = __builtin_amdgcn_mfma_f32_16x16x32_bf16(Bt[n][k], At[m][k], acc[ai][bj][m][n], 0, 0, 0); } if (PG8_PRIO) __builtin_amdgcn_s_setprio(PG8_PRIO_AFTER); } while (0)
#define PG8_WAIT_V(n) asm volatile("s_waitcnt vmcnt(" #n ")" ::: "memory")
#define PG8_WAIT_L(n) asm volatile("s_waitcnt lgkmcnt(" #n ")" ::: "memory")
#define PG8_BAR __builtin_amdgcn_s_barrier()
#define PG8_SCHED __builtin_amdgcn_sched_barrier(0)
    Unit cur, nxt; int ui = 0;
    if (!S.next(0, cur)) return;
    cur.slot = 0; pg8_prefetch(E, cur, wid, lane);
    f32x4 acc[2][2][4][2];
#pragma unroll
    for (int a = 0; a < 2; ++a)
#pragma unroll
        for (int b = 0; b < 2; ++b)
#pragma unroll
            for (int m = 0; m < 4; ++m)
#pragma unroll
                for (int n = 0; n < 2; ++n) acc[a][b][m][n] = (f32x4){0.f, 0.f, 0.f, 0.f};
    bf16x8 At[4][2], B0[2][2], B1[2][2]; pg8_v8i At8[4], B08[2], B18[2];
    const char* cA = (const char*)g.A + (size_t)cur.pm * tstep; const char* cB = (const char*)g.Bt + (size_t)cur.pn * tstep;
    S.a_ready(cur);
    if constexpr (SP2) {
        PG8_STAGE(PG8_SB(0, 0), cB, voffB); PG8_STAGE(PG8_SB(0, 1), cB + hstep, voffB); PG8_STAGE(PG8_SA(0, 0), cA, voffA); PG8_STAGE(PG8_SA(0, 1), cA + hstep, voffA);
        if (wr == 1) PG8_BAR;
        PG8_WAIT_V(2); PG8_BAR;
        PG8_STAGE(PG8_SB(1, 0), cB + kstep, voffB); PG8_STAGE(PG8_SA(1, 0), cA + kstep, voffA); PG8_STAGE(PG8_SB(1, 1), cB + hstep + kstep, voffB);
        PG8_WAIT_V(6); PG8_BAR;
    } else {
        PG8_STAGE(PG8_SB(0, 0), cB, voffB); PG8_STAGE(PG8_SA(0, 0), cA, voffA); PG8_STAGE(PG8_SB(0, 1), cB + hstep, voffB); PG8_STAGE(PG8_SA(0, 1), cA + hstep, voffA);
        if (wr == 1) PG8_BAR;
        PG8_WAIT_V(4); PG8_BAR;
        PG8_STAGE(PG8_SB(1, 0), cB + kstep, voffB); PG8_STAGE(PG8_SA(1, 0), cA + kstep, voffA); PG8_STAGE(PG8_SB(1, 1), cB + hstep + kstep, voffB);
        PG8_WAIT_V(6); PG8_BAR;
    }
    for (;;) {
        const bool has_next = S.next(ui + 1, nxt);
        const char* nA = has_next ? (const char*)g.A + (size_t)nxt.pm * tstep : cA; const char* nB = has_next ? (const char*)g.Bt + (size_t)nxt.pn * tstep : cB;
        for (int t = 0; t < (Epi::NT8 > 0 ? Epi::NT8 : 0); t += 2) {
            const bool last = (t == nt - 2);
            constexpr bool f8now = true; (void)f8now;
            const char* a1 = cA + (size_t)(t + 1) * kstep;
            const char* a2 = last ? nA : cA + (size_t)(t + 2) * kstep; const char* b2 = last ? nB : cB + (size_t)(t + 2) * kstep;
            const char* a3 = a2 + kstep; const char* b3 = b2 + kstep;
            if (last && has_next) S.a_ready(nxt);
            if constexpr (SP2) {
            PG8_LDB(B0, 0, 0); PG8_LDB(B1, 0, 1); PG8_SCHED; PG8_LDA(At, 0, 0); PG8_STAGE(PG8_SA(1, 1), a1 + hstep, voffA);
            PG8_WAIT_V(8); PG8_WAIT_L(0); PG8_BAR; PG8_MMA(0, 0, At, B0); PG8_MMA(0, 1, At, B1); PG8_BAR; PG8_SCHED;
            PG8_LDA(At, 0, 1); PG8_STAGE(PG8_SB(0, 0), b2, voffB); PG8_STAGE(PG8_SB(0, 1), b2 + hstep, voffB); PG8_STAGE(PG8_SA(0, 0), a2, voffA);
            PG8_WAIT_V(8); PG8_WAIT_L(0); PG8_BAR; PG8_MMA(1, 0, At, B0); PG8_MMA(1, 1, At, B1); PG8_BAR; PG8_SCHED;
            PG8_LDB(B0, 1, 0); PG8_LDB(B1, 1, 1); PG8_SCHED; PG8_LDA(At, 1, 0); PG8_STAGE(PG8_SA(0, 1), a2 + hstep, voffA);
            PG8_WAIT_V(8); PG8_WAIT_L(0); PG8_BAR; PG8_MMA(0, 0, At, B0); PG8_MMA(0, 1, At, B1); PG8_BAR; PG8_SCHED;
            PG8_LDA(At, 1, 1); PG8_STAGE(PG8_SB(1, 0), b3, voffB); PG8_STAGE(PG8_SB(1, 1), b3 + hstep, voffB); PG8_STAGE(PG8_SA(1, 0), a3, voffA);
            PG8_WAIT_V(8); PG8_WAIT_L(0); PG8_BAR; PG8_MMA(1, 0, At, B0); PG8_MMA(1, 1, At, B1); PG8_BAR; PG8_SCHED;
            } else {
            PG8_LDB(B0, 0, 0); PG8_SCHED; PG8_LDA(At, 0, 0); PG8_STAGE(PG8_SA(1, 1), a1 + hstep, voffA);
            PG8_WAIT_L(8); PG8_BAR; PG8_WAIT_L(0); PG8_MMA(0, 0, At, B0); PG8_BAR; PG8_SCHED;
            PG8_LDB(B1, 0, 1); PG8_STAGE(PG8_SB(0, 0), b2, voffB);
            PG8_BAR; PG8_WAIT_L(0); PG8_MMA(0, 1, At, B1); PG8_BAR;
            PG8_LDA(At, 0, 1); PG8_STAGE(PG8_SA(0, 0), a2, voffA);
            PG8_BAR; PG8_WAIT_L(0); PG8_MMA(1, 0, At, B0); PG8_BAR; PG8_SCHED;
            PG8_STAGE(PG8_SB(0, 1), b2 + hstep, voffB);
            PG8_WAIT_V(6); PG8_BAR; PG8_MMA(1, 1, At, B1); PG8_BAR;
            PG8_LDB(B0, 1, 0); PG8_SCHED; PG8_LDA(At, 1, 0); PG8_STAGE(PG8_SA(0, 1), a2 + hstep, voffA);
            PG8_WAIT_L(8); PG8_BAR; PG8_WAIT_L(0); PG8_MMA(0, 0, At, B0); PG8_BAR; PG8_SCHED;
            PG8_LDB(B1, 1, 1); PG8_STAGE(PG8_SB(1, 0), b3, voffB);
            PG8_BAR; PG8_WAIT_L(0); PG8_MMA(0, 1, At, B1); PG8_BAR;
            PG8_LDA(At, 1, 1); PG8_STAGE(PG8_SA(1, 0), a3, voffA);
            PG8_BAR; PG8_WAIT_L(0); PG8_MMA(1, 0, At, B0); PG8_BAR; PG8_SCHED;
            PG8_STAGE(PG8_SB(1, 1), b3 + hstep, voffB);
            PG8_WAIT_V(6); PG8_BAR; PG8_MMA(1, 1, At, B1); PG8_BAR;
            }
        }
        if constexpr (Epi::NT8 > 0) { const float rs_ = E.mix_rescale();
#pragma unroll
            for (int a_ = 0; a_ < 2; ++a_)
#pragma unroll
                for (int b_ = 0; b_ < 2; ++b_)
#pragma unroll
                    for (int m_ = 0; m_ < 4; ++m_)
#pragma unroll
                        for (int n_ = 0; n_ < 2; ++n_) acc[a_][b_][m_][n_] *= rs_; }
        for (int t = (Epi::NT8 > 0 ? Epi::NT8 : 0); t < nt; t += 2) {
            const bool last = (t == nt - 2);
            constexpr bool f8now = false; (void)f8now;
            const char* a1 = cA + (size_t)(t + 1) * kstep;
            const char* a2 = last ? nA : cA + (size_t)(t + 2) * kstep; const char* b2 = last ? nB : cB + (size_t)(t + 2) * kstep;
            const char* a3 = a2 + kstep; const char* b3 = b2 + kstep;
            if (last && has_next) S.a_ready(nxt);
            if constexpr (SP2) {
            PG8_LDB(B0, 0, 0); PG8_LDB(B1, 0, 1); PG8_SCHED; PG8_LDA(At, 0, 0); PG8_STAGE(PG8_SA(1, 1), a1 + hstep, voffA);
            PG8_WAIT_V(8); PG8_WAIT_L(0); PG8_BAR; PG8_MMA(0, 0, At, B0); PG8_MMA(0, 1, At, B1); PG8_BAR; PG8_SCHED;
            PG8_LDA(At, 0, 1); PG8_STAGE(PG8_SB(0, 0), b2, voffB); PG8_STAGE(PG8_SB(0, 1), b2 + hstep, voffB); PG8_STAGE(PG8_SA(0, 0), a2, voffA);
            PG8_WAIT_V(8); PG8_WAIT_L(0); PG8_BAR; PG8_MMA(1, 0, At, B0); PG8_MMA(1, 1, At, B1); PG8_BAR; PG8_SCHED;
            PG8_LDB(B0, 1, 0); PG8_LDB(B1, 1, 1); PG8_SCHED; PG8_LDA(At, 1, 0); PG8_STAGE(PG8_SA(0, 1), a2 + hstep, voffA);
            PG8_WAIT_V(8); PG8_WAIT_L(0); PG8_BAR; PG8_MMA(0, 0, At, B0); PG8_MMA(0, 1, At, B1); PG8_BAR; PG8_SCHED;
            PG8_LDA(At, 1, 1); PG8_STAGE(PG8_SB(1, 0), b3, voffB); PG8_STAGE(PG8_SB(1, 1), b3 + hstep, voffB); PG8_STAGE(PG8_SA(1, 0), a3, voffA);
            PG8_WAIT_V(8); PG8_WAIT_L(0); PG8_BAR; PG8_MMA(1, 0, At, B0); PG8_MMA(1, 1, At, B1); PG8_BAR; PG8_SCHED;
            } else {
            PG8_LDB(B0, 0, 0); PG8_SCHED; PG8_LDA(At, 0, 0); PG8_STAGE(PG8_SA(1, 1), a1 + hstep, voffA);
            PG8_WAIT_L(8); PG8_BAR; PG8_WAIT_L(0); PG8_MMA(0, 0, At, B0); PG8_BAR; PG8_SCHED;
            PG8_LDB(B1, 0, 1); PG8_STAGE(PG8_SB(0, 0), b2, voffB);
            PG8_BAR; PG8_WAIT_L(0); PG8_MMA(0, 1, At, B1); PG8_BAR;
            PG8_LDA(At, 0, 1); PG8_STAGE(PG8_SA(0, 0), a2, voffA);
            PG8_BAR; PG8_WAIT_L(0); PG8_MMA(1, 0, At, B0); PG8_BAR; PG8_SCHED;
            PG8_STAGE(PG8_SB(0, 1), b2 + hstep, voffB);
            PG8_WAIT_V(6); PG8_BAR; PG8_MMA(1, 1, At, B1); PG8_BAR;
            PG8_LDB(B0, 1, 0); PG8_SCHED; PG8_LDA(At, 1, 0); PG8_STAGE(PG8_SA(0, 1), a2 + hstep, voffA);
            PG8_WAIT_L(8); PG8_BAR; PG8_WAIT_L(0); PG8_MMA(0, 0, At, B0); PG8_BAR; PG8_SCHED;
            PG8_LDB(B1, 1, 1); PG8_STAGE(PG8_SB(1, 0), b3, voffB);
            PG8_BAR; PG8_WAIT_L(0); PG8_MMA(0, 1, At, B1); PG8_BAR;
            PG8_LDA(At, 1, 1); PG8_STAGE(PG8_SA(1, 0), a3, voffA);
            PG8_BAR; PG8_WAIT_L(0); PG8_MMA(1, 0, At, B0); PG8_BAR; PG8_SCHED;
            PG8_STAGE(PG8_SB(1, 1), b3 + hstep, voffB);
            PG8_WAIT_V(6); PG8_BAR; PG8_MMA(1, 1, At, B1); PG8_BAR;
            }
        }
        if constexpr (ALIGN_EPI) { if (wr == 0) PG8_BAR; }
#ifdef PROBE_EPI2
        if constexpr (!Epi::AFTER_DRAIN) { if constexpr (Epi::I8) {
                int reps_ = 2; asm volatile("" : "+s"(reps_));
#pragma unroll 1
                for (int rep_ = 0; rep_ < reps_; ++rep_) { asm volatile("" ::: "memory"); E(acc, cur, wr, wc, fr, fq); } }
            else E(acc, cur, wr, wc, fr, fq);
            S.done(cur); }
#else
        if constexpr (!Epi::AFTER_DRAIN) { E(acc, cur, wr, wc, fr, fq); S.done(cur); }
#endif
        if (!has_next) break;
#pragma unroll
        for (int a = 0; a < 2; ++a)
#pragma unroll
            for (int b = 0; b < 2; ++b)
#pragma unroll
                for (int m = 0; m < 4; ++m)
#pragma unroll
                    for (int n = 0; n < 2; ++n) acc[a][b][m][n] = (f32x4){0.f, 0.f, 0.f, 0.f};
        cur = nxt; cA = nA; cB = nB; ++ui; cur.slot = ui & 1; pg8_prefetch(E, cur, wid, lane);
        if constexpr (ALIGN_EPI) { if (wr == 1) PG8_BAR; }
    }
    PG8_WAIT_V(0);
    if constexpr (!ALIGN_EPI) { if (wr == 0) PG8_BAR; }
    PG8_BAR;
    if (PG8_PRIO) __builtin_amdgcn_s_setprio(0);
    if constexpr (Epi::AFTER_DRAIN) { E.fused(acc, cur, wr, wc, fr, fq, lds, wid, lane); S.done(cur); }
#undef PG8_SA
#undef PG8_SB
#undef PG8_STAGE
#undef PG8_LDA
#undef PG8_LDB
#undef PG8_MMA
#undef PG8_WAIT_V
#undef PG8_WAIT_L
#undef PG8_BAR
#undef PG8_SCHED
}
}
#define ATT_LAS __attribute__((address_space(3)))
namespace att {
typedef unsigned short bf16;
using bf16x8 = __attribute__((ext_vector_type(8))) short;
using s16x4  = __attribute__((ext_vector_type(4))) short;
using f32x16 = __attribute__((ext_vector_type(16))) float;
using f32x4  = __attribute__((ext_vector_type(4))) float;
using u32x4  = __attribute__((ext_vector_type(4))) unsigned;
constexpr int NW = 8, QBLK = 32, KVBLK = 64;
constexpr float THR = 8.f;
#ifndef ATT_SRCC
#define ATT_SRCC 1
#endif
#define ATT_KS8 (ATT_SRCC ? 0.5f : 16.0f)
constexpr int SHM_V = KVBLK * 128 * 2;
constexpr int SHM_KMAX = KVBLK * (192 * 2 + 16);
constexpr int OFF_K = 3 * SHM_V, OFF_WS = OFF_K + 2 * SHM_KMAX, ATT_LDS = OFF_WS + NW * 64 * 4;
constexpr int OPITCH = 272;
static_assert(NW * 32 * OPITCH <= OFF_WS, "output staging fits under the K/V buffers");
#define ATT_SBAR() __builtin_amdgcn_sched_barrier(0)
template <int DQK, bool KF8 = false> __device__ __forceinline__ constexpr int kpitch() { return DQK * (KF8 ? 1 : 2) + 16; }
template <int DQK> __device__ __forceinline__ int kswz(int row, int cb) { return row * kpitch<DQK>() + cb; }
__device__ __forceinline__ int crow(int r, int hi) { return (r & 3) + 8 * (r >> 2) + 4 * hi; }
__device__ __forceinline__ unsigned cvtpk(float lo, float hi) { unsigned r; asm volatile("v_cvt_pk_bf16_f32 %0, %1, %2" : "=v"(r) : "v"(lo), "v"(hi)); return r; }
__device__ __forceinline__ float bf2f(unsigned short b) { return __uint_as_float(((unsigned)b) << 16); }

template <bool MASKABLE>
__device__ __forceinline__ void partialSM(f32x16& p0, f32x16& p1, float& m_reg, float& mn, float& alpha, const float C, const float thr_raw, const float pl2, const bool domask, const int mbase) {
  if (MASKABLE) { if (domask) {
#pragma unroll
    for (int r = 0; r < 16; ++r) { const int off = (r & 3) + 8 * (r >> 2);
      p0[r] = ((unsigned)(mbase + off) > 256u) ? -1e30f : p0[r]; p1[r] = ((unsigned)(mbase + 32 + off) > 256u) ? -1e30f : p1[r]; } } }
  float pmax = p0[0];
#pragma unroll
  for (int r = 1; r < 16; ++r) pmax = fmaxf(pmax, p0[r]);
#pragma unroll
  for (int r = 0; r < 16; ++r) pmax = fmaxf(pmax, p1[r]);
  { auto rr = __builtin_amdgcn_permlane32_swap(__float_as_uint(pmax), __float_as_uint(pmax), false, false);
    pmax = fmaxf(__uint_as_float(rr[0]), __uint_as_float(rr[1])); }
  if (__builtin_expect(__all(pmax - m_reg <= thr_raw), 1)) { mn = m_reg; alpha = 1.f; }
  else { mn = fmaxf(m_reg, pmax); alpha = __builtin_amdgcn_exp2f((m_reg - mn) * C); m_reg = mn; }
  const float mnC = pl2 - mn * C;
#pragma unroll
  for (int r = 0; r < 16; ++r) p0[r] = fmaf(p0[r], C, mnC);
#pragma unroll
  for (int r = 0; r < 16; ++r) p1[r] = fmaf(p1[r], C, mnC);
#pragma unroll
  for (int r = 0; r < 16; ++r) p0[r] = __builtin_amdgcn_exp2f(p0[r]);
}
template <bool MASKABLE, bool FIRST>
__device__ __forceinline__ void partialSM2(f32x16& p0, f32x16& p1, float& m_reg, float& alpha, const float thr_l2, const float pl2, const bool domask, const int mbase) {
  if (MASKABLE) { if (domask) {
#pragma unroll
    for (int r = 0; r < 16; ++r) { const int off = (r & 3) + 8 * (r >> 2);
      p0[r] = ((unsigned)(mbase + off) > 256u) ? -1e30f : p0[r]; p1[r] = ((unsigned)(mbase + 32 + off) > 256u) ? -1e30f : p1[r]; } } }
  float pmax = p0[0];
#pragma unroll
  for (int r = 1; r < 16; ++r) pmax = fmaxf(pmax, p0[r]);
#pragma unroll
  for (int r = 0; r < 16; ++r) pmax = fmaxf(pmax, p1[r]);
  { auto rr = __builtin_amdgcn_permlane32_swap(__float_as_uint(pmax), __float_as_uint(pmax), false, false);
    pmax = fmaxf(__uint_as_float(rr[0]), __uint_as_float(rr[1])); }
  const float rel = pmax - pl2;
  if (!FIRST && __builtin_expect(__all(rel <= thr_l2), 1)) { alpha = 1.f; }
  else { const float d = FIRST ? rel : fmaxf(rel, 0.f); alpha = FIRST ? 1.f : __builtin_amdgcn_exp2f(-d); m_reg += d;
#pragma unroll
    for (int r = 0; r < 16; ++r) { p0[r] -= d; p1[r] -= d; } }
#pragma unroll
  for (int r = 0; r < 16; ++r) p0[r] = __builtin_amdgcn_exp2f(p0[r]);
}
__device__ __forceinline__ void finishSM(f32x16& p0, f32x16& p1, float alpha, float& l_reg, bf16x8& pa0, bf16x8& pa1, bf16x8& pa2, bf16x8& pa3) {
#pragma unroll
  for (int r = 0; r < 16; ++r) p1[r] = __builtin_amdgcn_exp2f(p1[r]);
  float ps = 0;
#pragma unroll
  for (int r = 0; r < 16; ++r) ps += p0[r];
#pragma unroll
  for (int r = 0; r < 16; ++r) ps += p1[r];
  { auto rr = __builtin_amdgcn_permlane32_swap(__float_as_uint(ps), __float_as_uint(ps), false, false);
    ps = __uint_as_float(rr[0]) + __uint_as_float(rr[1]); }
  l_reg = l_reg * alpha + ps;
#define ATT_PK4(P, BASE, OUT) do { unsigned a0 = cvtpk(P[BASE + 0], P[BASE + 1]), a1 = cvtpk(P[BASE + 2], P[BASE + 3]);   \
    unsigned b0 = cvtpk(P[BASE + 4], P[BASE + 5]), b1 = cvtpk(P[BASE + 6], P[BASE + 7]);                              \
    auto r0 = __builtin_amdgcn_permlane32_swap(a0, b0, false, false); auto r1 = __builtin_amdgcn_permlane32_swap(a1, b1, false, false); \
    u32x4 w = {r0[0], r1[0], r0[1], r1[1]}; OUT = *reinterpret_cast<bf16x8*>(&w); } while (0)
  ATT_PK4(p0, 0, pa0); ATT_PK4(p0, 8, pa1); ATT_PK4(p1, 0, pa2); ATT_PK4(p1, 8, pa3);
#undef ATT_PK4
}
template <int DQK>
__device__ __forceinline__ void qkt(f32x16& p0, f32x16& p1, const char* Ks, const bf16x8* qr, int r32, int hi) {
  p0 = f32x16{}; p1 = f32x16{};
  const char* kb = Ks + r32 * kpitch<DQK>() + hi * 16;
#pragma unroll
  for (int d0 = 0; d0 < DQK / 16; ++d0) {
    const bf16x8 b0 = *reinterpret_cast<const bf16x8*>(kb + d0 * 32);
    const bf16x8 b1 = *reinterpret_cast<const bf16x8*>(kb + d0 * 32 + 32 * kpitch<DQK>());
    p0 = __builtin_amdgcn_mfma_f32_32x32x16_bf16(b0, qr[d0], p0, 0, 0, 0);
    p1 = __builtin_amdgcn_mfma_f32_32x32x16_bf16(b1, qr[d0], p1, 0, 0, 0);
    if ((d0 & 3) == 3) ATT_SBAR(); }
}
typedef int v8i __attribute__((ext_vector_type(8)));
template <int DQK>
__device__ __forceinline__ void qkt8(f32x16& p0, f32x16& p1, const char* Ks, const v8i* qf, int r32, int hi, const float cinit = 0.f) {
#pragma unroll
  for (int r = 0; r < 16; ++r) { p0[r] = cinit; p1[r] = cinit; }
  constexpr int KP = kpitch<DQK, true>();
  const char* kb = Ks + r32 * KP + hi * 32;
#pragma unroll
  for (int s = 0; s < DQK / 64; ++s) {
    typedef int v4i __attribute__((ext_vector_type(4)));
    const v4i a00 = *reinterpret_cast<const v4i*>(kb + s * 64), a01 = *reinterpret_cast<const v4i*>(kb + s * 64 + 16);
    const v4i a10 = *reinterpret_cast<const v4i*>(kb + s * 64 + 32 * KP), a11 = *reinterpret_cast<const v4i*>(kb + s * 64 + 32 * KP + 16);
    const v8i a0 = __builtin_shufflevector(a00, a01, 0, 1, 2, 3, 4, 5, 6, 7), a1 = __builtin_shufflevector(a10, a11, 0, 1, 2, 3, 4, 5, 6, 7);
    p0 = __builtin_amdgcn_mfma_scale_f32_32x32x64_f8f6f4(a0, qf[s], p0, 0, 0, 0, 0, 0, 0);
    p1 = __builtin_amdgcn_mfma_scale_f32_32x32x64_f8f6f4(a1, qf[s], p1, 0, 0, 0, 0, 0, 0); }
}
__device__ __forceinline__ int v_st(int k, int c) { const int kk = (k & ~0xC) | ((k & 4) << 1) | ((k & 8) >> 1); return ((kk >> 3) * 4 + (c >> 5)) * 512 + ((kk & 7) * 32 + (c & 31)) * 2; }
__device__ __forceinline__ int v_rd_base(int lane) { return ((lane & 3) << 3) | (((lane >> 2) & 3) << 6) | (((lane >> 4) & 1) << 5) | (((lane >> 5) & 1) << 8); }
constexpr int v_rd_off(int d0, int ks, int half) { return d0 * 512 + ks * 4096 + half * 2048; }
template <int OFF> __device__ __forceinline__ s16x4 tr_read(int vb) {
  s16x4 r; asm volatile("ds_read_b64_tr_b16 %0, %1 offset:%2" : "=&v"(r) : "v"(vb), "i"(OFF) : "memory"); return r;
}
template <int D0> __device__ __forceinline__ void pv_one(f32x16& od, int vb, bf16x8 pa0, bf16x8 pa1, bf16x8 pa2, bf16x8 pa3) {
  const s16x4 l0 = tr_read<v_rd_off(D0, 0, 0)>(vb), h0 = tr_read<v_rd_off(D0, 0, 1)>(vb), l1 = tr_read<v_rd_off(D0, 1, 0)>(vb), h1 = tr_read<v_rd_off(D0, 1, 1)>(vb);
  const s16x4 l2 = tr_read<v_rd_off(D0, 2, 0)>(vb), h2 = tr_read<v_rd_off(D0, 2, 1)>(vb), l3 = tr_read<v_rd_off(D0, 3, 0)>(vb), h3 = tr_read<v_rd_off(D0, 3, 1)>(vb);
  asm volatile("s_waitcnt lgkmcnt(0)" ::: "memory"); ATT_SBAR();
#define ATT_PK(L, H) (bf16x8){L[0], L[1], L[2], L[3], H[0], H[1], H[2], H[3]}
  od = __builtin_amdgcn_mfma_f32_32x32x16_bf16(pa0, ATT_PK(l0, h0), od, 0, 0, 0);
  od = __builtin_amdgcn_mfma_f32_32x32x16_bf16(pa1, ATT_PK(l1, h1), od, 0, 0, 0);
  od = __builtin_amdgcn_mfma_f32_32x32x16_bf16(pa2, ATT_PK(l2, h2), od, 0, 0, 0);
  od = __builtin_amdgcn_mfma_f32_32x32x16_bf16(pa3, ATT_PK(l3, h3), od, 0, 0, 0);
#undef ATT_PK
}
__device__ __forceinline__ void pv_d0(f32x16* o, int vb, bf16x8 pa0, bf16x8 pa1, bf16x8 pa2, bf16x8 pa3) {
  pv_one<0>(o[0], vb, pa0, pa1, pa2, pa3); pv_one<1>(o[1], vb, pa0, pa1, pa2, pa3); pv_one<2>(o[2], vb, pa0, pa1, pa2, pa3); pv_one<3>(o[3], vb, pa0, pa1, pa2, pa3);
}

constexpr int VT8_PITCH = 80, VT8_BYTES = 128 * VT8_PITCH;
__device__ __forceinline__ int pk4_fp8(float a, float b, float c, float d) { int t = 0; t = __builtin_amdgcn_cvt_pk_fp8_f32(a, b, t, false); t = __builtin_amdgcn_cvt_pk_fp8_f32(c, d, t, true); return t; }
__device__ __forceinline__ void finishSM8(f32x16& p0, f32x16& p1, float alpha, float& l_reg, v8i& pa) {
#pragma unroll
  for (int r = 0; r < 16; ++r) p1[r] = __builtin_amdgcn_exp2f(p1[r]);
  float ps = 0;
#pragma unroll
  for (int r = 0; r < 16; ++r) ps += p0[r];
#pragma unroll
  for (int r = 0; r < 16; ++r) ps += p1[r];
  { auto rr = __builtin_amdgcn_permlane32_swap(__float_as_uint(ps), __float_as_uint(ps), false, false);
    ps = __uint_as_float(rr[0]) + __uint_as_float(rr[1]); }
  l_reg = l_reg * alpha + ps;
#pragma unroll
  for (int i = 0; i < 4; ++i) { pa[i] = pk4_fp8(p0[4 * i], p0[4 * i + 1], p0[4 * i + 2], p0[4 * i + 3]); pa[4 + i] = pk4_fp8(p1[4 * i], p1[4 * i + 1], p1[4 * i + 2], p1[4 * i + 3]); }
}
__device__ __forceinline__ void pv8_d0(f32x16* o, const char* vp, v8i pa) {
  typedef int v4i __attribute__((ext_vector_type(4)));
#pragma unroll
  for (int d0 = 0; d0 < 4; ++d0) { const v4i x0 = *reinterpret_cast<const v4i*>(vp + d0 * 32 * VT8_PITCH), x1 = *reinterpret_cast<const v4i*>(vp + d0 * 32 * VT8_PITCH + 16);
    const v8i bf = __builtin_shufflevector(x0, x1, 0, 1, 2, 3, 4, 5, 6, 7);
    o[d0] = __builtin_amdgcn_mfma_scale_f32_32x32x64_f8f6f4(pa, bf, o[d0], 0, 0, 0, 0, 0, 0); }
}

template <int DQK> __device__ __forceinline__ constexpr float q8_scale() { return (ATT_SRCC != 0) ? (DQK == 192 ? 0.07216878364870323f : 0.08838834764831845f) * 1.4426950408889634f / ATT_KS8 : 16.0f; }
template <int DQK, bool QNORM, bool MASKABLE, bool OFP8, bool KF8, bool VF8, bool Q8IN = false>
__device__ __forceinline__ void attn_body(const bf16* __restrict__ Qlane, const float* __restrict__ gq, const float* __restrict__ rope, int qrow, int qcol,
                                          const bf16* __restrict__ K0, long ldk, const bf16* __restrict__ V0, long ldv, int a0, int nA, int b0, int nB, int jB, int qi,
                                          float sink_l2, bf16* __restrict__ Owave, long ldo, char* lds, ATT_LAS unsigned char* ldsl, const int tid) {
  constexpr float SCALE = DQK == 192 ? 0.07216878364870323f : 0.08838834764831845f;
  constexpr bool SRCC = KF8 && (ATT_SRCC != 0);
  constexpr float QKS = KF8 ? 256.0f : 1.0f;
  constexpr float C = SRCC ? 1.0f : SCALE * 1.4426950408889634f / QKS;
  constexpr float THR_RAW = (VF8 ? 2.f : THR) / SCALE * QKS;
  constexpr float THR_L2 = (VF8 ? 2.f : THR) * 1.4426950408889634f;
  constexpr float SQ8 = SRCC ? SCALE * 1.4426950408889634f / ATT_KS8 : 16.0f;
  constexpr int SHMV = VF8 ? VT8_BYTES : SHM_V;
  constexpr float PL2 = VF8 ? 5.0f : 0.0f;
  constexpr int SHM_K = KVBLK * kpitch<DQK, KF8>();
  constexpr int KP = DQK / 64;
  const int wid = __builtin_amdgcn_readfirstlane(tid >> 6), lane = tid & 63, r32 = lane & 31, hi = lane >> 5;
  char* V_lds = lds; char* K_lds = lds + OFF_K;
  float* ws = (float*)(lds + OFF_WS) + wid * 64; float* li_l = ws; float* al_l = ws + 32;
  float m_reg = (KF8 && (ATT_SRCC != 0)) ? 0.f : -1e30f, l_reg = 0; f32x16 o[4] = {}; bf16x8 qr[KF8 ? 1 : DQK / 16]; v8i qf[KF8 ? DQK / 64 : 1];
  bf16x8 qw[(KF8 && !(Q8IN && !QNORM)) ? DQK / 64 : 1][4];
  if constexpr (KF8 && !(Q8IN && !QNORM)) { const bf16* Qw0 = Qlane + hi * 32;
#pragma unroll
    for (int s_ = 0; s_ < DQK / 64; ++s_)
#pragma unroll
      for (int i = 0; i < 4; ++i) qw[s_][i] = *reinterpret_cast<const bf16x8*>(Qw0 + s_ * 64 + i * 8); }
  asm volatile("" ::: "memory");
  constexpr int KPITCH = kpitch<DQK, KF8>(), KSLOTW = SHM_K / 1024, KI = (KSLOTW + 7) / 8, KROWB = DQK * (KF8 ? 1 : 2), KES = KF8 ? 1 : 2;
  int koff[KI], voff[2];
#pragma unroll
  for (int i = 0; i < KI; ++i) { const int p = ((i * 8 + wid) * 64 + lane) * 16; const int row = p / KPITCH; int cb = p - row * KPITCH; if (cb >= KROWB) cb = 0; koff[i] = row * (int)ldk * KES + cb; }
  if constexpr (!VF8) {
#pragma unroll
  for (int i = 0; i < 2; ++i) { const int p = (i * 8 + wid) * 64 + lane; const int sub = p >> 5; const int kk = ((sub >> 2) << 3) | ((p >> 2) & 7); const int k = (kk & ~0xC) | ((kk & 4) << 1) | ((kk & 8) >> 1);
    const int c = (sub & 3) * 32 + (p & 3) * 8; voff[i] = k * (int)ldv * 2 + c * 2; }
  } else { voff[0] = (wid * 64 + lane) * 16; voff[1] = ((8 + wid) * 64 + lane) * 16; }
  const int vbase = (int)(uintptr_t)V_lds + v_rd_base(lane);
  const char* vp8 = V_lds + r32 * VT8_PITCH + hi * 32;
  const int NT = nA + nB;
#define ATT_TROW(t) ((t) < nA ? a0 + 64 * (t) : b0 + 64 * ((t) - nA))
#define ATT_DMA(t, kbsel, vbyte) do { const long r0_ = ATT_TROW(t); const char* kt_ = (const char*)K0 + r0_ * ldk * KES; const char* vt_ = VF8 ? (const char*)V0 + (r0_ >> 6) * ldv : (const char*)V0 + r0_ * ldv * 2; \
    _Pragma("unroll") for (int i_ = 0; i_ < KI; ++i_) { const int s_ = i_ * 8 + wid; if (s_ < KSLOTW) __builtin_amdgcn_global_load_lds((const unsigned*)(kt_ + koff[i_]), (ATT_LAS unsigned*)(ldsl + OFF_K + (kbsel) * SHM_K + s_ * 1024), 16, 0, 0); } \
    _Pragma("unroll") for (int i_ = 0; i_ < 2; ++i_) { if (!VF8 || i_ * 8 + wid < VT8_BYTES / 1024) __builtin_amdgcn_global_load_lds((const unsigned*)(vt_ + voff[i_]), (ATT_LAS unsigned*)(ldsl + (vbyte) + (i_ * 8 + wid) * 1024), 16, 0, 0); } } while (0)
  ATT_DMA(0, 0, 0); ATT_DMA(1, 1, SHMV);
  if constexpr (KF8 && Q8IN && !QNORM) {
    typedef int v4i_q __attribute__((ext_vector_type(4))); const char* Q8 = (const char*)Qlane + hi * 32;
#pragma unroll
    for (int s_ = 0; s_ < DQK / 64; ++s_) { const v4i_q a_ = *reinterpret_cast<const v4i_q*>(Q8 + s_ * 64), b_ = *reinterpret_cast<const v4i_q*>(Q8 + s_ * 64 + 16); qf[s_] = __builtin_shufflevector(a_, b_, 0, 1, 2, 3, 4, 5, 6, 7); }
  } else if constexpr (KF8) {
    constexpr int NS = DQK / 64; float y[NS][32];
    const bf16* Qw = Qlane + hi * 32;
#pragma unroll
    for (int s_ = 0; s_ < NS; ++s_)
#pragma unroll
      for (int i = 0; i < 4; ++i) { const bf16x8 w = qw[s_][i];
#pragma unroll
        for (int e = 0; e < 8; ++e) y[s_][i * 8 + e] = bf2f((unsigned short)w[e]); }
    if constexpr (QNORM) {
      float ss = 0.f;
#pragma unroll
      for (int s_ = 0; s_ < NS; ++s_)
#pragma unroll
        for (int e = 0; e < 32; ++e) ss = fmaf(y[s_][e], y[s_][e], ss);
      ss += __shfl_xor(ss, 32);
      const float rn = 1.0f / sqrtf(ss * (1.0f / DQK) + 1e-6f);
#pragma unroll
      for (int s_ = 0; s_ < NS; ++s_)
#pragma unroll
        for (int i = 0; i < 8; ++i) { const f32x4 g4 = *(const f32x4*)(gq + s_ * 64 + hi * 32 + i * 4);
#pragma unroll
          for (int e = 0; e < 4; ++e) y[s_][i * 4 + e] *= rn * g4[e]; }
      if (rope != nullptr && DQK == 192) {
        const int pos = hi ? qcol : qrow; const float* tp = rope + (size_t)pos * 32;
#pragma unroll
        for (int j = 0; j < 16; ++j) { const float cs = tp[2 * j], sn = tp[2 * j + 1]; const float x1 = y[NS - 1][j], x2 = y[NS - 1][16 + j];
          y[NS - 1][j] = x1 * cs - x2 * sn; y[NS - 1][16 + j] = x1 * sn + x2 * cs; }
      }
    }
#pragma unroll
    for (int s_ = 0; s_ < NS; ++s_)
#pragma unroll
      for (int i = 0; i < 8; ++i) { int t = 0; t = __builtin_amdgcn_cvt_pk_fp8_f32(y[s_][4 * i] * SQ8, y[s_][4 * i + 1] * SQ8, t, false); t = __builtin_amdgcn_cvt_pk_fp8_f32(y[s_][4 * i + 2] * SQ8, y[s_][4 * i + 3] * SQ8, t, true); qf[s_][i] = t; }
  } else
  {
    const bf16* Qw = Qlane + hi * 8;
    if constexpr (!QNORM) {
#pragma unroll
      for (int d0 = 0; d0 < DQK / 16; ++d0) qr[d0] = *reinterpret_cast<const bf16x8*>(Qw + d0 * 16);
    } else {
      float ss = 0.f;
#pragma unroll
      for (int d0 = 0; d0 < DQK / 16; ++d0) { qr[d0] = *reinterpret_cast<const bf16x8*>(Qw + d0 * 16);
#pragma unroll
        for (int e = 0; e < 8; ++e) { const float x = bf2f((unsigned short)qr[d0][e]); ss = fmaf(x, x, ss); } }
      ss += __shfl_xor(ss, 32);
      const float rn = 1.0f / sqrtf(ss * (1.0f / DQK) + 1e-6f);
      float y[DQK / 16][8];
#pragma unroll
      for (int d0 = 0; d0 < DQK / 16; ++d0) { const f32x4 g0 = *(const f32x4*)(gq + d0 * 16 + hi * 8), g1 = *(const f32x4*)(gq + d0 * 16 + hi * 8 + 4);
#pragma unroll
        for (int e = 0; e < 8; ++e) y[d0][e] = bf2f((unsigned short)qr[d0][e]) * rn * (e < 4 ? g0[e] : g1[e - 4]); }
      if (rope != nullptr && DQK == 192) {
#pragma unroll
        for (int half = 0; half < 2; ++half) { const int pos = half ? qcol : qrow; const float* tp = rope + (size_t)(pos * 16 + hi * 8) * 2;
#pragma unroll
          for (int e = 0; e < 8; ++e) { const float cs = tp[2 * e], sn = tp[2 * e + 1]; const float x1 = y[8 + 2 * half][e], x2 = y[9 + 2 * half][e];
            y[8 + 2 * half][e] = x1 * cs - x2 * sn; y[9 + 2 * half][e] = x1 * sn + x2 * cs; } }
      }
#pragma unroll
      for (int d0 = 0; d0 < DQK / 16; ++d0) { u32x4 w = {cvtpk(y[d0][0], y[d0][1]), cvtpk(y[d0][2], y[d0][3]), cvtpk(y[d0][4], y[d0][5]), cvtpk(y[d0][6], y[d0][7])}; qr[d0] = *reinterpret_cast<bf16x8*>(&w); }
    }
  }
#define ATT_QKT(P0, P1, KS) do { if constexpr (SRCC) qkt8<DQK>(P0, P1, KS, qf, r32, hi, PL2 - m_reg); else if constexpr (KF8) qkt8<DQK>(P0, P1, KS, qf, r32, hi); else qkt<DQK>(P0, P1, KS, qr, r32, hi); } while (0)
#define ATT_PSM(FIRST_, P0, P1, MN, AL, ...) do { if constexpr (SRCC) partialSM2<MASKABLE, FIRST_>(P0, P1, m_reg, AL, THR_L2, PL2, __VA_ARGS__); else partialSM<MASKABLE>(P0, P1, m_reg, MN, AL, C, THR_RAW, PL2, __VA_ARGS__); } while (0)
#define ATT_LAND() do { asm volatile("s_waitcnt vmcnt(0)" ::: "memory"); __syncthreads(); } while (0)
#define ATT_RESC(a) do { if (__any((a) < 1.f)) { if (hi == 0) al_l[r32] = (a); asm volatile("s_waitcnt lgkmcnt(0)" ::: "memory"); \
    _Pragma("unroll") for (int d = 0; d < 4; ++d) _Pragma("unroll") for (int r = 0; r < 16; ++r) o[d][r] *= al_l[crow(r, hi)]; } } while (0)
#define ATT_MASKARGS(t) (MASKABLE && (t) >= nA), (jB + 64 * ((t) - nA) - qi + 128 + 4 * hi)
  f32x16 pA0, pA1, pB0, pB1; float mnA, mnB, alA, alB; bf16x8 pa0, pa1, pa2, pa3; v8i pa8;
#define ATT_FIN(P0, P1, AL) do { if constexpr (VF8) finishSM8(P0, P1, AL, l_reg, pa8); else finishSM(P0, P1, AL, l_reg, pa0, pa1, pa2, pa3); } while (0)
#define ATT_PV(VOFF) do { if constexpr (VF8) pv8_d0(o, vp8 + (VOFF), pa8); else pv_d0(o, vbase + (VOFF), pa0, pa1, pa2, pa3); } while (0)
  int vprev = 0, vcur = SHMV, vnext = 2 * SHMV;
  ATT_LAND();
  ATT_QKT(pA0, pA1, K_lds); ATT_PSM(true, pA0, pA1, mnA, alA, ATT_MASKARGS(0));
  __syncthreads();
#ifdef ATT_PRIO_HALF
  if (wid >= 4) __builtin_amdgcn_s_setprio(1);
#endif
  for (int j = 1; j + 1 < NT; j += 2) {
    ATT_DMA(j + 1, 0, vnext);
    ATT_SBAR(); ATT_QKT(pB0, pB1, K_lds + SHM_K);
    ATT_FIN(pA0, pA1, alA); ATT_SBAR();
    ATT_PV(vprev); ATT_PSM(false, pB0, pB1, mnB, alB, ATT_MASKARGS(j));
    ATT_RESC(alB); ATT_LAND();
    { const int t_ = vprev; vprev = vcur; vcur = vnext; vnext = t_; }
    ATT_DMA(j + 2, 1, vnext);
    ATT_SBAR(); ATT_QKT(pA0, pA1, K_lds);
    ATT_FIN(pB0, pB1, alB); ATT_SBAR();
    ATT_PV(vprev); ATT_PSM(false, pA0, pA1, mnA, alA, ATT_MASKARGS(j + 1));
    ATT_RESC(alA); ATT_LAND();
    { const int t_ = vprev; vprev = vcur; vcur = vnext; vnext = t_; }
  }
  ATT_SBAR(); ATT_QKT(pB0, pB1, K_lds + SHM_K);
  ATT_FIN(pA0, pA1, alA); ATT_SBAR();
  ATT_PV(vprev); ATT_PSM(false, pB0, pB1, mnB, alB, ATT_MASKARGS(NT - 1));
  ATT_RESC(alB);
  ATT_FIN(pB0, pB1, alB); ATT_SBAR();
  ATT_PV(vcur);
#ifdef ATT_PRIO_HALF
  __builtin_amdgcn_s_setprio(0);
#endif
  l_reg += __builtin_amdgcn_exp2f(sink_l2 - m_reg * C + PL2);
  if (hi == 0) li_l[r32] = l_reg; asm volatile("s_waitcnt lgkmcnt(0)" ::: "memory");
  float rli[16];
#pragma unroll
  for (int r = 0; r < 16; ++r) rli[r] = __builtin_amdgcn_rcpf(li_l[crow(r, hi)]) * (VF8 ? (1.0f / 32.0f) : 1.0f);
  __syncthreads();
  if constexpr (OFP8) {
    char* ost = lds + wid * (32 * 144);
#pragma unroll
    for (int r = 0; r < 16; ++r) { const int orow = crow(r, hi);
#pragma unroll
      for (int d0 = 0; d0 < 4; ++d0) { const float v = o[d0][r] * rli[r] * 32.0f; const float vc = __builtin_amdgcn_fmed3f(v, -448.f, 448.f); const unsigned w = (unsigned)__builtin_amdgcn_cvt_pk_fp8_f32(vc, vc, 0, false);
        *(unsigned char*)(ost + orow * 144 + d0 * 32 + r32) = (unsigned char)(w & 0xffu); } }
    asm volatile("s_waitcnt lgkmcnt(0)" ::: "memory");
#pragma unroll
    for (int ps = 0; ps < 4; ++ps) { const int row = ps * 8 + (lane >> 3), c16 = lane & 7;
      const u32x4 w = *(const u32x4*)(ost + row * 144 + c16 * 16);
      *(u32x4*)((char*)Owave + (long)row * ldo + c16 * 16) = w; }
  } else {
  char* ost = lds + wid * (32 * OPITCH);
#pragma unroll
  for (int r = 0; r < 16; ++r) { const int orow = crow(r, hi);
#pragma unroll
    for (int d0 = 0; d0 < 4; ++d0) { const float v = o[d0][r] * rli[r]; unsigned u = __float_as_uint(v); u += 0x7fffu + ((u >> 16) & 1u);
      *(unsigned short*)(ost + orow * OPITCH + (d0 * 32 + r32) * 2) = (unsigned short)(u >> 16); } }
  asm volatile("s_waitcnt lgkmcnt(0)" ::: "memory");
#pragma unroll
  for (int ps = 0; ps < 8; ++ps) { const int row = ps * 4 + (lane >> 4), c16 = lane & 15;
    const u32x4 w = *(const u32x4*)(ost + row * OPITCH + c16 * 16);
    *(u32x4*)(Owave + (long)row * ldo + c16 * 8) = w; }
  }
  __syncthreads();
#undef ATT_TROW
#undef ATT_DMA
#undef ATT_QKT
#undef ATT_PSM
#undef ATT_FIN
#undef ATT_PV
#undef ATT_LAND
#undef ATT_RESC
#undef ATT_MASKARGS
}
}

#define LAS __attribute__((address_space(3)))
#define XB_TMO      128
#define XB_XCNT(j)  (256  + 64 * (j))
#define XB_XSUB(j)  (1280 + 64 * (j))
#define XB_XGEN(j)  (2304 + 64 * (j))
#define XB_TOP      3328
#define XB_TOPGEN   3392
#define XCD_BAR_WORDS 3456
#define XB_SPIN_CAP (1u << 18)

__device__ __forceinline__ unsigned xb_ld(unsigned* p)              { return __hip_atomic_load(p, __ATOMIC_RELAXED, __HIP_MEMORY_SCOPE_AGENT); }
__device__ __forceinline__ unsigned xb_add(unsigned* p, unsigned v) { return __hip_atomic_fetch_add(p, v, __ATOMIC_RELAXED, __HIP_MEMORY_SCOPE_AGENT); }
__device__ __forceinline__ unsigned xb_xcc_id() { return (unsigned)__builtin_amdgcn_s_getreg((3 << 11) | 20) & 0xFu; }
#define XB_SPIN(cond, bar) do { unsigned _sp = 0; while (cond) { __builtin_amdgcn_s_sleep(1); \
    if ((++_sp & 255u) == 0u) { if (xb_ld(&(bar)[XB_TMO])) break; if (_sp > XB_SPIN_CAP) { atomicAdd(&(bar)[XB_TMO], 1u); break; } } } } while (0)

struct XcdBarrier {
    unsigned* bar; unsigned x;
    volatile LAS unsigned* st;
};

__device__ __forceinline__ XcdBarrier xcd_barrier_post(unsigned* bar, volatile LAS unsigned* st) {
    XcdBarrier b; b.bar = bar; b.x = xb_xcc_id(); b.st = st;
    if (threadIdx.x == 0) (void)xb_add(&bar[XB_XCNT(b.x)], 1u);
    return b;
}
__device__ __forceinline__ void xcd_barrier_complete(unsigned* bar, unsigned x, unsigned& nloc, unsigned& nx) {
    const unsigned G = gridDim.x * gridDim.y * gridDim.z;
    unsigned sum, cnt, mine, sp = 0u;
    for (;;) {
        sum = 0u; cnt = 0u; mine = 0u;
#pragma unroll
        for (unsigned j = 0; j < 16; ++j) { const unsigned c = xb_ld(&bar[XB_XCNT(j)]); sum += c; cnt += (c > 0u) ? 1u : 0u; mine = (j == x) ? c : mine; }
        if (sum == G) break;
        __builtin_amdgcn_s_sleep(1);
        if ((++sp & 255u) == 0u) { if (xb_ld(&bar[XB_TMO])) break; if (sp > XB_SPIN_CAP) { atomicAdd(&bar[XB_TMO], 1u); break; } }
    }
    nloc = mine > 0u ? mine : 1u; nx = cnt > 0u ? cnt : 1u;
}

__device__ __forceinline__ void xcd_barrier(const XcdBarrier& b) {
    asm volatile("s_waitcnt vmcnt(0)" ::: "memory");
    __syncthreads();
    if (threadIdx.x == 0) {
        unsigned* bar = b.bar;
        __builtin_amdgcn_s_waitcnt(0);
        unsigned nloc = b.st[0], nx = b.st[1];
        if (nloc == 0u) { xcd_barrier_complete(bar, b.x, nloc, nx); b.st[0] = nloc; b.st[1] = nx; }
        const unsigned old = xb_add(&bar[XB_XSUB(b.x)], 1u);
        const unsigned gen = old / nloc;
        if (old + 1u == (gen + 1u) * nloc) {
            __builtin_amdgcn_fence(__ATOMIC_RELEASE, "agent");
            asm volatile("s_waitcnt vmcnt(0)" ::: "memory");
            const unsigned og = xb_add(&bar[XB_TOP], 1u);
            const unsigned tg = og / nx;
            if (og + 1u == (tg + 1u) * nx) xb_add(&bar[XB_TOPGEN], 1u);
            else XB_SPIN(xb_ld(&bar[XB_TOPGEN]) == tg, bar);
            __builtin_amdgcn_fence(__ATOMIC_ACQUIRE, "agent");
            xb_add(&bar[XB_XGEN(b.x)], 1u);
            asm volatile("s_waitcnt vmcnt(0)" ::: "memory");
        } else {
            XB_SPIN(xb_ld(&bar[XB_XGEN(b.x)]) == gen, bar);
            __builtin_amdgcn_fence(__ATOMIC_ACQUIRE, "agent");
            asm volatile("s_waitcnt vmcnt(0)" ::: "memory");
        }
    }
    __syncthreads();
}
#ifndef QUP_I8
#define QUP_I8 0
#endif
#ifndef UP_SUBSTAT
#define UP_SUBSTAT 1
#endif
#ifndef FFN_SORT
#define FFN_SORT 1
#endif
#ifndef UP_I8
#define UP_I8 1
#endif
#ifndef GQ_FP8
#define GQ_FP8 1
#endif
#ifndef W_TAIL3
#define W_TAIL3 1
#endif
#ifndef TAP_FOLD
#define TAP_FOLD 1
#endif
#ifndef UP_TAIL
#define UP_TAIL 0
#endif
#ifndef UPT_A
#define UPT_A 13000
#endif
#ifndef UPT_B
#define UPT_B 15000
#endif
#ifndef DOWN_TAIL
#define DOWN_TAIL 1
#endif
#ifndef KV_FUSE
#define KV_FUSE 1
#endif
#ifndef KVUP_I8
#define KVUP_I8 1
#endif
#ifndef KVUP_FP8
#define KVUP_FP8 1
#endif
#ifndef DOWN_NT8
#define DOWN_NT8 74
#endif
constexpr int DM = 4096, NPROMPT = 16, SEQ = 256, NLAT = 8, LSEQ = 4096, PAST = 256;
constexpr int TP = NPROMPT * SEQ;
constexpr int TL = NLAT * LSEQ;
constexpr int MTOK = TP + TL;
constexpr int KVROWS = TP + NLAT * (PAST + LSEQ);
constexpr int QRANK = 1024, KVRANK = 512, ROPED = 64, MLAH = 16, MLAQK = 192, GQH = 16, GKVH = 4, GHD = 128, DFF = 11008;
constexpr int INC = 4672, INCP = 4864;
constexpr int ZBW = 1792, ZQW = 3072;
constexpr int ZKV = 0, ZPE = 512, ZGK = 576, ZGV = 1088, ZQ = 0, ZGQ = 1024;
constexpr int NMOD = 9;
constexpr int KSPLIT = 32;
constexpr float EPS = 1e-6f;
constexpr int GK8 = DOWN_NT8 * 128;
constexpr int GPB = GK8 + (DFF - GK8) * 2;
constexpr float SG8 = 4.0f, SW8 = 256.0f;
static_assert(DOWN_NT8 % 2 == 0 && GK8 <= DFF && ((DFF - GK8) / 64) % 2 == 0, "mixed-K split");

constexpr size_t MiB = 1u << 20;
constexpr size_t WS_CTL = 0, CTL_ZERO_BYTES = 1 * MiB;
constexpr size_t WS_MOD = 1 * MiB;
constexpr size_t WS_ROPE16 = WS_MOD + 900 * 1024;
constexpr size_t WS_ROPE32 = WS_ROPE16 + 8192;
constexpr size_t WS_COLSC = WS_MOD + 928 * 1024;
constexpr size_t WS_COLMAX = 256 * 1024;
constexpr size_t WS_ROWSC = 2 * MiB;
constexpr size_t WS_MODP = 2 * MiB;
constexpr size_t WS_WIN = 32 * MiB;
constexpr size_t WS_WINQ = 48 * MiB;
constexpr size_t WS_WQUP = 70 * MiB;
constexpr size_t WS_RANK = 73 * MiB;
constexpr size_t WS_SIGMA = WS_RANK + 64 * 1024, WS_CWP = WS_RANK + 128 * 1024, WS_CBP = WS_RANK + 512 * 1024;
constexpr size_t WS_WKVUP = 76 * MiB;
constexpr size_t WS_WOUT = 80 * MiB;
constexpr size_t WS_WUP = 112 * MiB;
constexpr size_t WS_WDOWN = 284 * MiB;
constexpr size_t WS_HB = 370 * MiB;
constexpr size_t WS_Z = 658 * MiB;
constexpr size_t WS_ZB = 874 * MiB;
constexpr size_t WS_K8 = 874 * MiB;
constexpr size_t WS_H8 = 1116 * MiB;
constexpr size_t WS_QRAW = 658 * MiB;
constexpr size_t WS_QN = 1000 * MiB;
constexpr size_t WS_CKV = 1072 * MiB;
constexpr size_t WS_KPE = 1110 * MiB;
constexpr size_t WS_CKVS = WS_KPE + 5 * MiB;
constexpr size_t WS_KPESS = WS_CKVS + 256 * 1024;
constexpr size_t WS_KVCOLMAX = 448 * 1024;
constexpr size_t WS_KVCS = WS_RANK + 640 * 1024;
constexpr size_t WS_KB = 1116 * MiB;
constexpr size_t WS_VB = 1344 * MiB;
constexpr size_t WS_GQ = 1496 * MiB;
constexpr size_t WS_GK = 1640 * MiB;
constexpr size_t WS_GV = 1678 * MiB;
constexpr size_t WS_G = 658 * MiB;
constexpr size_t WS_EDGE = 1432 * MiB;
constexpr size_t WS_VT8 = 1716 * MiB;
constexpr size_t WS_X1 = 1716 * MiB;
constexpr size_t WS_END = 2004 * MiB;
static_assert(WS_G + (size_t)MTOK * DFF * 2 <= WS_EDGE && WS_EDGE + (size_t)576 * 4 * 22016 * 4 <= WS_END, "ws map");
static_assert(WS_KB + (size_t)KVROWS * 3072 * 2 <= WS_VB && WS_VB + (size_t)KVROWS * 2048 * 2 <= WS_GQ && WS_GQ + (size_t)MTOK * 2048 * 2 <= WS_GK && WS_GK + (size_t)KVROWS * 512 * 2 <= WS_GV && WS_GV + (size_t)KVROWS * 512 * 2 <= WS_END, "ws map 2");
static_assert(WS_Z + (size_t)MTOK * ZQW * 2 <= WS_ZB && WS_ZB + (size_t)MTOK * ZBW * 2 <= WS_QN && WS_QN + (size_t)MTOK * 1024 * 2 <= WS_CKV && WS_CKV + (size_t)KVROWS * 512 * 2 <= WS_KPE && WS_KPE + (size_t)KVROWS * 64 * 2 <= WS_KB, "ws map 3");
static_assert(WS_HB + (size_t)MTOK * DM * 2 <= WS_Z && WS_WDOWN + (size_t)DM * DFF * 2 <= WS_HB && WS_WUP + (size_t)22016 * DM * 2 <= WS_WDOWN && WS_WIN + (size_t)ZBW * DM * 2 <= WS_WINQ && WS_WINQ + (size_t)ZQW * DM <= WS_WQUP, "ws map 4");
constexpr int CW_BAR = 4096;

constexpr size_t OUT_Y = 0, OUT_CKV = (size_t)MTOK * DM, OUT_KPE = OUT_CKV + (size_t)TP * KVRANK, OUT_GK = OUT_KPE + (size_t)TP * ROPED, OUT_GV = OUT_GK + (size_t)TP * 512, OUT_END = OUT_GV + (size_t)TP * 512;

constexpr int RING_OFF = 0, RING_BYTES = 131072;
constexpr int MISC_OFF = RING_BYTES + 320;
constexpr int LDS_BYTES = 147456;
constexpr int NWAVES = 8, NTHREADS = 512;
#ifndef MK_ONE_LAUNCH
#define MK_ONE_LAUNCH 1
#endif
constexpr int N_PHASES = 13;
#ifndef ATT_VF8
#define ATT_VF8 1
#endif
#ifndef ATT_KF8
#define ATT_KF8 1
#endif
#ifndef QUP_FP8
#define QUP_FP8 1
#endif
#ifndef MIX_FP8
#define MIX_FP8 1
#endif
#ifndef PROBE_GSCALE
#define PROBE_GSCALE 1.0f
#endif
#ifndef PROBE_GSCALE2
#define PROBE_GSCALE2 1.0f
#endif
#ifndef W_P10
#define W_P3B 4
#define W_P3Q 4
#define W_P5K 4
#define W_P5Q 4
#define W_P8 4
#define W_P10 4
#define W_P12 4
#endif
#ifndef GEMM_ALIGN
#define GEMM_ALIGN true
#endif
#ifndef GEMM_SP2
#define GEMM_SP2 true
#endif

#define LAS __attribute__((address_space(3)))
typedef unsigned short bf16;
typedef unsigned v4u __attribute__((ext_vector_type(4)));
typedef unsigned v2u __attribute__((ext_vector_type(2)));
typedef float f32x4 __attribute__((ext_vector_type(4)));
typedef short bf16x8 __attribute__((ext_vector_type(8)));
#define LDS_WAIT() asm volatile("s_waitcnt lgkmcnt(0)" ::: "memory")
__device__ __forceinline__ unsigned f2bf(float f) { unsigned u = __builtin_bit_cast(unsigned, f); return (u + 0x7fffu + ((u >> 16) & 1u)) >> 16; }
__device__ __forceinline__ unsigned pk2(float lo, float hi) { return f2bf(lo) | (f2bf(hi) << 16); }
__device__ __forceinline__ float bflo(unsigned w) { return __uint_as_float(w << 16); }
__device__ __forceinline__ float bfhi(unsigned w) { return __uint_as_float(w & 0xffff0000u); }
__device__ __forceinline__ void unpack8(const v4u w, float (&x)[8]) { x[0] = bflo(w.x); x[1] = bfhi(w.x); x[2] = bflo(w.y); x[3] = bfhi(w.y); x[4] = bflo(w.z); x[5] = bfhi(w.z); x[6] = bflo(w.w); x[7] = bfhi(w.w); }
__device__ __forceinline__ v4u pack8(const float (&x)[8]) { v4u w; w.x = pk2(x[0], x[1]); w.y = pk2(x[2], x[3]); w.z = pk2(x[4], x[5]); w.w = pk2(x[6], x[7]); return w; }
__device__ __forceinline__ float wave_sum(float v) {
#pragma unroll
    for (int o = 1; o < 64; o <<= 1) v += __shfl_xor(v, o);
    return v;
}
__device__ __forceinline__ float silu_f(float a) { return a / (1.0f + __expf(-a)); }

struct Args { const float* in[27]; float* out; unsigned char* ws; int ph_lo, ph_hi; };

__device__ __forceinline__ int kvrow_of(int t) { if (t < TP) return t; const int u = t - TP, b = u >> 12, s = u & 4095; return TP + b * (PAST + LSEQ) + PAST + s; }

__device__ __forceinline__ void p0_load_block(const float* W, int N, const unsigned* srcrow, int k0, int n0, LAS float* scr, int lane) {
    f32x4 v[8];
#pragma unroll
    for (int i = 0; i < 8; ++i) { const int kk = 8 * i + (lane >> 3); const size_t sr = srcrow ? (size_t)srcrow[k0 + kk] : (size_t)(k0 + kk); v[i] = *(const f32x4*)(W + sr * N + n0 + 4 * (lane & 7)); }
#pragma unroll
    for (int i = 0; i < 8; ++i) { LAS float* d = scr + (8 * i + (lane >> 3)) * 33 + 4 * (lane & 7); d[0] = v[i].x; d[1] = v[i].y; d[2] = v[i].z; d[3] = v[i].w; }
}
template <class DMap>
__device__ __forceinline__ void p0_transpose_item(const float* W, int K, int N, bf16* WT, const DMap& dmap, LAS float* scr, int item, int lane, const unsigned* srcrow = nullptr) {
    const int nblk = N / 32, kb = item / nblk, nb = item % nblk, k0 = 64 * kb, n0 = 32 * nb;
    p0_load_block(W, N, srcrow, k0, n0, scr, lane);
    LDS_WAIT(); asm volatile("" ::: "memory");
    const int c = lane & 7; const int r0 = dmap(n0);
#pragma unroll
    for (int j = 0; j < 4; ++j) { const int n = (lane >> 3) + 8 * j; const LAS float* s = scr + (8 * c) * 33 + n;
        v4u o; o.x = pk2(s[0 * 33], s[1 * 33]); o.y = pk2(s[2 * 33], s[3 * 33]); o.z = pk2(s[4 * 33], s[5 * 33]); o.w = pk2(s[6 * 33], s[7 * 33]);
        *(v4u*)(WT + (size_t)(r0 + n) * K + k0 + 8 * c) = o; }
    LDS_WAIT(); asm volatile("" ::: "memory");
}
__device__ __forceinline__ void p0_transpose_item_fp8(const float* W, int K, int N, unsigned char* WT, LAS float* scr, int item, int lane, int row_shift = 0, const unsigned* srcrow = nullptr) {
    const int nblk = N / 32, kb = item / nblk, nb = item % nblk, k0 = 64 * kb, n0 = 32 * nb;
    p0_load_block(W, N, srcrow, k0, n0, scr, lane);
    LDS_WAIT(); asm volatile("" ::: "memory");
    const int c = lane & 3;
#pragma unroll
    for (int j = 0; j < 2; ++j) { const int n = (lane >> 2) + 16 * j; const LAS float* s = scr + (16 * c) * 33 + n; unsigned w[4];
#pragma unroll
        for (int q = 0; q < 4; ++q) { int t = 0; t = cvt_pk_fp8_sat(s[(4 * q) * 33] * 256.f, s[(4 * q + 1) * 33] * 256.f, t, false); t = cvt_pk_fp8_sat(s[(4 * q + 2) * 33] * 256.f, s[(4 * q + 3) * 33] * 256.f, t, true); w[q] = (unsigned)t; }
        v4u o; o.x = w[0]; o.y = w[1]; o.z = w[2]; o.w = w[3];
        *(v4u*)(WT + (size_t)(n0 + n + row_shift) * K + k0 + 16 * c) = o; }
    LDS_WAIT(); asm volatile("" ::: "memory");
}
__device__ __forceinline__ void p0_colmax_item(const float* W, int N, unsigned* colmax, int item, int lane) {
    const int nblk = N / 32, kb = item / nblk, nb = item % nblk, k0 = 64 * kb, n0 = 32 * nb; f32x4 v[8]; f32x4 mx = (f32x4){0.f, 0.f, 0.f, 0.f};
#pragma unroll
    for (int i = 0; i < 8; ++i) v[i] = *(const f32x4*)(W + (size_t)(k0 + 8 * i + (lane >> 3)) * N + n0 + 4 * (lane & 7));
#pragma unroll
    for (int i = 0; i < 8; ++i) { mx.x = fmaxf(mx.x, fabsf(v[i].x)); mx.y = fmaxf(mx.y, fabsf(v[i].y)); mx.z = fmaxf(mx.z, fabsf(v[i].z)); mx.w = fmaxf(mx.w, fabsf(v[i].w)); }
#pragma unroll
    for (int o = 8; o < 64; o <<= 1) { mx.x = fmaxf(mx.x, __shfl_xor(mx.x, o)); mx.y = fmaxf(mx.y, __shfl_xor(mx.y, o)); mx.z = fmaxf(mx.z, __shfl_xor(mx.z, o)); mx.w = fmaxf(mx.w, __shfl_xor(mx.w, o)); }
    if (lane < 8) { unsigned* c = colmax + n0 + 4 * lane; atomicMax(c, __float_as_uint(mx.x)); atomicMax(c + 1, __float_as_uint(mx.y)); atomicMax(c + 2, __float_as_uint(mx.z)); atomicMax(c + 3, __float_as_uint(mx.w)); }
}
__device__ __forceinline__ void p0_colss_item(const float* W, int N, unsigned long long* colss, int item, int lane) {
    const int nblk = N / 32, kb = item / nblk, nb = item % nblk, k0 = 64 * kb, n0 = 32 * nb; f32x4 v[8]; f32x4 ss = (f32x4){0.f, 0.f, 0.f, 0.f};
#pragma unroll
    for (int i = 0; i < 8; ++i) v[i] = *(const f32x4*)(W + (size_t)(k0 + 8 * i + (lane >> 3)) * N + n0 + 4 * (lane & 7));
#pragma unroll
    for (int i = 0; i < 8; ++i) ss += v[i] * v[i];
#pragma unroll
    for (int o = 8; o < 64; o <<= 1) { ss.x += __shfl_xor(ss.x, o); ss.y += __shfl_xor(ss.y, o); ss.z += __shfl_xor(ss.z, o); ss.w += __shfl_xor(ss.w, o); }
    if (lane < 8) { unsigned long long* c = colss + n0 + 4 * lane; atomicAdd(c, (unsigned long long)(ss.x * 1099511627776.0f)); atomicAdd(c + 1, (unsigned long long)(ss.y * 1099511627776.0f));
        atomicAdd(c + 2, (unsigned long long)(ss.z * 1099511627776.0f)); atomicAdd(c + 3, (unsigned long long)(ss.w * 1099511627776.0f)); }
}
template <class DMap, bool EXACT = false>
__device__ __forceinline__ void p0_transpose_item_i8(const float* W, int K, int N, signed char* WT, const DMap& dmap, const unsigned* colmax, float* colscale, LAS float* scr, int item, int lane, float fixed_cm = 0.15875f) {
    const int nblk = N / 32, kb = item / nblk, nb = item % nblk, k0 = 64 * kb, n0 = 32 * nb;
    p0_load_block(W, N, nullptr, k0, n0, scr, lane);
    LDS_WAIT(); asm volatile("" ::: "memory");
    const int c = lane & 3;
#pragma unroll
    for (int j = 0; j < 2; ++j) { const int n = (lane >> 2) + 16 * j; const LAS float* s = scr + (16 * c) * 33 + n; const int r0 = dmap(n0 + n) - n;
        const float cm = colmax ? ((UP_SUBSTAT && !EXACT) ? 4.2f * sqrtf((float)((const unsigned long long*)colmax)[n0 + n] * (1.0f / 1099511627776.0f) * (1.0f / 512.0f)) : __uint_as_float(colmax[n0 + n])) : fixed_cm; const float inv = cm > 0.f ? 127.0f / cm : 0.f; unsigned w[4];
#pragma unroll
        for (int q = 0; q < 4; ++q) { unsigned t = 0;
#pragma unroll
            for (int e = 0; e < 4; ++e) { int v = (int)__builtin_rintf(s[(4 * q + e) * 33] * inv); v = v > 127 ? 127 : (v < -127 ? -127 : v); t |= ((unsigned)v & 0xffu) << (8 * e); }
            w[q] = t; }
        *(v4u*)(WT + (size_t)(r0 + n) * K + k0 + 16 * c) = (v4u){w[0], w[1], w[2], w[3]};
        if (colscale && kb == 0 && c == 0) colscale[r0 + n] = cm * (1.0f / 127.0f); }
    LDS_WAIT(); asm volatile("" ::: "memory");
}
struct MapId { __device__ __forceinline__ int operator()(int n) const { return n; } };
template <class DMap>
__device__ __forceinline__ void p0_transpose_item_fp8m(const float* W, int K, int N, unsigned char* WT, const DMap& dmap, LAS float* scr, int item, int lane) {
    const int nblk = N / 32, kb = item / nblk, nb = item % nblk, k0 = 64 * kb, n0 = 32 * nb;
    p0_load_block(W, N, nullptr, k0, n0, scr, lane);
    LDS_WAIT(); asm volatile("" ::: "memory");
    const int c = lane & 3; const int r0 = dmap(n0);
#pragma unroll
    for (int j = 0; j < 2; ++j) { const int n = (lane >> 2) + 16 * j; const LAS float* s = scr + (16 * c) * 33 + n; unsigned w[4];
#pragma unroll
        for (int q = 0; q < 4; ++q) { int t = 0; t = cvt_pk_fp8_sat(s[(4 * q) * 33] * 256.f, s[(4 * q + 1) * 33] * 256.f, t, false); t = cvt_pk_fp8_sat(s[(4 * q + 2) * 33] * 256.f, s[(4 * q + 3) * 33] * 256.f, t, true); w[q] = (unsigned)t; }
        *(v4u*)(WT + (size_t)(r0 + n) * K + k0 + 16 * c) = (v4u){w[0], w[1], w[2], w[3]}; }
    LDS_WAIT(); asm volatile("" ::: "memory");
}
struct MapShift { int sh; __device__ __forceinline__ int operator()(int n) const { return n + sh; } };
struct MapUpPerm { const unsigned* rank; __device__ __forceinline__ int operator()(int n) const { const int v = n >= DFF, c = n - v * DFF; const int p = (int)rank[c]; return (p >> 7) * 256 + v * 128 + (p & 127); } };
struct MapUp { __device__ __forceinline__ int operator()(int n) const { const int v = n >= DFF, c = n - v * DFF; return (c >> 7) * 256 + v * 128 + (c & 127); } };

__device__ __forceinline__ void phase0(const Args& a, LAS unsigned char* lds, int vcu, int G) {
    const int tid = threadIdx.x, lane = tid & 63, wave = __builtin_amdgcn_readfirstlane(tid >> 6);
    LAS float* scr = (LAS float*)(lds + RING_OFF + wave * 16384);
    const int gw = vcu * NWAVES + wave, NGW = G * NWAVES;
    unsigned char* ws = a.ws;
    if (FFN_SORT) {
        const float* cw = a.in[24]; LAS float* e = (LAS float*)(lds + RING_OFF);
        for (int k = tid; k < DFF; k += NTHREADS) { const float a0 = cw[k], a1 = cw[22016 + k], a2 = cw[2 * 22016 + k], b0 = cw[DFF + k], b1 = cw[22016 + DFF + k], b2 = cw[2 * 22016 + DFF + k];
            e[k] = (a0 * a0 + a1 * a1 + a2 * a2) * (b0 * b0 + b1 * b1 + b2 * b2); }
        __syncthreads();
        unsigned* rank = (unsigned*)(ws + WS_RANK); unsigned* sigma = (unsigned*)(ws + WS_SIGMA);
        for (int k = gw; k < DFF; k += NGW) { const float ek = e[k]; int cnt = 0;
            for (int j = lane; j < DFF; j += 64) { const float ej = e[j]; cnt += (ej < ek || (ej == ek && j < k)) ? 1 : 0; }
#pragma unroll
            for (int o = 1; o < 64; o <<= 1) cnt += __shfl_xor(cnt, o);
            if (lane == 0) { rank[k] = (unsigned)cnt; sigma[cnt] = (unsigned)k; } }
        __syncthreads();
    }
    {
        const float* cvec = a.in[6]; const float* cctx = a.in[7]; const float* wada = a.in[10];
        float* modp = (float*)(ws + WS_MODP);
        for (int task = gw; task < 96 * KSPLIT; task += NGW) {
            const int cg = task % 96, ks = task / 96, k0 = ks * 128;
            for (int i = lane; i < NMOD * 128; i += 64) { const int r = i >> 7, kk = i & 127; const float v = (r < 8) ? cvec[r * DM + k0 + kk] : cctx[k0 + kk]; scr[i] = silu_f(v); }
            LDS_WAIT(); asm volatile("" ::: "memory");
            f32x4 acc[NMOD];
#pragma unroll
            for (int r = 0; r < NMOD; ++r) acc[r] = (f32x4){0.f, 0.f, 0.f, 0.f};
            const float* wp = wada + (size_t)k0 * 24576 + cg * 256 + lane * 4;
#pragma unroll 4
            for (int kk = 0; kk < 128; ++kk) { const f32x4 w = *(const f32x4*)(wp + (size_t)kk * 24576);
#pragma unroll
                for (int r = 0; r < NMOD; ++r) acc[r] += w * scr[r * 128 + kk]; }
#pragma unroll
            for (int r = 0; r < NMOD; ++r) *(f32x4*)(modp + ((size_t)ks * NMOD + r) * 24576 + cg * 256 + lane * 4) = acc[r];
            LDS_WAIT(); asm volatile("" ::: "memory");
        }
    }
    {
        constexpr int I_IN = (DM / 64) * (INC / 32), I_QUP = (QRANK / 64) * (3072 / 32), I_KVUP = (KVRANK / 64) * (4096 / 32), I_OUT = (DM / 64) * (DM / 32), I_UP = (DM / 64) * (22016 / 32), I_DOWN = (DFF / 64) * (DM / 32);
        constexpr int NITEMS = I_IN + I_QUP + I_KVUP + I_OUT + I_UP + I_DOWN;
        for (int it = gw; it < NITEMS; it += NGW) {
            int r = it;
            if (r < I_IN) { const int n0 = 32 * (r % (INC / 32));
                if (n0 < 1024) p0_transpose_item_fp8(a.in[12], DM, INC, (unsigned char*)(ws + WS_WINQ), scr, r, lane, 0);
                else if (n0 < 1536) p0_transpose_item(a.in[12], DM, INC, (bf16*)(ws + WS_WIN), MapShift{ZKV - 1024}, scr, r, lane);
                else if (n0 < 1600) p0_transpose_item(a.in[12], DM, INC, (bf16*)(ws + WS_WIN), MapShift{ZPE - 1536}, scr, r, lane);
                else if (n0 < 3648) p0_transpose_item_fp8(a.in[12], DM, INC, (unsigned char*)(ws + WS_WINQ), scr, r, lane, ZGQ - 1600);
                else if (n0 < 4160) p0_transpose_item(a.in[12], DM, INC, (bf16*)(ws + WS_WIN), MapShift{ZGK - 3648}, scr, r, lane);
                else p0_transpose_item(a.in[12], DM, INC, (bf16*)(ws + WS_WIN), MapShift{ZGV - 4160}, scr, r, lane);
                continue; } r -= I_IN;
            if (r < I_QUP) { if (W_TAIL3 && QUP_FP8 && !QUP_I8 && MIX_FP8) continue; if (QUP_I8) p0_transpose_item_i8(a.in[14], QRANK, 3072, (signed char*)(ws + WS_WQUP), MapId(), nullptr, nullptr, scr, r, lane); else if (QUP_FP8) p0_transpose_item_fp8(a.in[14], QRANK, 3072, (unsigned char*)(ws + WS_WQUP), scr, r, lane); else p0_transpose_item(a.in[14], QRANK, 3072, (bf16*)(ws + WS_WQUP), MapId(), scr, r, lane); continue; } r -= I_QUP;
            if (r < I_KVUP) { if (KVUP_I8) p0_colmax_item(a.in[16], 4096, (unsigned*)(ws + WS_KVCOLMAX), r, lane); else if (KVUP_FP8) p0_transpose_item_fp8(a.in[16], KVRANK, 4096, (unsigned char*)(ws + WS_WKVUP), scr, r, lane); else p0_transpose_item(a.in[16], KVRANK, 4096, (bf16*)(ws + WS_WKVUP), MapId(), scr, r, lane); continue; } r -= I_KVUP;
            if (r < I_OUT) { if (W_TAIL3 && QUP_FP8 && !QUP_I8 && MIX_FP8) continue; if (MIX_FP8) p0_transpose_item_fp8(a.in[22], DM, DM, (unsigned char*)(ws + WS_WOUT), scr, r, lane); else p0_transpose_item(a.in[22], DM, DM, (bf16*)(ws + WS_WOUT), MapId(), scr, r, lane); continue; } r -= I_OUT;
#if defined(PROBE_UPF8W)
            if (r < I_UP) { p0_transpose_item_fp8m(a.in[23], DM, 22016, (unsigned char*)(ws + WS_WUP), MapUp(), scr, r, lane); continue; }
#endif
#if defined(PROBE_P0CONV)
            if (r < I_UP) { p0_transpose_item_i8(a.in[23], DM, 22016, (signed char*)(ws + WS_WUP), MapUp(), nullptr, (float*)(ws + WS_COLSC), scr, r, lane, 0.085f); continue; }
#endif
            if (r < I_UP) { if (UP_I8 && UP_SUBSTAT) { if (r < 8 * (22016 / 32)) p0_colss_item(a.in[23], 22016, (unsigned long long*)(ws + WS_COLMAX), r, lane); } else if (UP_I8) p0_colmax_item(a.in[23], 22016, (unsigned*)(ws + WS_COLMAX), r, lane); else p0_transpose_item(a.in[23], DM, 22016, (bf16*)(ws + WS_WUP), MapUp(), scr, r, lane); continue; } r -= I_UP;
            if (FFN_SORT) continue;
            { const int k0 = 64 * (r / (DM / 32));
              if (k0 < GK8) p0_transpose_item_fp8(a.in[26], GPB, DM, (unsigned char*)(ws + WS_WDOWN), scr, r, lane, 0);
              else p0_transpose_item(a.in[26], GPB / 2, DM, (bf16*)(ws + WS_WDOWN) - GK8 / 2, MapId(), scr, r, lane); }
        }
        v4u* pz = (v4u*)((bf16*)(ws + WS_WIN) + (size_t)1600 * DM); const size_t nz = (size_t)(ZBW - 1600) * DM * 2 / 16;
        for (size_t i = (size_t)vcu * NTHREADS + tid; i < nz; i += (size_t)G * NTHREADS) pz[i] = (v4u){0u, 0u, 0u, 0u};
    }
}
__device__ __forceinline__ void phase1(const Args& a, LAS unsigned char* lds, int vcu, int G) {
    const int tid = threadIdx.x; unsigned char* ws = a.ws;
#if defined(PROBE_P0CONV)
    if (false) {
#else
    if (UP_I8 && !(UP_TAIL && FFN_SORT)) {
#endif
        const int lane = tid & 63, wave = __builtin_amdgcn_readfirstlane(tid >> 6); LAS float* scr = (LAS float*)(lds + RING_OFF + wave * 16384);
        for (int it = vcu * NWAVES + wave; it < (DM / 64) * (22016 / 32); it += G * NWAVES)
#if defined(PROBE_FIXEDCOL)
            p0_transpose_item_i8(a.in[23], DM, 22016, (signed char*)(ws + WS_WUP), MapUp(), nullptr, (float*)(ws + WS_COLSC), scr, it, lane, 0.085f);
#else
            if (FFN_SORT) p0_transpose_item_i8(a.in[23], DM, 22016, (signed char*)(ws + WS_WUP), MapUpPerm{(const unsigned*)(ws + WS_RANK)}, (const unsigned*)(ws + WS_COLMAX), (float*)(ws + WS_COLSC), scr, it, lane);
            else p0_transpose_item_i8(a.in[23], DM, 22016, (signed char*)(ws + WS_WUP), MapUp(), (const unsigned*)(ws + WS_COLMAX), (float*)(ws + WS_COLSC), scr, it, lane);
#endif
    }
    if (KVUP_I8) {
        const int lane = tid & 63, wave = __builtin_amdgcn_readfirstlane(tid >> 6); LAS float* scr = (LAS float*)(lds + RING_OFF + wave * 16384);
        for (int it = vcu * NWAVES + wave; it < (KVRANK / 64) * (4096 / 32); it += G * NWAVES)
            p0_transpose_item_i8<MapId, true>(a.in[16], KVRANK, 4096, (signed char*)(ws + WS_WKVUP), MapId(), (const unsigned*)(ws + WS_KVCOLMAX), (float*)(ws + WS_KVCS), scr, it, lane);
    }
    if (FFN_SORT) {
        const int lane = tid & 63, wave = __builtin_amdgcn_readfirstlane(tid >> 6); LAS float* scr = (LAS float*)(lds + RING_OFF + wave * 16384); const unsigned* sigma = (const unsigned*)(ws + WS_SIGMA);
        if (!DOWN_TAIL)
        for (int it = vcu * NWAVES + wave; it < (DFF / 64) * (DM / 32); it += G * NWAVES) { const int k0 = 64 * (it / (DM / 32));
            if (k0 < GK8) p0_transpose_item_fp8(a.in[26], GPB, DM, (unsigned char*)(ws + WS_WDOWN), scr, it, lane, 0, sigma);
            else p0_transpose_item(a.in[26], GPB / 2, DM, (bf16*)(ws + WS_WDOWN) - GK8 / 2, MapId(), scr, it, lane, sigma); }
        const float* cw = a.in[24]; const float* cb = a.in[25]; float* cwp = (float*)(ws + WS_CWP); float* cbp = (float*)(ws + WS_CBP);
        for (int i = vcu * NTHREADS + tid; i < 2 * DFF; i += G * NTHREADS) { const int v = i >= DFF, pp = i - v * DFF; const int src = v * DFF + (int)sigma[pp];
            const float f = !TAP_FOLD ? 1.0f : (v ? (-0.6931471805599453f) * (pp < GK8 ? SG8 : 1.0f) : -1.4426950408889634f);
            cwp[i] = cw[src] * f; cwp[22016 + i] = cw[22016 + src] * f; cwp[2 * 22016 + i] = cw[2 * 22016 + src] * f; cbp[i] = cb[src] * f; }
    }
    const float* modp = (const float*)(ws + WS_MODP); float* mod = (float*)(ws + WS_MOD); const float* bada = a.in[11];
    for (int i = vcu * NTHREADS + tid; i < NMOD * 24576; i += G * NTHREADS) { const int n = i % 24576; float s = bada[n];
#pragma unroll 8
        for (int ks = 0; ks < KSPLIT; ++ks) s += modp[(size_t)ks * NMOD * 24576 + i];
        mod[i] = s; }
    const int gi = vcu * NTHREADS + tid;
    if (gi < 64 * 16 + 64 * 32) {
        const bool t32 = gi >= 64 * 16; const int idx = t32 ? gi - 64 * 16 : gi; const int half = t32 ? 32 : 16; const int pos = idx / half, j = idx % half;
        const double step = t32 ? 0.74989420933245582730 : 0.56234132519034908039;
        double inv = 1.0; for (int q = 0; q < j; ++q) inv *= step;
        double ang = (double)pos * (double)(float)inv;
        const double twopi = 6.283185307179586476925286766559;
        const double kq = __builtin_rint(ang / twopi); double x = ang - kq * twopi; const double x2 = x * x;
        double sn = x, cs = 1.0, ts = x, tc = 1.0;
        for (int q = 1; q <= 14; ++q) { tc = -tc * x2 / (double)((2 * q - 1) * (2 * q)); cs += tc; ts = -ts * x2 / (double)((2 * q) * (2 * q + 1)); sn += ts; }
        float* tab = (float*)(ws + (t32 ? WS_ROPE32 : WS_ROPE16));
        tab[(size_t)idx * 2] = (float)cs; tab[(size_t)idx * 2 + 1] = (float)sn;
    }
}
template <bool XB>
__device__ __forceinline__ void phase_norm(const void* xp, const void* xs, const float* g, const float* mod, int off_shift, int off_scale, bf16* out, unsigned char* out8, float* rowscale, LAS unsigned char* lds, int vcu, int G) {
    const int tid = threadIdx.x, lane = tid & 63, wave = tid >> 6;
    LAS float* Av = (LAS float*)(lds + RING_OFF); LAS float* Bv = Av + DM;
    const int ntask = MTOK / 16, per = (ntask + G - 1) / G; int cur_mr = -1;
    for (int k = 0; k < per; ++k) { const int task = vcu * per + k; if (task >= ntask) break;
        const int t0 = task * 16; const int mr = t0 < TP ? 8 : ((t0 - TP) >> 12);
        if (mr != cur_mr) { __syncthreads();
            for (int c = tid; c < DM; c += NTHREADS) { Av[c] = g[c] * (1.0f + mod[(size_t)mr * 24576 + off_scale + c]); Bv[c] = mod[(size_t)mr * 24576 + off_shift + c]; }
            __syncthreads(); cur_mr = mr; }
#pragma unroll 1
        for (int i = 0; i < 2; ++i) { const int t = t0 + wave * 2 + i;
            f32x4 v[16]; float ss = 0.f;
            if constexpr (XB) { const bf16* xr = (const bf16*)xp + (size_t)t * DM;
#pragma unroll
                for (int q = 0; q < 8; ++q) { const v4u w = *(const v4u*)(xr + lane * 8 + 512 * q); v[2 * q] = (f32x4){bflo(w.x), bfhi(w.x), bflo(w.y), bfhi(w.y)}; v[2 * q + 1] = (f32x4){bflo(w.z), bfhi(w.z), bflo(w.w), bfhi(w.w)}; }
            } else { const float* xr = (t < TP) ? (const float*)xp + (size_t)t * DM : (const float*)xs + (size_t)(t - TP) * DM;
#pragma unroll
                for (int j = 0; j < 16; ++j) v[j] = *(const f32x4*)(xr + lane * 8 + 512 * (j >> 1) + 4 * (j & 1));
            }
#pragma unroll
            for (int j = 0; j < 16; ++j) ss += (v[j].x * v[j].x + v[j].y * v[j].y) + (v[j].z * v[j].z + v[j].w * v[j].w);
            const float r = 1.0f / sqrtf(wave_sum(ss) * (1.0f / DM) + EPS);
            if (rowscale) {
                float mx = 0.f;
#pragma unroll
                for (int j = 0; j < 16; ++j) { const int c = lane * 8 + 512 * (j >> 1) + 4 * (j & 1); const f32x4 av = *(const LAS f32x4*)(Av + c), bv = *(const LAS f32x4*)(Bv + c);
                    v[j] = (v[j] * r) * av + bv; mx = fmaxf(fmaxf(mx, fmaxf(fabsf(v[j].x), fabsf(v[j].y))), fmaxf(fabsf(v[j].z), fabsf(v[j].w)));
                    if ((j & 3) == 3) asm volatile("" ::: "memory"); }
#pragma unroll
                for (int o = 1; o < 64; o <<= 1) mx = fmaxf(mx, __shfl_xor(mx, o));
                const float inv = mx > 0.f ? 127.0f / mx : 0.f;
                if (lane == 0) rowscale[t] = mx * (1.0f / 127.0f);
#pragma unroll
                for (int q = 0; q < 8; ++q) { v2u o;
#define PN_Q8(vv) (((unsigned)(int)__builtin_rintf((vv).x * inv) & 0xffu) | (((unsigned)(int)__builtin_rintf((vv).y * inv) & 0xffu) << 8) | (((unsigned)(int)__builtin_rintf((vv).z * inv) & 0xffu) << 16) | (((unsigned)(int)__builtin_rintf((vv).w * inv)) << 24))
                    o.x = PN_Q8(v[2 * q]); o.y = PN_Q8(v[2 * q + 1]);
#undef PN_Q8
                    *(v2u*)(out8 + (size_t)t * DM + lane * 8 + 512 * q) = o; }
            } else {
            bf16* orow = out + (size_t)t * DM;
#pragma unroll
            for (int q = 0; q < 8; ++q) { const int c = lane * 8 + 512 * q;
                const f32x4 a0 = *(const LAS f32x4*)(Av + c), b0 = *(const LAS f32x4*)(Bv + c), a1 = *(const LAS f32x4*)(Av + c + 4), b1 = *(const LAS f32x4*)(Bv + c + 4);
                const f32x4 y0 = (v[2 * q] * r) * a0 + b0, y1 = (v[2 * q + 1] * r) * a1 + b1;
                v4u w; w.x = pk2(y0.x, y0.y); w.y = pk2(y0.z, y0.w); w.z = pk2(y1.x, y1.y); w.w = pk2(y1.z, y1.w); *(v4u*)(orow + c) = w;
                if (out8) { v2u o8; int tt = 0; tt = cvt_pk_fp8_sat(y0.x * 16.f, y0.y * 16.f, tt, false); tt = cvt_pk_fp8_sat(y0.z * 16.f, y0.w * 16.f, tt, true); o8.x = (unsigned)tt;
                    tt = 0; tt = cvt_pk_fp8_sat(y1.x * 16.f, y1.y * 16.f, tt, false); tt = cvt_pk_fp8_sat(y1.z * 16.f, y1.w * 16.f, tt, true); o8.y = (unsigned)tt;
                    *(v2u*)(out8 + (size_t)t * DM + c) = o8; }
                if (q & 1) asm volatile("" ::: "memory"); }
            }
        }
    }
    __syncthreads();
}
template <int CTRL> __device__ __forceinline__ float dppx(float v) { return __builtin_bit_cast(float, __builtin_amdgcn_update_dpp(0, __builtin_bit_cast(int, v), CTRL, 0xf, 0xf, true)); }
__device__ __forceinline__ float row16_sum(float v) { v += dppx<0xB1>(v); v += dppx<0x4E>(v); v += dppx<0x141>(v); v += dppx<0x140>(v); return v; }
__device__ __forceinline__ float wave_sum_rl(float v) { v = row16_sum(v); const int b = __builtin_bit_cast(int, v);
    return (__builtin_bit_cast(float, __builtin_amdgcn_readlane(b, 0)) + __builtin_bit_cast(float, __builtin_amdgcn_readlane(b, 16))) + (__builtin_bit_cast(float, __builtin_amdgcn_readlane(b, 32)) + __builtin_bit_cast(float, __builtin_amdgcn_readlane(b, 48))); }
__device__ __forceinline__ float wave_max_rl(float v) { v = fmaxf(v, dppx<0xB1>(v)); v = fmaxf(v, dppx<0x4E>(v)); v = fmaxf(v, dppx<0x141>(v)); v = fmaxf(v, dppx<0x140>(v)); const int b = __builtin_bit_cast(int, v);
    return fmaxf(fmaxf(__builtin_bit_cast(float, __builtin_amdgcn_readlane(b, 0)), __builtin_bit_cast(float, __builtin_amdgcn_readlane(b, 16))), fmaxf(__builtin_bit_cast(float, __builtin_amdgcn_readlane(b, 32)), __builtin_bit_cast(float, __builtin_amdgcn_readlane(b, 48)))); }
__device__ __forceinline__ void store_row_i8(const float (&x)[8], unsigned char* dst, float* scale, int lane) {
    float mx = 0.f;
#pragma unroll
    for (int e = 0; e < 8; ++e) mx = fmaxf(mx, fabsf(x[e]));
    mx = wave_max_rl(mx); const float inv = mx > 0.f ? 127.0f / mx : 0.f; unsigned q[8];
#pragma unroll
    for (int e = 0; e < 8; ++e) q[e] = (unsigned)(int)__builtin_rintf(__builtin_amdgcn_fmed3f(x[e] * inv, -127.f, 127.f)) & 0xffu;
    v2u w; w.x = q[0] | (q[1] << 8) | (q[2] << 16) | (q[3] << 24); w.y = q[4] | (q[5] << 8) | (q[6] << 16) | (q[7] << 24);
    *(v2u*)(dst + lane * 8) = w; if (lane == 0) *scale = mx * (1.0f / 127.0f);
}
__device__ __forceinline__ v2u pack8_fp8s(const float (&x)[8], const float sc) { v2u w; int tt = 0; tt = cvt_pk_fp8_sat(x[0] * sc, x[1] * sc, tt, false); tt = cvt_pk_fp8_sat(x[2] * sc, x[3] * sc, tt, true); w.x = (unsigned)tt;
    tt = 0; tt = cvt_pk_fp8_sat(x[4] * sc, x[5] * sc, tt, false); tt = cvt_pk_fp8_sat(x[6] * sc, x[7] * sc, tt, true); w.y = (unsigned)tt; return w; }
__device__ __forceinline__ v2u pack8_fp8x16(const float (&x)[8]) { v2u w; int tt = 0; tt = cvt_pk_fp8_sat(x[0] * 16.f, x[1] * 16.f, tt, false); tt = cvt_pk_fp8_sat(x[2] * 16.f, x[3] * 16.f, tt, true); w.x = (unsigned)tt;
    tt = 0; tt = cvt_pk_fp8_sat(x[4] * 16.f, x[5] * 16.f, tt, false); tt = cvt_pk_fp8_sat(x[6] * 16.f, x[7] * 16.f, tt, true); w.y = (unsigned)tt; return w; }
__device__ __forceinline__ void phase4(const Args& a, int vcu, int G) {
    const int tid = threadIdx.x, lane = tid & 63, wave = tid >> 6; unsigned char* ws = a.ws;
    const bf16* Zq = (const bf16*)(ws + WS_Z); const bf16* Zb = (const bf16*)(ws + WS_ZB); bf16* QN = (bf16*)(ws + WS_QN); bf16* CKV = (bf16*)(ws + WS_CKV); bf16* KPE = (bf16*)(ws + WS_KPE);
    bf16* GQ = (bf16*)(ws + WS_GQ); bf16* GK = (bf16*)(ws + WS_GK); bf16* GV = (bf16*)(ws + WS_GV); unsigned char* GK8 = (unsigned char*)(ws + WS_GK);
    const float* T32 = (const float*)(ws + WS_ROPE32);
    const float* g_q_lat = a.in[13]; const float* g_kv_lat = a.in[15]; const float* g_gq = a.in[19]; const float* g_gk = a.in[20];
    float* out = a.out;
    const int gw = vcu * NWAVES + wave, NGW = G * NWAVES;
    const int hq = lane & 15;
    const f32x4 gqa = *(const f32x4*)(g_q_lat + lane * 8), gqb = *(const f32x4*)(g_q_lat + lane * 8 + 4), gqc = *(const f32x4*)(g_q_lat + 512 + lane * 8), gqd = *(const f32x4*)(g_q_lat + 512 + lane * 8 + 4);
    const f32x4 gka = *(const f32x4*)(g_kv_lat + lane * 8), gkb = *(const f32x4*)(g_kv_lat + lane * 8 + 4);
    const float* T16 = (const float*)(ws + WS_ROPE16); const float* g_mk = a.in[18];
    f32x4 gpa = (f32x4){0.f, 0.f, 0.f, 0.f}, gpb = gpa; if (lane < 8) { gpa = *(const f32x4*)(g_mk + 128 + lane * 8); gpb = *(const f32x4*)(g_mk + 128 + lane * 8 + 4); }
    const f32x4 ggqa = *(const f32x4*)(g_gq + hq * 8), ggqb = *(const f32x4*)(g_gq + hq * 8 + 4), ggka = *(const f32x4*)(g_gk + hq * 8), ggkb = *(const f32x4*)(g_gk + hq * 8 + 4);
    for (int t = gw; t < MTOK + NLAT * PAST; t += NGW) {
        if (t >= MTOK) {
            const int u = t - MTOK, b = u >> 8, s = u & 255; const size_t kr = (size_t)TP + (size_t)b * (PAST + LSEQ) + s;
            { const float* src = a.in[2] + (size_t)u * KVRANK + lane * 8; const f32x4 x0 = *(const f32x4*)src, x1 = *(const f32x4*)(src + 4);
              if (KVUP_I8) { const float xx[8] = {x0.x, x0.y, x0.z, x0.w, x1.x, x1.y, x1.z, x1.w}; store_row_i8(xx, (unsigned char*)CKV + kr * KVRANK, (float*)(ws + WS_CKVS) + kr, lane); }
              else if (KVUP_FP8) { const float xx[8] = {x0.x, x0.y, x0.z, x0.w, x1.x, x1.y, x1.z, x1.w}; *(v2u*)((unsigned char*)CKV + kr * KVRANK + lane * 8) = pack8_fp8x16(xx); }
              else { v4u w; w.x = pk2(x0.x, x0.y); w.y = pk2(x0.z, x0.w); w.z = pk2(x1.x, x1.y); w.w = pk2(x1.z, x1.w); *(v4u*)(CKV + kr * KVRANK + lane * 8) = w; } }
            if (KV_FUSE) { f32x4 x0 = (f32x4){0.f, 0.f, 0.f, 0.f}, x1 = x0; if (lane < 8) { const float* src = a.in[3] + (size_t)u * ROPED + lane * 8; x0 = *(const f32x4*)src; x1 = *(const f32x4*)(src + 4); }
              float ss = (x0.x * x0.x + x0.y * x0.y) + (x0.z * x0.z + x0.w * x0.w) + (x1.x * x1.x + x1.y * x1.y) + (x1.z * x1.z + x1.w * x1.w);
              ss = row16_sum(ss); if (lane == 0) ((float*)(ws + WS_KPESS))[kr] = ss;
              x0 *= gpa; x1 *= gpb;
              if (lane < 8) { v4u w; w.x = pk2(x0.x, x0.y); w.y = pk2(x0.z, x0.w); w.z = pk2(x1.x, x1.y); w.w = pk2(x1.z, x1.w); *(v4u*)(KPE + kr * ROPED + lane * 8) = w; } }
            else if (lane < 8) { const float* src = a.in[3] + (size_t)u * ROPED + lane * 8; const f32x4 x0 = *(const f32x4*)src, x1 = *(const f32x4*)(src + 4);
              v4u w; w.x = pk2(x0.x, x0.y); w.y = pk2(x0.z, x0.w); w.z = pk2(x1.x, x1.y); w.w = pk2(x1.z, x1.w); *(v4u*)(KPE + kr * ROPED + lane * 8) = w; }
            { const float* src = a.in[4] + (size_t)u * 512 + lane * 8; const f32x4 x0 = *(const f32x4*)src, x1 = *(const f32x4*)(src + 4);
              if (ATT_KF8) { const float xx[8] = {x0.x, x0.y, x0.z, x0.w, x1.x, x1.y, x1.z, x1.w}; *(v2u*)(GK8 + kr * 512 + lane * 8) = pack8_fp8s(xx, ATT_KS8); }
              else { v4u w; w.x = pk2(x0.x, x0.y); w.y = pk2(x0.z, x0.w); w.z = pk2(x1.x, x1.y); w.w = pk2(x1.z, x1.w); *(v4u*)(GK + kr * 512 + lane * 8) = w; } }
            { const float* src = a.in[5] + (size_t)u * 512 + lane * 8; const f32x4 x0 = *(const f32x4*)src, x1 = *(const f32x4*)(src + 4);
              v4u w; w.x = pk2(x0.x, x0.y); w.y = pk2(x0.z, x0.w); w.z = pk2(x1.x, x1.y); w.w = pk2(x1.z, x1.w); *(v4u*)(GV + kr * 512 + lane * 8) = w; }
            continue;
        }
        const bool prompt = t < TP; const size_t kr = (size_t)kvrow_of(t);
        const int spos = prompt ? 0 : ((t - TP) & 4095); const int prow = spos >> 6, pcol = spos & 63;
        const bf16* zq = Zq + (size_t)t * ZQW; const bf16* z = Zb + (size_t)t * ZBW;
        const v4u wq0 = *(const v4u*)(zq + ZQ + lane * 8), wq1 = *(const v4u*)(zq + ZQ + 512 + lane * 8);
        const v4u wkv = *(const v4u*)(z + ZKV + lane * 8), wgk = *(const v4u*)(z + ZGK + lane * 8), wgv = *(const v4u*)(z + ZGV + lane * 8);
        v4u wpe = (v4u){0u, 0u, 0u, 0u}; if (lane < 8) wpe = *(const v4u*)(z + ZPE + lane * 8);
        v4u wgq[4];
#pragma unroll
        for (int it = 0; it < 4; ++it) wgq[it] = *(const v4u*)(zq + ZGQ + it * 512 + lane * 8);
        float rc[8], rs[8];
        if (!prompt) { const int pos = (hq < 8) ? prow : pcol; const float* tp = T32 + (size_t)(pos * 32 + (hq & 3) * 8) * 2;
#pragma unroll
          for (int q = 0; q < 4; ++q) { const f32x4 cs = *(const f32x4*)(tp + 4 * q); rc[2 * q] = cs[0]; rc[2 * q + 1] = cs[2]; rs[2 * q] = (hq & 4) ? cs[1] : -cs[1]; rs[2 * q + 1] = (hq & 4) ? cs[3] : -cs[3]; } }
        { float x0[8], x1[8]; unpack8(wq0, x0); unpack8(wq1, x1); float ss = 0.f;
#pragma unroll
          for (int e = 0; e < 8; ++e) ss += x0[e] * x0[e] + x1[e] * x1[e];
          const float r = 1.0f / sqrtf(wave_sum_rl(ss) * (1.0f / QRANK) + EPS);
#pragma unroll
          for (int e = 0; e < 8; ++e) { x0[e] = x0[e] * r * (e < 4 ? gqa[e] : gqb[e - 4]); x1[e] = x1[e] * r * (e < 4 ? gqc[e] : gqd[e - 4]); }
          if (QUP_I8) { unsigned char* q8 = (unsigned char*)QN + (size_t)t * QRANK; v2u w0, w1;
#define Q8(x) ((unsigned)(int)__builtin_rintf(__builtin_amdgcn_fmed3f((x) * 16.f, -127.f, 127.f)) & 0xffu)
            w0.x = Q8(x0[0]) | (Q8(x0[1]) << 8) | (Q8(x0[2]) << 16) | (Q8(x0[3]) << 24); w0.y = Q8(x0[4]) | (Q8(x0[5]) << 8) | (Q8(x0[6]) << 16) | (Q8(x0[7]) << 24);
            w1.x = Q8(x1[0]) | (Q8(x1[1]) << 8) | (Q8(x1[2]) << 16) | (Q8(x1[3]) << 24); w1.y = Q8(x1[4]) | (Q8(x1[5]) << 8) | (Q8(x1[6]) << 16) | (Q8(x1[7]) << 24);
#undef Q8
            *(v2u*)(q8 + lane * 8) = w0; *(v2u*)(q8 + 512 + lane * 8) = w1; }
          else if (QUP_FP8) { unsigned char* q8 = (unsigned char*)QN + (size_t)t * QRANK; *(v2u*)(q8 + lane * 8) = pack8_fp8x16(x0); *(v2u*)(q8 + 512 + lane * 8) = pack8_fp8x16(x1); }
          else { *(v4u*)(QN + (size_t)t * QRANK + lane * 8) = pack8(x0); *(v4u*)(QN + (size_t)t * QRANK + 512 + lane * 8) = pack8(x1); } }
        { float x[8]; unpack8(wkv, x); float ss = 0.f;
#pragma unroll
          for (int e = 0; e < 8; ++e) ss += x[e] * x[e];
          const float r = 1.0f / sqrtf(wave_sum_rl(ss) * (1.0f / KVRANK) + EPS);
#pragma unroll
          for (int e = 0; e < 8; ++e) x[e] = x[e] * r * (e < 4 ? gka[e] : gkb[e - 4]);
          if (KVUP_I8) store_row_i8(x, (unsigned char*)CKV + kr * KVRANK, (float*)(ws + WS_CKVS) + kr, lane);
          else if (KVUP_FP8) *(v2u*)((unsigned char*)CKV + kr * KVRANK + lane * 8) = pack8_fp8x16(x); else *(v4u*)(CKV + kr * KVRANK + lane * 8) = pack8(x);
          if (prompt) { float* o = out + OUT_CKV + (size_t)t * KVRANK + lane * 8; *(f32x4*)o = (f32x4){x[0], x[1], x[2], x[3]}; *(f32x4*)(o + 4) = (f32x4){x[4], x[5], x[6], x[7]}; } }
        if (KV_FUSE) { float x[8]; unpack8(wpe, x);
          if (prompt && lane < 8) { float* o = out + OUT_KPE + (size_t)t * ROPED + lane * 8; *(f32x4*)o = (f32x4){x[0], x[1], x[2], x[3]}; *(f32x4*)(o + 4) = (f32x4){x[4], x[5], x[6], x[7]}; }
          float ss = 0.f;
#pragma unroll
          for (int e = 0; e < 8; ++e) ss += x[e] * x[e];
          ss = row16_sum(ss); if (lane == 0) ((float*)(ws + WS_KPESS))[kr] = ss;
#pragma unroll
          for (int e = 0; e < 8; ++e) x[e] *= (e < 4 ? gpa[e] : gpb[e - 4]);
          if (!prompt) { const int pos = (lane & 4) ? pcol : prow; const float* tp = T16 + (size_t)(pos * 16 + 8 * (lane & 1)) * 2;
#pragma unroll
            for (int q = 0; q < 4; ++q) { const f32x4 cs = *(const f32x4*)(tp + 4 * q);
#pragma unroll
              for (int h2 = 0; h2 < 2; ++h2) { const int e = 2 * q + h2; const float pa = dppx<0x112>(x[e]), pb = dppx<0x102>(x[e]); const float pr = (lane & 2) ? pa : pb;
                x[e] = x[e] * cs[2 * h2] + ((lane & 2) ? pr : -pr) * cs[2 * h2 + 1]; } } }
          if (lane < 8) *(v4u*)(KPE + kr * ROPED + lane * 8) = pack8(x); }
        else if (lane < 8) { *(v4u*)(KPE + kr * ROPED + lane * 8) = wpe;
          if (prompt) { float x[8]; unpack8(wpe, x); float* o = out + OUT_KPE + (size_t)t * ROPED + lane * 8; *(f32x4*)o = (f32x4){x[0], x[1], x[2], x[3]}; *(f32x4*)(o + 4) = (f32x4){x[4], x[5], x[6], x[7]}; } }
#pragma unroll
        for (int it = 0; it < 4; ++it) { float x[8]; unpack8(wgq[it], x); float ss = 0.f;
#pragma unroll
            for (int e = 0; e < 8; ++e) ss += x[e] * x[e];
            const float r = 1.0f / sqrtf(row16_sum(ss) * (1.0f / GHD) + EPS);
#pragma unroll
            for (int e = 0; e < 8; ++e) x[e] = x[e] * r * (e < 4 ? ggqa[e] : ggqb[e - 4]);
            if (!prompt) {
#pragma unroll
              for (int e = 0; e < 8; ++e) { const float pa = dppx<0x114>(x[e]), pb = dppx<0x104>(x[e]); const float p = (hq & 4) ? pa : pb;     x[e] = x[e] * rc[e] + p * rs[e]; } }
            if (GQ_FP8 && ATT_KF8) *(v2u*)((unsigned char*)GQ + (size_t)t * 2048 + it * 512 + lane * 8) = pack8_fp8s(x, att::q8_scale<128>());
            else *(v4u*)(GQ + (size_t)t * 2048 + it * 512 + lane * 8) = pack8(x); }
        { float x[8]; unpack8(wgk, x); float ss = 0.f;
#pragma unroll
          for (int e = 0; e < 8; ++e) ss += x[e] * x[e];
          const float r = 1.0f / sqrtf(row16_sum(ss) * (1.0f / GHD) + EPS);
#pragma unroll
          for (int e = 0; e < 8; ++e) x[e] = x[e] * r * (e < 4 ? ggka[e] : ggkb[e - 4]);
          if (prompt) { float* o = out + OUT_GK + (size_t)t * 512 + lane * 8; *(f32x4*)o = (f32x4){x[0], x[1], x[2], x[3]}; *(f32x4*)(o + 4) = (f32x4){x[4], x[5], x[6], x[7]}; }
          else {
#pragma unroll
            for (int e = 0; e < 8; ++e) { const float pa = dppx<0x114>(x[e]), pb = dppx<0x104>(x[e]); const float p = (hq & 4) ? pa : pb;     x[e] = x[e] * rc[e] + p * rs[e]; } }
          if (ATT_KF8) *(v2u*)(GK8 + kr * 512 + lane * 8) = pack8_fp8s(x, ATT_KS8);
          else *(v4u*)(GK + kr * 512 + lane * 8) = pack8(x); }
        { *(v4u*)(GV + kr * 512 + lane * 8) = wgv;
          if (prompt) { float x[8]; unpack8(wgv, x); float* o = out + OUT_GV + (size_t)t * 512 + lane * 8; *(f32x4*)o = (f32x4){x[0], x[1], x[2], x[3]}; *(f32x4*)(o + 4) = (f32x4){x[4], x[5], x[6], x[7]}; } }
    }
}
__device__ __forceinline__ void phase6(const Args& a, LAS unsigned char* lds, int vcu, int G) {
    const int tid = threadIdx.x, lane = tid & 63, wave = tid >> 6; unsigned char* ws = a.ws;
    bf16* KB = (bf16*)(ws + WS_KB); const bf16* KPE = (const bf16*)(ws + WS_KPE); const float* T16 = (const float*)(ws + WS_ROPE16); const float* gk = a.in[18];
    const int gw = vcu * NWAVES + wave, NGW = G * NWAVES; const int h = lane >> 2, q = lane & 3;
    float gn[32], gp[16];
#pragma unroll
    for (int e = 0; e < 32; ++e) gn[e] = gk[32 * q + e];
#pragma unroll
    for (int e = 0; e < 16; ++e) gp[e] = gk[128 + 16 * q + e];
    for (int kr = gw; kr < KVROWS; kr += NGW) {
        bool lat = false; int spos = 0;
        if (kr >= TP) { const int u = (kr - TP) % (PAST + LSEQ); if (u >= PAST) { lat = true; spos = u - PAST; } }
        bf16* kp = KB + ((size_t)kr * 16 + h) * 192; const bf16* pp = KPE + (size_t)kr * ROPED + 16 * q;
        f32x4 tq[8];
        if (lat) { const int pos = (q < 2) ? (spos >> 6) : (spos & 63); const float* tp = T16 + (size_t)pos * 32;
#pragma unroll
            for (int i = 0; i < 8; ++i) tq[i] = *(const f32x4*)(tp + 4 * i); }
        float xn[32], xp[16];
#pragma unroll
        for (int i = 0; i < 4; ++i) { float t8[8]; unpack8(*(const v4u*)(kp + 32 * q + 8 * i), t8);
#pragma unroll
            for (int e = 0; e < 8; ++e) xn[8 * i + e] = t8[e]; }
#pragma unroll
        for (int i = 0; i < 2; ++i) { float t8[8]; unpack8(*(const v4u*)(pp + 8 * i), t8);
#pragma unroll
            for (int e = 0; e < 8; ++e) xp[8 * i + e] = t8[e]; }
        float ss = 0.f;
#pragma unroll
        for (int e = 0; e < 32; ++e) ss += xn[e] * xn[e];
#pragma unroll
        for (int e = 0; e < 16; ++e) ss += xp[e] * xp[e];
        ss += dppx<0xB1>(ss); ss += dppx<0x4E>(ss);
        const float r = 1.0f / sqrtf(ss * (1.0f / MLAQK) + EPS);
#pragma unroll
        for (int e = 0; e < 32; ++e) xn[e] = xn[e] * r * gn[e];
#pragma unroll
        for (int e = 0; e < 16; ++e) xp[e] = xp[e] * r * gp[e];
        if (lat) {
#pragma unroll
            for (int e = 0; e < 16; ++e) { const float p = dppx<0xB1>(xp[e]); const float cs = tq[e >> 1][2 * (e & 1)], sn = tq[e >> 1][2 * (e & 1) + 1]; xp[e] = xp[e] * cs + ((q & 1) ? p : -p) * sn; } }
        if (ATT_KF8) { unsigned char* k8 = (unsigned char*)(ws + WS_K8) + ((size_t)kr * 16 + h) * 192; unsigned wn[8], wp[4];
#pragma unroll
            for (int i = 0; i < 8; ++i) { int tt = 0; tt = cvt_pk_fp8_sat(xn[4 * i] * ATT_KS8, xn[4 * i + 1] * ATT_KS8, tt, false); tt = cvt_pk_fp8_sat(xn[4 * i + 2] * ATT_KS8, xn[4 * i + 3] * ATT_KS8, tt, true); wn[i] = (unsigned)tt; }
#pragma unroll
            for (int i = 0; i < 4; ++i) { int tt = 0; tt = cvt_pk_fp8_sat(xp[4 * i] * ATT_KS8, xp[4 * i + 1] * ATT_KS8, tt, false); tt = cvt_pk_fp8_sat(xp[4 * i + 2] * ATT_KS8, xp[4 * i + 3] * ATT_KS8, tt, true); wp[i] = (unsigned)tt; }
            *(v4u*)(k8 + 32 * q) = (v4u){wn[0], wn[1], wn[2], wn[3]}; *(v4u*)(k8 + 32 * q + 16) = (v4u){wn[4], wn[5], wn[6], wn[7]}; *(v4u*)(k8 + 128 + 16 * q) = (v4u){wp[0], wp[1], wp[2], wp[3]};
        } else {
#pragma unroll
        for (int i = 0; i < 4; ++i) { float t8[8];
#pragma unroll
            for (int e = 0; e < 8; ++e) t8[e] = xn[8 * i + e];
            *(v4u*)(kp + 32 * q + 8 * i) = pack8(t8); }
#pragma unroll
        for (int i = 0; i < 2; ++i) { float t8[8];
#pragma unroll
            for (int e = 0; e < 8; ++e) t8[e] = xp[8 * i + e];
            *(v4u*)(kp + 128 + 16 * q + 8 * i) = pack8(t8); }
        }
    }
}
__device__ __forceinline__ void phase6_vt(const Args& a, LAS unsigned char* lds, int vcu, int G) {
    const int tid = threadIdx.x, lane = tid & 63, wave = __builtin_amdgcn_readfirstlane(tid >> 6); unsigned char* ws = a.ws;
    const bf16* VB = (const bf16*)(ws + WS_VB); const bf16* GV = (const bf16*)(ws + WS_GV); unsigned char* VT8 = ws + WS_VT8;
    LAS unsigned short* scr = (LAS unsigned short*)(lds + RING_OFF + wave * 16384);
    const int gw = vcu * NWAVES + wave, NGW = G * NWAVES;
    for (int it4 = gw; it4 < (KVROWS / 64) * 4; it4 += NGW) {
        const int T = it4 >> 2, hd = 16 + (it4 & 3), it = T * 20 + hd;
        const bf16* src = (hd < 16) ? VB + ((size_t)T * 64 * 16 + hd) * 128 : GV + ((size_t)T * 64 * 4 + (hd - 16)) * 128; const size_t rs = (hd < 16) ? 2048 : 512;
#pragma unroll 4
        for (int i = 0; i < 16; ++i) { const int row = 4 * i + (lane >> 4), c8 = (lane & 15) * 8; const v4u w = *(const v4u*)(src + (size_t)row * rs + c8); *(LAS v4u*)(scr + row * 128 + c8) = w; }
        LDS_WAIT(); asm volatile("" ::: "memory");
        unsigned char* dst = VT8 + (size_t)it * 10240;
#pragma unroll
        for (int cc = 0; cc < 2; ++cc) { const int c = lane + 64 * cc;
#pragma unroll
            for (int k4 = 0; k4 < 4; ++k4) { unsigned wd[4];
#pragma unroll
                for (int q4 = 0; q4 < 4; ++q4) { const int q = 4 * k4 + q4, hi2 = q >> 3, b0 = (4 * q) & 31; float v[4];
#pragma unroll
                    for (int j = 0; j < 4; ++j) { const int b = b0 + j, key = 32 * (b >> 4) + 8 * ((b & 15) >> 2) + 4 * hi2 + (b & 3); v[j] = __uint_as_float(((unsigned)scr[key * 128 + c]) << 16) * 32.f; }
                    int tt = 0; tt = cvt_pk_fp8_sat(v[0], v[1], tt, false); tt = cvt_pk_fp8_sat(v[2], v[3], tt, true); wd[q4] = (unsigned)tt; }
                *(v4u*)(dst + c * 80 + 16 * k4) = (v4u){wd[0], wd[1], wd[2], wd[3]}; } }
        LDS_WAIT(); asm volatile("" ::: "memory");
    }
}
__device__ __forceinline__ void phase7(const Args& a, LAS unsigned char* ldsl, char* lds, int vcu, int G) {
    unsigned char* ws = a.ws;
    constexpr long KES = ATT_KF8 ? 1 : 2;
    const char* VT8 = (const char*)(ws + WS_VT8); constexpr long VTS = 20 * 10240;
    const bf16* QRAW = (const bf16*)(ws + WS_QRAW); const char* KB = (const char*)(ws + (ATT_KF8 ? WS_K8 : WS_KB)); const bf16* VB = (const bf16*)(ws + WS_VB);
    const bf16* GQ = (const bf16*)(ws + WS_GQ); const char* GK = (const char*)(ws + WS_GK); const bf16* GV = (const bf16*)(ws + WS_GV);
    constexpr long MIXS = MIX_FP8 ? 1 : 2; constexpr long LDO = DM;
    bf16* MIX = (bf16*)(ws + WS_HB); const float* T16 = (const float*)(ws + WS_ROPE16); const float* gmq = a.in[17]; const float* sink = a.in[21];
    constexpr float NOSINK = -1e30f, L2E = 1.4426950408889634f;
    constexpr int U_ML = NLAT * MLAH * (LSEQ / 256), U_GL = NLAT * GKVH * (LSEQ / 128) * 2, U_MC = NPROMPT * MLAH, U_GC = NPROMPT * GQH;
#ifndef ATT_ONLY
#define ATT_ONLY 15
#endif
#define ATT_TID() int tid = threadIdx.x; asm volatile("" : "+v"(tid)); const int wave = __builtin_amdgcn_readfirstlane(tid >> 6), r32 = tid & 31
    if (ATT_ONLY & 1) for (int u = vcu; u < U_ML; u += G) {
        ATT_TID();
        const int qt = u & 15, h = (u >> 4) & 15, b = u >> 8; const int qpos = qt * 256 + wave * 32 + r32; const size_t trow = (size_t)TP + (size_t)b * LSEQ + qpos;
        const size_t kr0 = (size_t)TP + (size_t)b * (PAST + LSEQ);
        att::attn_body<192, true, false, MIX_FP8, ATT_KF8, ATT_VF8>(QRAW + trow * 3072 + h * 192, gmq, T16, qpos >> 6, qpos & 63, (const bf16*)(KB + (kr0 * 16 + h) * 192 * KES), 3072, ATT_VF8 ? (const bf16*)(VT8 + ((kr0 >> 6) * 20 + h) * 10240) : VB + (kr0 * 16 + h) * 128, ATT_VF8 ? VTS : 2048,
                                         0, (PAST + LSEQ) / 64, 0, 0, 0, 0, NOSINK, (bf16*)((char*)MIX + (((size_t)TP + (size_t)b * LSEQ + qt * 256 + wave * 32) * DM + h * 128) * MIXS), LDO, lds, ldsl, tid);
    }
    if (ATT_ONLY & 2) for (int v = vcu; v < U_GL; v += G) {
        ATT_TID();
        const int gp = v & 1, c = (v >> 1) & 31, n = (v >> 6) & 3, b = v >> 8; const int h = 4 * n + 2 * gp + (wave >> 2);
        const int q0 = 128 * c + 32 * (wave & 3), qi = q0 + r32; const size_t trow = (size_t)TP + (size_t)b * LSEQ + qi;
        const size_t kr0 = (size_t)TP + (size_t)b * (PAST + LSEQ);
        const int js = c > 0 ? 128 * (c - 1) : 0, je = (c < 31) ? 128 * (c + 2) : LSEQ;
        att::attn_body<128, false, true, MIX_FP8, ATT_KF8, ATT_VF8, (GQ_FP8 && ATT_KF8)>((GQ_FP8 && ATT_KF8) ? (const bf16*)((const unsigned char*)GQ + (trow * 16 + h) * 128) : GQ + (trow * 16 + h) * 128, nullptr, nullptr, 0, 0, (const bf16*)(GK + (kr0 * 4 + n) * 128 * KES), 512, ATT_VF8 ? (const bf16*)(VT8 + ((kr0 >> 6) * 20 + 16 + n) * 10240) : GV + (kr0 * 4 + n) * 128, ATT_VF8 ? VTS : 512,
                                         0, PAST / 64, PAST + js, (je - js) / 64, js, qi, sink[h] * L2E, (bf16*)((char*)MIX + (((size_t)TP + (size_t)b * LSEQ + q0) * DM + 2048 + h * 128) * MIXS), LDO, lds, ldsl, tid);
    }
    if (ATT_ONLY & 4) for (int v = vcu; v < U_MC; v += G) {
        ATT_TID();
        const int h = v & 15, p = v >> 4; const size_t trow = (size_t)p * SEQ + wave * 32 + r32; const size_t kr0 = (size_t)p * SEQ;
        att::attn_body<192, true, false, MIX_FP8, ATT_KF8, ATT_VF8>(QRAW + trow * 3072 + h * 192, gmq, nullptr, 0, 0, (const bf16*)(KB + (kr0 * 16 + h) * 192 * KES), 3072, ATT_VF8 ? (const bf16*)(VT8 + ((kr0 >> 6) * 20 + h) * 10240) : VB + (kr0 * 16 + h) * 128, ATT_VF8 ? VTS : 2048,
                                         0, SEQ / 64, 0, 0, 0, 0, NOSINK, (bf16*)((char*)MIX + (((size_t)p * SEQ + wave * 32) * DM + h * 128) * MIXS), LDO, lds, ldsl, tid);
    }
    if (ATT_ONLY & 8) for (int v = vcu; v < U_GC; v += G) {
        ATT_TID();
        const int h = v & 15, p = v >> 4; const size_t trow = (size_t)p * SEQ + wave * 32 + r32; const size_t kr0 = (size_t)p * SEQ;
        att::attn_body<128, false, false, MIX_FP8, ATT_KF8, ATT_VF8, (GQ_FP8 && ATT_KF8)>((GQ_FP8 && ATT_KF8) ? (const bf16*)((const unsigned char*)GQ + (trow * 16 + h) * 128) : GQ + (trow * 16 + h) * 128, nullptr, nullptr, 0, 0, (const bf16*)(GK + (kr0 * 4 + (h >> 2)) * 128 * KES), 512, ATT_VF8 ? (const bf16*)(VT8 + ((kr0 >> 6) * 20 + 16 + (h >> 2)) * 10240) : GV + (kr0 * 4 + (h >> 2)) * 128, ATT_VF8 ? VTS : 512,
                                          0, SEQ / 64, 0, 0, 0, 0, sink[h] * L2E, (bf16*)((char*)MIX + (((size_t)p * SEQ + wave * 32) * DM + 2048 + h * 128) * MIXS), LDO, lds, ldsl, tid);
    }
}
#undef ATT_TID
__device__ __forceinline__ void wup_convert_dyn(const Args& a, LAS unsigned char* lds, unsigned* ctr, unsigned lo, unsigned hi) {
    const int tid = threadIdx.x, lane = tid & 63, wave = __builtin_amdgcn_readfirstlane(tid >> 6); unsigned char* ws = a.ws;
    LAS float* scr = (LAS float*)(lds + RING_OFF + wave * 16384);
    for (;;) { unsigned it0 = 0; if (lane == 0) it0 = atomicAdd(ctr, 4u); it0 = lo + __builtin_amdgcn_readfirstlane(it0); if (it0 >= hi) break;
        for (unsigned it = it0; it < it0 + 4u && it < hi; ++it)
            p0_transpose_item_i8(a.in[23], DM, 22016, (signed char*)(ws + WS_WUP), MapUpPerm{(const unsigned*)(ws + WS_RANK)}, (const unsigned*)(ws + WS_COLMAX), (float*)(ws + WS_COLSC), scr, (int)it, lane); }
}
__device__ __forceinline__ void wqo_convert_dyn(const Args& a, LAS unsigned char* lds, unsigned* ctr) {
    const int tid = threadIdx.x, lane = tid & 63, wave = __builtin_amdgcn_readfirstlane(tid >> 6); unsigned char* ws = a.ws;
    LAS float* scr = (LAS float*)(lds + RING_OFF + wave * 16384);
    constexpr unsigned NQ = (QRANK / 64) * (3072 / 32), NO = (DM / 64) * (DM / 32);
    for (;;) { unsigned it0 = 0; if (lane == 0) it0 = atomicAdd(ctr, 4u); it0 = __builtin_amdgcn_readfirstlane(it0); if (it0 >= NQ + NO) break;
        for (unsigned it = it0; it < it0 + 4u && it < NQ + NO; ++it) {
            if (it < NQ) p0_transpose_item_fp8(a.in[14], QRANK, 3072, (unsigned char*)(ws + WS_WQUP), scr, (int)it, lane);
            else p0_transpose_item_fp8(a.in[22], DM, DM, (unsigned char*)(ws + WS_WOUT), scr, (int)(it - NQ), lane); } }
}
__device__ __forceinline__ void wdown_convert_dyn(const Args& a, LAS unsigned char* lds, unsigned* ctr) {
    const int tid = threadIdx.x, lane = tid & 63, wave = __builtin_amdgcn_readfirstlane(tid >> 6); unsigned char* ws = a.ws;
    LAS float* scr = (LAS float*)(lds + RING_OFF + wave * 16384); const unsigned* sigma = (const unsigned*)(ws + WS_SIGMA);
    constexpr unsigned NIT = (DFF / 64) * (DM / 32);
    for (;;) { unsigned it0 = 0; if (lane == 0) it0 = atomicAdd(ctr, 4u); it0 = __builtin_amdgcn_readfirstlane(it0); if (it0 >= NIT) break;
        for (unsigned it = it0; it < it0 + 4u && it < NIT; ++it) { const int k0 = 64 * (int)(it / (DM / 32));
            if (k0 < GK8) p0_transpose_item_fp8(a.in[26], GPB, DM, (unsigned char*)(ws + WS_WDOWN), scr, (int)it, lane, 0, sigma);
            else p0_transpose_item(a.in[26], GPB / 2, DM, (bf16*)(ws + WS_WDOWN) - GK8 / 2, MapId(), scr, (int)it, lane, sigma); } }
}
__device__ __forceinline__ void phase11(const Args& a, int vcu, int G) {
    const int tid = threadIdx.x; unsigned char* ws = a.ws;
    const float* edge = (const float*)(ws + WS_EDGE); bf16* Gb = (bf16*)(ws + WS_G); const float* cw = FFN_SORT ? (const float*)(ws + WS_CWP) : a.in[24];
    const int nrun = MTOK / 64; const size_t total = (size_t)nrun * 2 * (DFF / 4);
    for (size_t i = (size_t)vcu * NTHREADS + tid; i < total; i += (size_t)G * NTHREADS) {
        const int c4 = (int)(i % (DFF / 4)); const int rr = (int)(i / (DFF / 4)); const int rho = rr >> 1, last = rr & 1; const int c = c4 * 4;
        const int t = rho * 64 + (last ? 63 : 0); const int L = (t < TP) ? SEQ : LSEQ;
        const float* e = edge + ((size_t)rho * 4 + (last ? 2 : 0)) * 22016;
        f32x4 pg = *(const f32x4*)(e + c), pv = *(const f32x4*)(e + DFF + c);
        const bool has = last ? (((t + 1) % L) != 0) : ((t % L) != 0);
        if (has) { const float* ne = edge + ((size_t)(last ? rho + 1 : rho - 1) * 4 + (last ? 1 : 3)) * 22016; const float* w = cw + (last ? 2 * 22016 : 0);
            pg += *(const f32x4*)(w + c) * *(const f32x4*)(ne + c); pv += *(const f32x4*)(w + DFF + c) * *(const f32x4*)(ne + DFF + c); }
        auto gate = [](float a_, float b_) __attribute__((always_inline)) { return (TAP_FOLD && FFN_SORT) ? (a_ * __builtin_amdgcn_rcpf(1.0f + __builtin_amdgcn_exp2f(a_))) * b_ : silu_f(a_) * b_; };
        const float g0 = gate(pg.x, pv.x), g1 = gate(pg.y, pv.y), g2 = gate(pg.z, pv.z), g3 = gate(pg.w, pv.w);
        unsigned char* grow = (unsigned char*)Gb + (size_t)t * GPB; const float s8 = (TAP_FOLD && FFN_SORT) ? 1.0f : SG8;
        if (c < GK8) { int tt = 0; tt = cvt_pk_fp8_sat(g0 * s8, g1 * s8, tt, false); tt = cvt_pk_fp8_sat(g2 * s8, g3 * s8, tt, true); *(unsigned*)(grow + c) = (unsigned)tt; }
        else { v2u o; o.x = pk2(g0, g1); o.y = pk2(g2, g3); *(v2u*)(grow + GK8 + (size_t)(c - GK8) * 2) = o; }
    }
}

#ifndef LB2
#define LB2 2
#endif
__global__ void __launch_bounds__(NTHREADS, LB2) mk_fwd(Args args) {
    extern __shared__ __attribute__((aligned(16))) unsigned char lds_raw[];
    LAS unsigned char* lds = (LAS unsigned char*)lds_raw;
    volatile LAS unsigned* MISC = (volatile LAS unsigned*)(lds + MISC_OFF);
    const int tid = threadIdx.x;
    const int G = gridDim.x; const int bx = blockIdx.x; const int vcu = (G % 8 == 0) ? (bx % 8) * (G / 8) + bx / 8 : bx;
    unsigned char* ws = args.ws;
    unsigned* ctl = (unsigned*)(ws + WS_CTL);
    { int tz = tid; asm volatile("" : "+v"(tz));
      for (int u = tz; u < (LDS_BYTES - RING_BYTES) / 4; u += NTHREADS) ((LAS unsigned*)(lds + RING_BYTES))[u] = 0u; }
    __syncthreads();
    XcdBarrier bar; bar.bar = ctl + CW_BAR; bar.x = 0; bar.st = nullptr;
    if (MK_ONE_LAUNCH) bar = xcd_barrier_post(ctl + CW_BAR, MISC + 8);
    const int lo = args.ph_lo, hi = args.ph_hi;
#ifndef PH_MASK
#define PH_MASK 0x1fff
#endif
#define IN(k) (((PH_MASK >> (k)) & 1) && lo <= (k) && (k) < hi)
#ifndef DUP_MASK
#define DUP_MASK 0
#endif
#define DUPQ(k) ((DUP_MASK >> (k)) & 1)
#define SEAM(k) do { if (IN(k) && IN((k) + 1)) xcd_barrier(bar); } while (0)
    const float* mod = (const float*)(ws + WS_MOD);
    bf16* HB = (bf16*)(ws + WS_HB);
    float* Y = args.out + OUT_Y; bf16* X1 = (bf16*)(ws + WS_X1);

    auto run3 = [&]() __attribute__((always_inline)) {
        { pg8::Gemm g{HB, (const bf16*)(ws + WS_WIN), MTOK, ZBW, DM}; pg8::StaticOrder S; S.init(MTOK, ZBW, G, bx, W_P3B);
          pg8::EpiBf16 E{(bf16*)(ws + WS_ZB), ZBW, 1.0f};
          pg8::gemm_phase<pg8::EpiBf16, pg8::StaticOrder, GEMM_ALIGN, GEMM_SP2>(lds + RING_OFF, g, S, E); }
        __syncthreads();
        { pg8::Gemm g{(const bf16*)(ws + WS_H8), (const bf16*)(ws + WS_WINQ), MTOK, ZQW, DM / 2}; pg8::StaticOrder S; S.init(MTOK, ZQW, G, bx, W_P3Q);
          pg8::EpiBf16T<true> E{(bf16*)(ws + WS_Z), ZQW, 1.0f / 4096.0f};
          pg8::gemm_phase<pg8::EpiBf16T<true>, pg8::StaticOrder, GEMM_ALIGN, GEMM_SP2>(lds + RING_OFF, g, S, E); } };
    auto run5 = [&]() __attribute__((always_inline)) {
        { pg8::Gemm g{(const bf16*)(ws + WS_CKV), (const bf16*)(ws + WS_WKVUP), KVROWS, 4096, (KVUP_FP8 || KVUP_I8) ? KVRANK / 2 : KVRANK}; pg8::StaticOrder S; S.init(KVROWS, 4096, G, bx, W_P5K);
          if constexpr (KV_FUSE) { static_assert(!KV_FUSE || (KVUP_I8 && ATT_VF8 && ATT_KF8 && GEMM_ALIGN), "KV_FUSE needs the int8 kv-up GEMM, fp8 keys / V images and aligned epilogues");
            typedef pg8::EpiKVFuse<WS_K8, WS_VT8, WS_CKVS, WS_KVCS, WS_KPESS, WS_KPE> EKF;
            EKF E{ws, args.in[18], (LAS float*)(lds + RING_BYTES + 4096), ATT_KS8};
            pg8::gemm_phase<EKF, pg8::StaticOrder, GEMM_ALIGN, GEMM_SP2>(lds + RING_OFF, g, S, E); }
          else {
          typedef pg8::EpiKVT<ATT_VF8, KVUP_FP8 && !KVUP_I8, KVUP_I8> EKV;
          EKV E{(bf16*)(ws + WS_KB), (bf16*)(ws + WS_VB), ws + WS_VT8, (const float*)(ws + WS_CKVS), (const float*)(ws + WS_KVCS)};
          pg8::gemm_phase<EKV, pg8::StaticOrder, GEMM_ALIGN, GEMM_SP2>(lds + RING_OFF, g, S, E); } }
        __syncthreads();
        { pg8::Gemm g{(const bf16*)(ws + WS_QN), (const bf16*)(ws + WS_WQUP), MTOK, 3072, (QUP_FP8 || QUP_I8) ? QRANK / 2 : QRANK}; pg8::StaticOrder S; S.init(MTOK, 3072, G, bx, W_P5Q);
          pg8::EpiBf16T<QUP_FP8 && !QUP_I8, QUP_I8> E{(bf16*)(ws + WS_QRAW), 3072, QUP_I8 ? (1.0f / 16.0f) * (0.15875f / 127.0f) : (QUP_FP8 ? 1.0f / 4096.0f : 1.0f)};
          pg8::gemm_phase<pg8::EpiBf16T<QUP_FP8 && !QUP_I8, QUP_I8>, pg8::StaticOrder, GEMM_ALIGN, GEMM_SP2>(lds + RING_OFF, g, S, E); } };
    auto run8 = [&]() __attribute__((always_inline)) {
        pg8::Gemm g{HB, (const bf16*)(ws + WS_WOUT), MTOK, DM, MIX_FP8 ? DM / 2 : DM}; pg8::StaticOrder S; S.init(MTOK, DM, G, bx, W_P8);
        pg8::EpiResT<MIX_FP8, false, true> E{args.in[0], args.in[1], X1, mod + 2 * 4096, MIX_FP8 ? PROBE_GSCALE * (1.0f / 8192.0f) : PROBE_GSCALE, 1.0f};
        pg8::gemm_phase<pg8::EpiResT<MIX_FP8, false, true>, pg8::StaticOrder, GEMM_ALIGN, GEMM_SP2>(lds + RING_OFF, g, S, E); };
    auto run10 = [&]() __attribute__((always_inline)) {
        pg8::Gemm g{HB, (const bf16*)(ws + WS_WUP), MTOK, 22016, UP_I8 ? DM / 2 : DM}; pg8::StaticOrder S; S.init(MTOK, 22016, G, bx, W_P10);
        pg8::EpiUpT<(UP_I8 && !PROBE_UPF8), (TAP_FOLD && FFN_SORT)> E{(LAS float*)(lds + RING_BYTES + 4096), (unsigned char*)(ws + WS_G), FFN_SORT ? (const float*)(ws + WS_CWP) : args.in[24], FFN_SORT ? (const float*)(ws + WS_CBP) : args.in[25], (float*)(ws + WS_EDGE), GK8, GPB, SG8, (const float*)(ws + WS_ROWSC), (const float*)(ws + WS_COLSC)};
        pg8::gemm_phase<pg8::EpiUpT<(UP_I8 && !PROBE_UPF8), (TAP_FOLD && FFN_SORT)>, pg8::StaticOrder, GEMM_ALIGN, GEMM_SP2>(lds + RING_OFF, g, S, E); };
    auto run12 = [&]() __attribute__((always_inline)) {
        pg8::Gemm g{(const bf16*)(ws + WS_G), (const bf16*)(ws + WS_WDOWN), MTOK, DM, GPB / 2}; pg8::StaticOrder S; S.init(MTOK, DM, G, bx, W_P12);
        pg8::EpiResT<false, true, false, DOWN_NT8> E{X1, X1 + (size_t)TP * DM, Y, mod + 5 * 4096, PROBE_GSCALE2, 1.0f / (SG8 * SW8)};
        pg8::gemm_phase<pg8::EpiResT<false, true, false, DOWN_NT8>, pg8::StaticOrder, GEMM_ALIGN, GEMM_SP2>(lds + RING_OFF, g, S, E); };
    if (IN(0)) { phase0(args, lds, vcu, G); if (DUPQ(0)) { __syncthreads(); phase0(args, lds, vcu, G); } } SEAM(0);
    if (IN(1)) { phase1(args, lds, vcu, G); if (DUPQ(1)) phase1(args, lds, vcu, G); } SEAM(1);
    if (IN(2)) { phase_norm<false>(args.in[0], args.in[1], args.in[8], mod, 0, 4096, HB, (unsigned char*)(ws + WS_H8), nullptr, lds, vcu, G); if (DUPQ(2)) phase_norm<false>(args.in[0], args.in[1], args.in[8], mod, 0, 4096, HB, (unsigned char*)(ws + WS_H8), nullptr, lds, vcu, G); } SEAM(2);
    constexpr unsigned UP_ITEMS = (DM / 64) * (22016 / 32);
    if (IN(3)) { run3(); if (DUPQ(3)) { __syncthreads(); run3(); }
        if (UP_TAIL && UP_I8 && FFN_SORT) { __syncthreads(); wup_convert_dyn(args, lds, ctl + 16448, 0u, UPT_A); }
        if (W_TAIL3 && QUP_FP8 && !QUP_I8 && MIX_FP8) { __syncthreads(); wqo_convert_dyn(args, lds, ctl + 16640); } } SEAM(3);
    if (IN(4)) { phase4(args, vcu, G); if (DUPQ(4)) phase4(args, vcu, G); } SEAM(4);
    if (IN(5)) { run5(); if (DUPQ(5)) { __syncthreads(); run5(); }
        if (KV_FUSE && ATT_VF8 && ((PH_MASK >> 6) & 1)) { __syncthreads(); phase6_vt(args, lds, vcu, G); }
        if (UP_TAIL && UP_I8 && FFN_SORT) { __syncthreads(); wup_convert_dyn(args, lds, ctl + 16512, UPT_A, UPT_B); } }
    if (!KV_FUSE) SEAM(5);
    if (IN(6)) { if (!KV_FUSE) { phase6(args, lds, vcu, G); if (ATT_VF8) phase6_vt(args, lds, vcu, G); if (DUPQ(6)) { phase6(args, lds, vcu, G); if (ATT_VF8) phase6_vt(args, lds, vcu, G); } } } SEAM(6);
    if (IN(7)) { phase7(args, lds, (char*)lds_raw, vcu, G); if (DUPQ(7)) { __syncthreads(); phase7(args, lds, (char*)lds_raw, vcu, G); } } SEAM(7);
    if (IN(8)) { run8(); if (DUPQ(8)) { __syncthreads(); run8(); } } SEAM(8);
    if (IN(9)) { phase_norm<true>(X1, X1, args.in[9], mod, 3 * 4096, 4 * 4096, HB, UP_I8 ? (unsigned char*)HB : nullptr, UP_I8 ? (float*)(ws + WS_ROWSC) : nullptr, lds, vcu, G); if (DUPQ(9)) phase_norm<true>(X1, X1, args.in[9], mod, 3 * 4096, 4 * 4096, HB, UP_I8 ? (unsigned char*)HB : nullptr, UP_I8 ? (float*)(ws + WS_ROWSC) : nullptr, lds, vcu, G);
        if (UP_TAIL && UP_I8 && FFN_SORT) { __syncthreads(); wup_convert_dyn(args, lds, ctl + 16576, UPT_B, UP_ITEMS); } } SEAM(9);
    if (IN(10)) { run10(); if (DUPQ(10)) { __syncthreads(); run10(); }
        if (DOWN_TAIL && FFN_SORT) { __syncthreads(); wdown_convert_dyn(args, lds, ctl + 16384); } } SEAM(10);
    if (IN(11)) { phase11(args, vcu, G); if (DUPQ(11)) phase11(args, vcu, G); } SEAM(11);
    if (IN(12)) { run12(); if (DUPQ(12)) { __syncthreads(); run12(); } }
#undef IN
#undef SEAM
}

extern "C" void kernel_launch(void* const* d_in, const int* in_sizes, int n_in, void* d_out, int out_size, void* d_ws, size_t ws_size, hipStream_t stream) {
    static int grid = 0;
    if (grid == 0) {
        if (n_in != 27 || in_sizes[0] != TP * DM || in_sizes[1] != TL * DM || (size_t)out_size != OUT_END || ws_size < WS_END) {
            fprintf(stderr, "kernel_launch: shape mismatch: n_in %d in0 %d in1 %d out %d ws %zu (need >= %zu); nothing launched\n", n_in, n_in > 0 ? in_sizes[0] : -1, n_in > 1 ? in_sizes[1] : -1, out_size, ws_size, (size_t)WS_END); grid = -1; return; }
        int dev = 0, cus = 0, per_cu = 0;
        if (hipGetDevice(&dev) != hipSuccess || hipDeviceGetAttribute(&cus, hipDeviceAttributeMultiprocessorCount, dev) != hipSuccess) { fprintf(stderr, "kernel_launch: device query failed\n"); grid = -1; return; }
        if (hipFuncSetAttribute((const void*)mk_fwd, hipFuncAttributeMaxDynamicSharedMemorySize, LDS_BYTES) != hipSuccess) { fprintf(stderr, "kernel_launch: hipFuncSetAttribute failed\n"); grid = -1; return; }
        if (hipOccupancyMaxActiveBlocksPerMultiprocessor(&per_cu, (const void*)mk_fwd, NTHREADS, LDS_BYTES) != hipSuccess || per_cu < 1) { fprintf(stderr, "kernel_launch: occupancy query says %d blocks per CU\n", per_cu); }
        (void)hipGetLastError();
        grid = cus;
    }
    if (grid < 0) return;
    if (hipMemsetAsync((char*)d_ws + WS_CTL, 0, CTL_ZERO_BYTES, stream) != hipSuccess) { fprintf(stderr, "kernel_launch: memset failed\n"); return; }
    Args a{};
    for (int i = 0; i < 27; ++i) a.in[i] = (const float*)d_in[i];
    a.out = (float*)d_out; a.ws = (unsigned char*)d_ws;
#if MK_ONE_LAUNCH
    a.ph_lo = 0; a.ph_hi = N_PHASES;
    hipLaunchKernelGGL(mk_fwd, dim3(grid), dim3(NTHREADS), LDS_BYTES, stream, a);
#else
    for (int p = 0; p < N_PHASES; ++p) { a.ph_lo = p; a.ph_hi = p + 1; hipLaunchKernelGGL(mk_fwd, dim3(grid), dim3(NTHREADS), LDS_BYTES, stream, a); }
#endif
    const hipError_t le = hipPeekAtLastError();
    if (le != hipSuccess) fprintf(stderr, "kernel_launch: launch failed: %s\n", hipGetErrorName(le));
}
```

```cpp
#include <hip/hip_runtime.h>
#include <cstdio>
#include <cstdint>
__device__ __forceinline__ int cvt_pk_fp8_sat(float a, float b, int old, bool hi) { a = __builtin_amdgcn_fmed3f(a, -448.f, 448.f); b = __builtin_amdgcn_fmed3f(b, -448.f, 448.f); return hi ? __builtin_amdgcn_cvt_pk_fp8_f32(a, b, old, true) : __builtin_amdgcn_cvt_pk_fp8_f32(a, b, old, false); }
#ifndef PG8_WGM
#define PG8_WGM 8
#endif
namespace pg8 {
#define PG8_LAS __attribute__((address_space(3)))
typedef unsigned short bf16_t;
typedef short bf16x8 __attribute__((ext_vector_type(8)));
typedef float f32x4 __attribute__((ext_vector_type(4)));
typedef unsigned u32x4 __attribute__((ext_vector_type(4)));
constexpr int BM = 256, BK = 64, HALF = 128, HTB = HALF * BK * 2  , STAGE_BYTES = 8 * HTB, NXCD = 8, WGM = PG8_WGM;

__host__ __device__ __forceinline__ int lds_byte(int r, int c) { const int st = (r >> 4) * 2 + (c >> 5), rr = r & 15, cc = c & 31, ob = rr * 64 + cc * 2; return st * 1024 + (ob ^ (((ob >> 9) & 1) << 5)); }
__host__ __device__ __forceinline__ void stage_rc(int b, int& R, int& C) { const int st = b / 1024, sb = b % 1024, swz = sb ^ (((sb >> 9) & 1) << 5); R = (st >> 1) * 16 + swz / 64; C = (st & 1) * 32 + (swz % 64) / 2; }
__host__ __device__ __forceinline__ int perm32(int rho) { const int n = rho >> 4, i = rho & 15; return 8 * (i >> 2) + 4 * n + (i & 3); }

struct Unit { int pm, pn, slot; };
struct Gemm { const bf16_t* A; const bf16_t* Bt; int M, N, K; };

struct StaticOrder {
    int nM, nN, nwg, G, c, wgm;
    __host__ __device__ void init(int M, int N, int G_, int c_, int wgm_ = WGM) { nM = M / BM; nN = N / BM; nwg = nM * nN; G = G_; c = c_; wgm = wgm_; }
    __host__ __device__ bool next(int i, Unit& u) const {
        const long L = (long)i * G + c; if (L >= nwg) return false;
        int wgid = (int)L; { const int q = nwg / NXCD, r = nwg % NXCD, xcd = wgid % NXCD, off = wgid / NXCD; wgid = (xcd < r ? xcd * (q + 1) : r * (q + 1) + (xcd - r) * q) + off; }
        const int nig = wgm * nN, gid = wgid / nig, fm = gid * wgm, gsz = (nM - fm) < wgm ? (nM - fm) : wgm;
        u.pm = fm + ((wgid % nig) % gsz); u.pn = (wgid % nig) / gsz; return true;
    }
    __device__ __forceinline__ void a_ready(const Unit&) const {}
    __device__ __forceinline__ void done(const Unit&) const {}
};

__device__ __forceinline__ unsigned cvt_pk_bf16(float lo, float hi) { unsigned r; asm volatile("v_cvt_pk_bf16_f32 %0, %1, %2" : "=v"(r) : "v"(lo), "v"(hi)); return r; }
#ifndef PROBE_QPERMA
#define PROBE_QPERMA false
#endif
template <bool F8, bool I8_ = false> struct EpiBf16T {
    static constexpr bool PERM = true, AFTER_DRAIN = false, PERMA = I8_ && PROBE_QPERMA, FP8 = F8; static constexpr int NT8 = 0; static constexpr bool I8 = I8_;
    bf16_t* O; int ldc; float scale;
    __device__ __forceinline__ void operator()(const f32x4 (&acc)[2][2][4][2], const Unit& u, int wr, int wc, int fr, int fq) const {
        const int row0 = u.pm * BM + wr * 64, col0 = u.pn * BM + wc * 32 + 8 * fq;
#pragma unroll
        for (int ai = 0; ai < 2; ++ai)
#pragma unroll
            for (int m = 0; m < 4; ++m) { bf16_t* rowp = O + (size_t)(row0 + ai * HALF + (PERMA ? 4 * fr + m : m * 16 + fr)) * ldc + col0;
#pragma unroll
                for (int bj = 0; bj < 2; ++bj) { f32x4 v0, v1;
                    if constexpr (I8) { typedef int i32x4_ __attribute__((ext_vector_type(4))); v0 = __builtin_convertvector(__builtin_bit_cast(i32x4_, acc[ai][bj][m][0]), f32x4) * scale; v1 = __builtin_convertvector(__builtin_bit_cast(i32x4_, acc[ai][bj][m][1]), f32x4) * scale; }
                    else { v0 = acc[ai][bj][m][0] * scale; v1 = acc[ai][bj][m][1] * scale; }
                    u32x4 w; w.x = cvt_pk_bf16(v0[0], v0[1]); w.y = cvt_pk_bf16(v0[2], v0[3]); w.z = cvt_pk_bf16(v1[0], v1[1]); w.w = cvt_pk_bf16(v1[2], v1[3]);
                    *(u32x4*)(rowp + bj * HALF) = w; } }
    }
};
typedef EpiBf16T<false> EpiBf16;
template <bool VIMG, bool F8 = false, bool I8_ = false> struct EpiKVT {
    static constexpr bool PERM = true, AFTER_DRAIN = false, PERMA = VIMG, FP8 = F8; static constexpr int NT8 = 0; static constexpr bool I8 = I8_;
    bf16_t* Kb; bf16_t* Vb; unsigned char* Vt8; const float* rowscale; const float* colscale;
    __device__ __forceinline__ void operator()(const f32x4 (&accr)[2][2][4][2], const Unit& u, int wr, int wc, int fr, int fq) const {
        const int col0 = wc * 32 + 8 * fq;
        f32x4 acc[2][2][4][2];
        if constexpr (I8) { typedef int i32x4_ __attribute__((ext_vector_type(4))); f32x4 cs[2][2];
#pragma unroll
            for (int bj = 0; bj < 2; ++bj)
#pragma unroll
                for (int n = 0; n < 2; ++n) cs[bj][n] = *(const f32x4*)(colscale + u.pn * 256 + bj * 128 + col0 + 4 * n);
#pragma unroll
            for (int ai = 0; ai < 2; ++ai)
#pragma unroll
                for (int m = 0; m < 4; ++m) { const float rs = rowscale[(size_t)(u.pm * BM + ai * HALF + wr * 64 + (VIMG ? 4 * fr + m : 16 * m + fr))];
#pragma unroll
                    for (int bj = 0; bj < 2; ++bj)
#pragma unroll
                        for (int n = 0; n < 2; ++n) acc[ai][bj][m][n] = __builtin_convertvector(__builtin_bit_cast(i32x4_, accr[ai][bj][m][n]), f32x4) * (cs[bj][n] * rs); } }
        else {
#pragma unroll
            for (int ai = 0; ai < 2; ++ai)
#pragma unroll
                for (int bj = 0; bj < 2; ++bj)
#pragma unroll
                    for (int m = 0; m < 4; ++m)
#pragma unroll
                        for (int n = 0; n < 2; ++n) acc[ai][bj][m][n] = accr[ai][bj][m][n]; }
#pragma unroll
        for (int ai = 0; ai < 2; ++ai) {
#pragma unroll
            for (int m = 0; m < 4; ++m) { const size_t row = (size_t)(u.pm * BM + ai * HALF + wr * 64 + (VIMG ? 4 * fr + m : 16 * m + fr));
                { const f32x4 v0 = acc[ai][0][m][0] * (F8 ? 1.0f / 4096.0f : 1.0f), v1 = acc[ai][0][m][1] * (F8 ? 1.0f / 4096.0f : 1.0f); u32x4 w; w.x = cvt_pk_bf16(v0[0], v0[1]); w.y = cvt_pk_bf16(v0[2], v0[3]); w.z = cvt_pk_bf16(v1[0], v1[1]); w.w = cvt_pk_bf16(v1[2], v1[3]);
                  *(u32x4*)(Kb + row * 3072 + u.pn * 192 + col0) = w; }
                if constexpr (!VIMG) { const f32x4 v0 = acc[ai][1][m][0] * (F8 ? 1.0f / 4096.0f : 1.0f), v1 = acc[ai][1][m][1] * (F8 ? 1.0f / 4096.0f : 1.0f); u32x4 w; w.x = cvt_pk_bf16(v0[0], v0[1]); w.y = cvt_pk_bf16(v0[2], v0[3]); w.z = cvt_pk_bf16(v1[0], v1[1]); w.w = cvt_pk_bf16(v1[2], v1[3]);
                  *(u32x4*)(Vb + row * 2048 + u.pn * 128 + col0) = w; } }
            if constexpr (VIMG) { const int T = u.pm * 4 + ai * 2 + wr;
                unsigned char* img = Vt8 + ((size_t)T * 20 + u.pn) * 10240 + (fr & 1) * 32 + (fr >> 3) * 16 + ((fr >> 1) & 3) * 4;
#pragma unroll
                for (int n = 0; n < 2; ++n)
#pragma unroll
                    for (int j = 0; j < 4; ++j) { int t = 0; constexpr float vs = F8 ? 32.f / 4096.f : 32.f; t = cvt_pk_fp8_sat(acc[ai][1][0][n][j] * vs, acc[ai][1][1][n][j] * vs, t, false); t = cvt_pk_fp8_sat(acc[ai][1][2][n][j] * vs, acc[ai][1][3][n][j] * vs, t, true);
                        *(unsigned*)(img + (col0 + 4 * n + j) * 80) = (unsigned)t; } }
        }
    }
};
template <size_t O_K8, size_t O_VT8, size_t O_ROWSC, size_t O_COLSC, size_t O_KPESS, size_t O_KPER>
struct EpiKVFuse {
    static constexpr bool PERM = true, AFTER_DRAIN = false, PERMA = true, FP8 = false; static constexpr int NT8 = 0; static constexpr bool I8 = true;
    unsigned char* wsb; const float* gk; PG8_LAS float* part; float ks8;
    static constexpr bool PREFETCH = true;
    __device__ __forceinline__ void prefetch(const Unit& u, int wid, int lane) const {
        if (wid < 4) { const float* src = wid == 0 ? (const float*)(wsb + O_ROWSC) + u.pm * BM + lane * 4 : (wid == 1 ? (const float*)(wsb + O_COLSC) + u.pn * 256 + lane * 4 : (wid == 2 ? (const float*)(wsb + O_KPESS) + u.pm * BM + lane * 4 : gk + (lane & 31) * 4));
            __builtin_amdgcn_global_load_lds((const unsigned*)src, (PG8_LAS unsigned*)(part + 1024 + u.slot * 1024 + wid * 256), 16, 0, 0); }
    }
    __device__ __forceinline__ void operator()(const f32x4 (&accr)[2][2][4][2], const Unit& u, int wr, int wc, int fr, int fq) const {
        typedef int i32x4_ __attribute__((ext_vector_type(4))); typedef unsigned u32x2k __attribute__((ext_vector_type(2)));
        unsigned char* K8 = wsb + O_K8; unsigned char* Vt8 = wsb + O_VT8; const PG8_LAS float* P = part + 1024 + u.slot * 1024;
        const bf16_t* kper = (const bf16_t*)(wsb + O_KPER);
        const int col0 = wc * 32 + 8 * fq;
        f32x4 cs[2][2]; float rsv[2][4];
#pragma unroll
        for (int bj = 0; bj < 2; ++bj)
#pragma unroll
            for (int n = 0; n < 2; ++n) cs[bj][n] = *(const PG8_LAS f32x4*)(P + 256 + bj * 128 + col0 + 4 * n);
#pragma unroll
        for (int ai = 0; ai < 2; ++ai)
#pragma unroll
            for (int m = 0; m < 4; ++m) rsv[ai][m] = P[ai * HALF + wr * 64 + 4 * fr + m];
#pragma unroll
        for (int ai = 0; ai < 2; ++ai) { const int T = u.pm * 4 + ai * 2 + wr;
            unsigned char* img = Vt8 + ((size_t)T * 20 + u.pn) * 10240 + (fr & 1) * 32 + (fr >> 3) * 16 + ((fr >> 1) & 3) * 4;
#pragma unroll
            for (int n = 0; n < 2; ++n) { f32x4 vv[4];
#pragma unroll
                for (int m = 0; m < 4; ++m) vv[m] = __builtin_convertvector(__builtin_bit_cast(i32x4_, accr[ai][1][m][n]), f32x4) * (cs[1][n] * (rsv[ai][m] * 32.f));
#pragma unroll
                for (int j = 0; j < 4; ++j) { int t = 0; t = cvt_pk_fp8_sat(vv[0][j], vv[1][j], t, false); t = cvt_pk_fp8_sat(vv[2][j], vv[3][j], t, true);
                    *(unsigned*)(img + (col0 + 4 * n + j) * 80) = (unsigned)t; } } }
        f32x4 kf[2][4][2]; float ssq[2][4];
#pragma unroll
        for (int ai = 0; ai < 2; ++ai)
#pragma unroll
            for (int m = 0; m < 4; ++m) { float s_ = 0.f;
#pragma unroll
                for (int n = 0; n < 2; ++n) { const f32x4 k4 = __builtin_convertvector(__builtin_bit_cast(i32x4_, accr[ai][0][m][n]), f32x4) * (cs[0][n] * rsv[ai][m]); kf[ai][m][n] = k4;
                    s_ += (k4[0] * k4[0] + k4[1] * k4[1]) + (k4[2] * k4[2] + k4[3] * k4[3]); }
                s_ += __shfl_xor(s_, 16); s_ += __shfl_xor(s_, 32); ssq[ai][m] = s_; }
        if (fq == 0) {
#pragma unroll
            for (int ai = 0; ai < 2; ++ai)
#pragma unroll
                for (int m = 0; m < 4; ++m) part[((wr * 2 + ai) * 64 + 4 * fr + m) * 4 + wc] = ssq[ai][m]; }
        u32x2k kw[2][4];
#pragma unroll
        for (int ai = 0; ai < 2; ++ai)
#pragma unroll
            for (int m = 0; m < 4; ++m) kw[ai][m] = *(const u32x2k*)(kper + (size_t)(u.pm * BM + ai * HALF + wr * 64 + 4 * fr + m) * 64 + wc * 16 + fq * 4);
        asm volatile("s_waitcnt lgkmcnt(0)" ::: "memory"); __builtin_amdgcn_s_barrier(); asm volatile("" ::: "memory");
        const f32x4 g0 = *(const PG8_LAS f32x4*)(P + 768 + col0), g1 = *(const PG8_LAS f32x4*)(P + 768 + col0 + 4);
#pragma unroll
        for (int ai = 0; ai < 2; ++ai)
#pragma unroll
            for (int m = 0; m < 4; ++m) { const size_t row = (size_t)(u.pm * BM + ai * HALF + wr * 64 + 4 * fr + m);
                const f32x4 pp = *(const PG8_LAS f32x4*)(part + ((wr * 2 + ai) * 64 + 4 * fr + m) * 4);
                const float ss = ((pp[0] + pp[1]) + (pp[2] + pp[3])) + P[512 + ai * HALF + wr * 64 + 4 * fr + m]; const float r = ks8 / sqrtf(ss * (1.0f / 192.0f) + 1e-6f);
                unsigned char* kd = K8 + (row * 16 + u.pn) * 192;
                const f32x4 v0 = kf[ai][m][0] * (g0 * r), v1 = kf[ai][m][1] * (g1 * r); int t0 = 0, t1 = 0;
                t0 = cvt_pk_fp8_sat(v0[0], v0[1], t0, false); t0 = cvt_pk_fp8_sat(v0[2], v0[3], t0, true); t1 = cvt_pk_fp8_sat(v1[0], v1[1], t1, false); t1 = cvt_pk_fp8_sat(v1[2], v1[3], t1, true);
                *(u32x2k*)(kd + col0) = (u32x2k){(unsigned)t0, (unsigned)t1};
                const u32x2k w = kw[ai][m]; int t2 = 0;
                t2 = cvt_pk_fp8_sat(__uint_as_float(w.x << 16) * r, __uint_as_float(w.x & 0xffff0000u) * r, t2, false); t2 = cvt_pk_fp8_sat(__uint_as_float(w.y << 16) * r, __uint_as_float(w.y & 0xffff0000u) * r, t2, true);
                *(unsigned*)(kd + 128 + wc * 16 + fq * 4) = (unsigned)t2; }
    }
};
template <bool F8, bool BB, bool OB, int NT8_ = 0> struct EpiResT {
    static constexpr bool PERM = true, AFTER_DRAIN = false, PERMA = false, FP8 = F8; static constexpr int NT8 = NT8_; static constexpr bool I8 = false;
    __device__ __forceinline__ float mix_rescale() const { return mixrs; }
    const void* base_p; const void* base_s; void* out; const float* gate; float gscale; float mixrs;
    __device__ __forceinline__ void operator()(const f32x4 (&acc)[2][2][4][2], const Unit& u, int wr, int wc, int fr, int fq) const {
        const int mr = u.pm < 16 ? 8 : ((u.pm - 16) >> 4);
        const int col0 = u.pn * BM + wc * 32 + 8 * fq;
        const float* gp = gate + (size_t)mr * 24576 + col0;
        f32x4 gv[2][2];
#pragma unroll
        for (int bj = 0; bj < 2; ++bj)
#pragma unroll
            for (int n = 0; n < 2; ++n) gv[bj][n] = *(const f32x4*)(gp + bj * HALF + n * 4) * gscale;
        const int rt = u.pm * BM + wr * 64 + fr;
        const size_t rb = (u.pm < 16) ? (size_t)rt : (size_t)(rt - 4096);
        const char* bb = (const char*)((u.pm < 16) ? base_p : base_s) + rb * 4096 * (BB ? 2 : 4);
        char* ob = (char*)out + (size_t)rt * 4096 * (OB ? 2 : 4);
#pragma unroll
        for (int ai = 0; ai < 2; ++ai)
#pragma unroll
            for (int m = 0; m < 4; ++m) { const size_t off = (size_t)(ai * HALF + m * 16) * 4096 + col0;
#pragma unroll
                for (int bj = 0; bj < 2; ++bj) { f32x4 b0, b1;
                    if constexpr (BB) { const u32x4 w = *(const u32x4*)(bb + (off + bj * HALF) * 2);
                        b0 = (f32x4){__uint_as_float(w.x << 16), __uint_as_float(w.x & 0xffff0000u), __uint_as_float(w.y << 16), __uint_as_float(w.y & 0xffff0000u)};
                        b1 = (f32x4){__uint_as_float(w.z << 16), __uint_as_float(w.z & 0xffff0000u), __uint_as_float(w.w << 16), __uint_as_float(w.w & 0xffff0000u)}; }
                    else { b0 = *(const f32x4*)(bb + (off + bj * HALF) * 4); b1 = *(const f32x4*)(bb + (off + bj * HALF) * 4 + 16); }
                    const f32x4 o0 = b0 + gv[bj][0] * acc[ai][bj][m][0], o1 = b1 + gv[bj][1] * acc[ai][bj][m][1];
                    if constexpr (OB) { u32x4 w; w.x = cvt_pk_bf16(o0[0], o0[1]); w.y = cvt_pk_bf16(o0[2], o0[3]); w.z = cvt_pk_bf16(o1[0], o1[1]); w.w = cvt_pk_bf16(o1[2], o1[3]); *(u32x4*)(ob + (off + bj * HALF) * 2) = w; }
                    else { *(f32x4*)(ob + (off + bj * HALF) * 4) = o0; *(f32x4*)(ob + (off + bj * HALF) * 4 + 16) = o1; } }
                asm volatile("" ::: "memory"); }
    }
};
__device__ __forceinline__ float dpp_from_prev_lane(float v) { return __builtin_bit_cast(float, __builtin_amdgcn_update_dpp(0, __builtin_bit_cast(int, v), 0x111, 0xf, 0xf, true)); }
__device__ __forceinline__ float dpp_from_next_lane(float v) { return __builtin_bit_cast(float, __builtin_amdgcn_update_dpp(0, __builtin_bit_cast(int, v), 0x101, 0xf, 0xf, true)); }
#ifndef PROBE_UPF8
#define PROBE_UPF8 false
#endif
template <bool I8_, bool FOLD = false> struct EpiUpT {
    static constexpr bool PERM = true, AFTER_DRAIN = false, PERMA = true, FP8 = PROBE_UPF8; static constexpr int NT8 = 0; static constexpr bool I8 = I8_;
    static constexpr bool PREFETCH = true;
    PG8_LAS float* prm;
    __device__ __forceinline__ void prefetch(const Unit& u, int wid, int lane) const {
        if (wid < (I8 ? 6 : 4)) { const int ci = (lane < 32) ? u.pn * 128 + lane * 4 : 11008 + u.pn * 128 + (lane - 32) * 4;
            const float* src = wid < 3 ? cw + wid * 22016 + ci : (wid == 3 ? cb + ci : (wid == 4 ? colscale + u.pn * 256 + lane * 4 : rowscale + u.pm * BM + lane * 4));
            __builtin_amdgcn_global_load_lds((const unsigned*)src, (PG8_LAS unsigned*)(prm + u.slot * 1536 + wid * 256), 16, 0, 0); }
    }
    unsigned char* G; const float* cw; const float* cb; float* edge; int k8; int gpb; float sg; const float* rowscale; const float* colscale;
    __device__ __forceinline__ void operator()(const f32x4 (&acc)[2][2][4][2], const Unit& u, int wr, int wc, int fr, int fq) const {
        const int colg = u.pn * 128 + wc * 32 + 8 * fq;
        const bool g8 = u.pn * 128 < k8;
        unsigned gw[2][4][4]; int gw8[2][4][2];
        f32x4 rs4[2] = {(f32x4){1.f, 1.f, 1.f, 1.f}, (f32x4){1.f, 1.f, 1.f, 1.f}};
        const PG8_LAS float* P = prm + u.slot * 1536;
        if constexpr (I8) { rs4[0] = *(const PG8_LAS f32x4*)(P + 1280 + wr * 64 + 4 * fr); rs4[1] = *(const PG8_LAS f32x4*)(P + 1280 + HALF + wr * 64 + 4 * fr); }
#pragma unroll
        for (int n = 0; n < 2; ++n) {
            f32x4 W0[2], W1[2], W2[2], Bv[2], cs4[2];
#pragma unroll
            for (int bj = 0; bj < 2; ++bj) { const int uc = bj * 11008 + colg + 4 * n;
                const int pe = bj * 128 + wc * 32 + 8 * fq + 4 * n;
                W0[bj] = *(const PG8_LAS f32x4*)(P + pe); W1[bj] = *(const PG8_LAS f32x4*)(P + 256 + pe); W2[bj] = *(const PG8_LAS f32x4*)(P + 512 + pe); Bv[bj] = *(const PG8_LAS f32x4*)(P + 768 + pe);
                cs4[bj] = (f32x4){1.f, 1.f, 1.f, 1.f};
                if constexpr (I8) { cs4[bj] = *(const PG8_LAS f32x4*)(P + 1024 + pe); W0[bj] *= cs4[bj]; W1[bj] *= cs4[bj]; W2[bj] *= cs4[bj]; } }
#pragma unroll
            for (int ai = 0; ai < 2; ++ai) {
                const int rho = u.pm * 4 + ai * 2 + wr;
                float* e0 = edge + ((size_t)rho * 4 + 0) * 22016;
                f32x4 Pf[2], Pl[2], Uf[2], Ul[2];
                f32x4 uv[2][4];
#pragma unroll
                for (int bj = 0; bj < 2; ++bj)
#pragma unroll
                    for (int m = 0; m < 4; ++m) {
                        if constexpr (I8) { typedef int i32x4_ __attribute__((ext_vector_type(4))); uv[bj][m] = __builtin_convertvector(__builtin_bit_cast(i32x4_, acc[ai][bj][m][n]), f32x4) * rs4[ai][m]; }
                        else uv[bj][m] = acc[ai][bj][m][n] * (FP8 ? (1.0f / 4096.0f) : 1.0f); }
                f32x4 Cc[2][4];
#pragma unroll
                for (int bj = 0; bj < 2; ++bj) {
                    const f32x4 U0 = uv[bj][0], U1 = uv[bj][1], U2 = uv[bj][2], U3 = uv[bj][3];
                    f32x4 pv, nx;
#pragma unroll
                    for (int j = 0; j < 4; ++j) { pv[j] = dpp_from_prev_lane(U3[j]); nx[j] = dpp_from_next_lane(U0[j]); }
                    Uf[bj] = U0; Ul[bj] = U3;
                    Cc[bj][0] = W1[bj] * U0 + (W0[bj] * pv + (W2[bj] * U1 + Bv[bj]));
                    Cc[bj][1] = W1[bj] * U1 + (W0[bj] * U0 + (W2[bj] * U2 + Bv[bj]));
                    Cc[bj][2] = W1[bj] * U2 + (W0[bj] * U1 + (W2[bj] * U3 + Bv[bj]));
                    Cc[bj][3] = W1[bj] * U3 + (W0[bj] * U2 + (W2[bj] * nx + Bv[bj]));
                    Pf[bj] = Cc[bj][0]; Pl[bj] = Cc[bj][3];
                }
#pragma unroll
                for (int m = 0; m < 4; ++m) { const f32x4 av = Cc[0][m], bv = Cc[1][m]; const f32x4 ea = FOLD ? av : av * (-1.4426950408889634f); f32x4 sv;
#pragma unroll
                    for (int j = 0; j < 4; ++j) sv[j] = __builtin_amdgcn_rcpf(1.0f + __builtin_amdgcn_exp2f(ea[j]));
                    const f32x4 gv4 = (av * sv) * bv;
                    if (g8) { const f32x4 gs = FOLD ? gv4 : gv4 * sg; int t = 0; t = cvt_pk_fp8_sat(gs[0], gs[1], t, false); t = cvt_pk_fp8_sat(gs[2], gs[3], t, true); gw8[ai][m][n] = t; }
                    else { gw[ai][m][n * 2] = cvt_pk_bf16(gv4[0], gv4[1]); gw[ai][m][n * 2 + 1] = cvt_pk_bf16(gv4[2], gv4[3]); } }
                if (fr == 0) {
#pragma unroll
                    for (int bj = 0; bj < 2; ++bj) { const int uc = bj * 11008 + colg + 4 * n; *(f32x4*)(e0 + uc) = Pf[bj]; *(f32x4*)(e0 + 22016 + uc) = Uf[bj] * cs4[bj]; } }
                if (fr == 15) {
#pragma unroll
                    for (int bj = 0; bj < 2; ++bj) { const int uc = bj * 11008 + colg + 4 * n; *(f32x4*)(e0 + 2 * 22016 + uc) = Pl[bj]; *(f32x4*)(e0 + 3 * 22016 + uc) = Ul[bj] * cs4[bj]; } }
            }
        }
#pragma unroll
        for (int ai = 0; ai < 2; ++ai) {
            const int row0 = u.pm * BM + ai * HALF + wr * 64 + 4 * fr;
#pragma unroll
            for (int m = 0; m < 4; ++m) { unsigned char* grow = G + (size_t)(row0 + m) * gpb;
                if (g8) { typedef unsigned u32x2 __attribute__((ext_vector_type(2))); *(u32x2*)(grow + colg) = (u32x2){(unsigned)gw8[ai][m][0], (unsigned)gw8[ai][m][1]}; }
                else { u32x4 w; w.x = gw[ai][m][0]; w.y = gw[ai][m][1]; w.z = gw[ai][m][2]; w.w = gw[ai][m][3]; *(u32x4*)(grow + k8 + (size_t)(colg - k8) * 2) = w; } }
        }
    }
};

typedef int pg8_v8i __attribute__((ext_vector_type(8)));
__device__ __forceinline__ pg8_v8i pg8_cat(bf16x8 a, bf16x8 b) { typedef short s16 __attribute__((ext_vector_type(16))); const s16 c = __builtin_shufflevector(a, b, 0, 1, 2, 3, 4, 5, 6, 7, 8, 9, 10, 11, 12, 13, 14, 15); return __builtin_bit_cast(pg8_v8i, c); }
__device__ __forceinline__ bf16x8 pg8_lo(pg8_v8i v) { typedef int v4i_ __attribute__((ext_vector_type(4))); return __builtin_bit_cast(bf16x8, (v4i_)__builtin_shufflevector(v, v, 0, 1, 2, 3)); }
__device__ __forceinline__ bf16x8 pg8_hi(pg8_v8i v) { typedef int v4i_ __attribute__((ext_vector_type(4))); return __builtin_bit_cast(bf16x8, (v4i_)__builtin_shufflevector(v, v, 4, 5, 6, 7)); }
template <class T, class = void> struct pg8_has_prefetch { static constexpr bool value = false; };
template <class T> struct pg8_has_prefetch<T, decltype((void)T::PREFETCH)> { static constexpr bool value = true; };
template <class Epi> __device__ __forceinline__ void pg8_prefetch(const Epi& E, const Unit& u, int wid, int lane) { if constexpr (pg8_has_prefetch<Epi>::value) E.prefetch(u, wid, lane); }
template <class Epi, class Sched, bool ALIGN_EPI = false, bool SP2 = false>
__device__ __forceinline__ void gemm_phase(PG8_LAS unsigned char* lds, const Gemm g, const Sched& S, const Epi& E) {
    const int tid = threadIdx.x, wid = __builtin_amdgcn_readfirstlane(tid >> 6), lane = tid & 63, wr = wid >> 2, wc = wid & 3, fr = lane & 15, fq = lane >> 4;
    const int K = g.K, nt = K / BK;
    unsigned voffA[2], voffB[2];
#pragma unroll
    for (int i = 0; i < 2; ++i) { int R, C; stage_rc(tid * 16 + i * 8192, R, C); const int Rb = Epi::PERM ? ((R & ~31) + perm32(R & 31)) : R;
        const int Ra = Epi::PERMA ? ((R & ~63) | ((R & 15) << 2) | ((R >> 4) & 3)) : R;
        voffA[i] = (unsigned)(Ra * K + C) * 2u; voffB[i] = (unsigned)(Rb * K + C) * 2u; }
    const size_t kstep = (size_t)(BK * 2);
    const size_t hstep = (size_t)HALF * K * 2;
    const size_t tstep = 2 * hstep;
    const unsigned ldsw = (unsigned)wid * 1024u;
    const int aoff = lds_byte(wr * 64 + fr, fq * 8), boff = lds_byte(wc * 32 + fr, fq * 8);
#define PG8_SA(b, h) (((b) * 2 + (h)) * HTB)
#define PG8_SB(b, h) ((4 + (b) * 2 + (h)) * HTB)
#define PG8_STAGE(bufoff, gbase, voff) do { _Pragma("unroll") for (int _i = 0; _i < 2; ++_i) \
        __builtin_amdgcn_global_load_lds((const unsigned*)((const char*)(gbase) + (voff)[_i]), (PG8_LAS unsigned*)(lds + (bufoff) + ldsw + _i * 8192), 16, 0, 0); } while (0)
#define PG8_LDA(dst, b, h) do { if constexpr (Epi::FP8 || Epi::NT8 > 0) { _Pragma("unroll") for (int m = 0; m < 4; ++m) dst##8[m] = pg8_cat(*(const PG8_LAS bf16x8*)(lds + PG8_SA(b, h) + aoff + m * 2048), *(const PG8_LAS bf16x8*)(lds + PG8_SA(b, h) + aoff + m * 2048 + 1024)); } \
        else { _Pragma("unroll") for (int m = 0; m < 4; ++m) _Pragma("unroll") for (int k = 0; k < 2; ++k) dst[m][k] = *(const PG8_LAS bf16x8*)(lds + PG8_SA(b, h) + aoff + m * 2048 + k * 1024); } } while (0)
#define PG8_LDB(dst, b, h) do { if constexpr (Epi::FP8 || Epi::NT8 > 0) { _Pragma("unroll") for (int n = 0; n < 2; ++n) dst##8[n] = pg8_cat(*(const PG8_LAS bf16x8*)(lds + PG8_SB(b, h) + boff + n * 2048), *(const PG8_LAS bf16x8*)(lds + PG8_SB(b, h) + boff + n * 2048 + 1024)); } \
        else { _Pragma("unroll") for (int n = 0; n < 2; ++n) _Pragma("unroll") for (int k = 0; k < 2; ++k) dst[n][k] = *(const PG8_LAS bf16x8*)(lds + PG8_SB(b, h) + boff + n * 2048 + k * 1024); } } while (0)
#define PG8_MMA8(ai, bj, At, Bt) do { _Pragma("unroll") for (int m = 0; m < 4; ++m) _Pragma("unroll") for (int n = 0; n < 2; ++n) \
        asm volatile("v_mfma_f32_16x16x128_f8f6f4 %0, %1, %2, %0" : "+v"(acc[ai][bj][m][n]) : "v"(Bt##8[n]), "v"(At##8[m])); } while (0)
#ifndef PG8_PRIO
#define PG8_PRIO 1
#endif
#ifndef PG8_PRIO_MMA
#define PG8_PRIO_MMA 1
#endif
#ifndef PG8_PRIO_AFTER
#define PG8_PRIO_AFTER 3
#endif
#define PG8_MMA(ai, bj, At, Bt) do { if (PG8_PRIO) __builtin_amdgcn_s_setprio(PG8_PRIO_MMA); if constexpr (Epi::FP8) { PG8_MMA8(ai, bj, At, Bt); } \
        else if constexpr (Epi::NT8 > 0) { if constexpr (f8now) { PG8_MMA8(ai, bj, At, Bt); } else { _Pragma("unroll") for (int m = 0; m < 4; ++m) _Pragma("unroll") for (int n = 0; n < 2; ++n) { \
            asm volatile("v_mfma_f32_16x16x32_bf16 %0, %1, %2, %0" : "+v"(acc[ai][bj][m][n]) : "v"(pg8_lo(Bt##8[n])), "v"(pg8_lo(At##8[m]))); \
            asm volatile("v_mfma_f32_16x16x32_bf16 %0, %1, %2, %0" : "+v"(acc[ai][bj][m][n]) : "v"(pg8_hi(Bt##8[n])), "v"(pg8_hi(At##8[m]))); } } } \
        else if constexpr (Epi::I8) { _Pragma("unroll") for (int m = 0; m < 4; ++m) _Pragma("unroll") for (int n = 0; n < 2; ++n) _Pragma("unroll") for (int k = 0; k < 2; ++k) \
        asm volatile("v_mfma_i32_16x16x64_i8 %0, %1, %2, %0" : "+v"(acc[ai][bj][m][n]) : "v"(Bt[n][k]), "v"(At[m][k])); } \
        else { _Pragma("unroll") for (int m = 0; m < 4; ++m) _Pragma("unroll") for (int n = 0; n < 2; ++n) _Pragma("unroll") for (int k = 0; k < 2; ++k) \
        acc[ai][bj][m][n] = __builtin_amdgcn_mfma_f32_16x16x32_bf16(Bt[n][k], At[m][k], acc[ai][bj][m][n], 0, 0, 0); } if (PG8_PRIO) __builtin_amdgcn_s_setprio(PG8_PRIO_AFTER); } while (0)
#define PG8_WAIT_V(n) asm volatile("s_waitcnt vmcnt(" #n ")" ::: "memory")
#define PG8_WAIT_L(n) asm volatile("s_waitcnt lgkmcnt(" #n ")" ::: "memory")
#define PG8_BAR __builtin_amdgcn_s_barrier()
#define PG8_SCHED __builtin_amdgcn_sched_barrier(0)
#ifndef PG8_MFMA_ZERO
#define PG8_MFMA_ZERO 1
#endif
    typedef float pg8_f2 __attribute__((ext_vector_type(2))); const pg8_f2 pg8_zero2 = {0.f, 0.f}; (void)pg8_zero2;
    Unit cur, nxt; int ui = 0;
    if (!S.next(0, cur)) return;
    cur.slot = 0; pg8_prefetch(E, cur, wid, lane);
    f32x4 acc[2][2][4][2];
#pragma unroll
    for (int a = 0; a < 2; ++a)
#pragma unroll
        for (int b = 0; b < 2; ++b)
#pragma unroll
            for (int m = 0; m < 4; ++m)
#pragma unroll
                for (int n = 0; n < 2; ++n) acc[a][b][m][n] = (f32x4){0.f, 0.f, 0.f, 0.f};
    bf16x8 At[4][2], B0[2][2], B1[2][2]; pg8_v8i At8[4], B08[2], B18[2];
    const char* cA = (const char*)g.A + (size_t)cur.pm * tstep; const char* cB = (const char*)g.Bt + (size_t)cur.pn * tstep;
    S.a_ready(cur);
    if constexpr (SP2) {
        PG8_STAGE(PG8_SB(0, 0), cB, voffB); PG8_STAGE(PG8_SB(0, 1), cB + hstep, voffB); PG8_STAGE(PG8_SA(0, 0), cA, voffA); PG8_STAGE(PG8_SA(0, 1), cA + hstep, voffA);
        if (wr == 1) PG8_BAR;
        PG8_WAIT_V(2); PG8_BAR;
        PG8_STAGE(PG8_SB(1, 0), cB + kstep, voffB); PG8_STAGE(PG8_SA(1, 0), cA + kstep, voffA); PG8_STAGE(PG8_SB(1, 1), cB + hstep + kstep, voffB);
        PG8_WAIT_V(6); PG8_BAR;
    } else {
        PG8_STAGE(PG8_SB(0, 0), cB, voffB); PG8_STAGE(PG8_SA(0, 0), cA, voffA); PG8_STAGE(PG8_SB(0, 1), cB + hstep, voffB); PG8_STAGE(PG8_SA(0, 1), cA + hstep, voffA);
        if (wr == 1) PG8_BAR;
        PG8_WAIT_V(4); PG8_BAR;
        PG8_STAGE(PG8_SB(1, 0), cB + kstep, voffB); PG8_STAGE(PG8_SA(1, 0), cA + kstep, voffA); PG8_STAGE(PG8_SB(1, 1), cB + hstep + kstep, voffB);
        PG8_WAIT_V(6); PG8_BAR;
    }
    for (;;) {
        const bool has_next = S.next(ui + 1, nxt);
        const char* nA = has_next ? (const char*)g.A + (size_t)nxt.pm * tstep : cA; const char* nB = has_next ? (const char*)g.Bt + (size_t)nxt.pn * tstep : cB;
        for (int t = 0; t < (Epi::NT8 > 0 ? Epi::NT8 : 0); t += 2) {
            const bool last = (t == nt - 2);
            constexpr bool f8now = true; (void)f8now;
            const char* a1 = cA + (size_t)(t + 1) * kstep;
            const char* a2 = last ? nA : cA + (size_t)(t + 2) * kstep; const char* b2 = last ? nB : cB + (size_t)(t + 2) * kstep;
            const char* a3 = a2 + kstep; const char* b3 = b2 + kstep;
            if (last && has_next) S.a_ready(nxt);
            if constexpr (SP2) {
            PG8_LDB(B0, 0, 0); PG8_LDB(B1, 0, 1); PG8_SCHED; PG8_LDA(At, 0, 0); PG8_STAGE(PG8_SA(1, 1), a1 + hstep, voffA);
            PG8_WAIT_V(8); PG8_WAIT_L(0); PG8_BAR; PG8_MMA(0, 0, At, B0); PG8_MMA(0, 1, At, B1); PG8_BAR; PG8_SCHED;
            PG8_LDA(At, 0, 1); PG8_STAGE(PG8_SB(0, 0), b2, voffB); PG8_STAGE(PG8_SB(0, 1), b2 + hstep, voffB); PG8_STAGE(PG8_SA(0, 0), a2, voffA);
            PG8_WAIT_V(8); PG8_WAIT_L(0); PG8_BAR; PG8_MMA(1, 0, At, B0); PG8_MMA(1, 1, At, B1); PG8_BAR; PG8_SCHED;
            PG8_LDB(B0, 1, 0); PG8_LDB(B1, 1, 1); PG8_SCHED; PG8_LDA(At, 1, 0); PG8_STAGE(PG8_SA(0, 1), a2 + hstep, voffA);
            PG8_WAIT_V(8); PG8_WAIT_L(0); PG8_BAR; PG8_MMA(0, 0, At, B0); PG8_MMA(0, 1, At, B1); PG8_BAR; PG8_SCHED;
            PG8_LDA(At, 1, 1); PG8_STAGE(PG8_SB(1, 0), b3, voffB); PG8_STAGE(PG8_SB(1, 1), b3 + hstep, voffB); PG8_STAGE(PG8_SA(1, 0), a3, voffA);
            PG8_WAIT_V(8); PG8_WAIT_L(0); PG8_BAR; PG8_MMA(1, 0, At, B0); PG8_MMA(1, 1, At, B1); PG8_BAR; PG8_SCHED;
            } else {
            PG8_LDB(B0, 0, 0); PG8_SCHED; PG8_LDA(At, 0, 0); PG8_STAGE(PG8_SA(1, 1), a1 + hstep, voffA);
            PG8_WAIT_L(8); PG8_BAR; PG8_WAIT_L(0); PG8_MMA(0, 0, At, B0); PG8_BAR; PG8_SCHED;
            PG8_LDB(B1, 0, 1); PG8_STAGE(PG8_SB(0, 0), b2, voffB);
            PG8_BAR; PG8_WAIT_L(0); PG8_MMA(0, 1, At, B1); PG8_BAR;
            PG8_LDA(At, 0, 1); PG8_STAGE(PG8_SA(0, 0), a2, voffA);
            PG8_BAR; PG8_WAIT_L(0); PG8_MMA(1, 0, At, B0); PG8_BAR; PG8_SCHED;
            PG8_STAGE(PG8_SB(0, 1), b2 + hstep, voffB);
            PG8_WAIT_V(6); PG8_BAR; PG8_MMA(1, 1, At, B1); PG8_BAR;
            PG8_LDB(B0, 1, 0); PG8_SCHED; PG8_LDA(At, 1, 0); PG8_STAGE(PG8_SA(0, 1), a2 + hstep, voffA);
            PG8_WAIT_L(8); PG8_BAR; PG8_WAIT_L(0); PG8_MMA(0, 0, At, B0); PG8_BAR; PG8_SCHED;
            PG8_LDB(B1, 1, 1); PG8_STAGE(PG8_SB(1, 0), b3, voffB);
            PG8_BAR; PG8_WAIT_L(0); PG8_MMA(0, 1, At, B1); PG8_BAR;
            PG8_LDA(At, 1, 1); PG8_STAGE(PG8_SA(1, 0), a3, voffA);
            PG8_BAR; PG8_WAIT_L(0); PG8_MMA(1, 0, At, B0); PG8_BAR; PG8_SCHED;
            PG8_STAGE(PG8_SB(1, 1), b3 + hstep, voffB);
            PG8_WAIT_V(6); PG8_BAR; PG8_MMA(1, 1, At, B1); PG8_BAR;
            }
        }
        if constexpr (Epi::NT8 > 0) { const float rs_ = E.mix_rescale();
#pragma unroll
            for (int a_ = 0; a_ < 2; ++a_)
#pragma unroll
                for (int b_ = 0; b_ < 2; ++b_)
#pragma unroll
                    for (int m_ = 0; m_ < 4; ++m_)
#pragma unroll
                        for (int n_ = 0; n_ < 2; ++n_) acc[a_][b_][m_][n_] *= rs_; }
        for (int t = (Epi::NT8 > 0 ? Epi::NT8 : 0); t < nt; t += 2) {
            const bool last = (t == nt - 2);
            constexpr bool f8now = false; (void)f8now;
            const char* a1 = cA + (size_t)(t + 1) * kstep;
            const char* a2 = last ? nA : cA + (size_t)(t + 2) * kstep; const char* b2 = last ? nB : cB + (size_t)(t + 2) * kstep;
            const char* a3 = a2 + kstep; const char* b3 = b2 + kstep;
            if (last && has_next) S.a_ready(nxt);
            if constexpr (SP2) {
            PG8_LDB(B0, 0, 0); PG8_LDB(B1, 0, 1); PG8_SCHED; PG8_LDA(At, 0, 0); PG8_STAGE(PG8_SA(1, 1), a1 + hstep, voffA);
            PG8_WAIT_V(8); PG8_WAIT_L(0); PG8_BAR; PG8_MMA(0, 0, At, B0); PG8_MMA(0, 1, At, B1); PG8_BAR; PG8_SCHED;
            PG8_LDA(At, 0, 1); PG8_STAGE(PG8_SB(0, 0), b2, voffB); PG8_STAGE(PG8_SB(0, 1), b2 + hstep, voffB); PG8_STAGE(PG8_SA(0, 0), a2, voffA);
            PG8_WAIT_V(8); PG8_WAIT_L(0); PG8_BAR; PG8_MMA(1, 0, At, B0); PG8_MMA(1, 1, At, B1); PG8_BAR; PG8_SCHED;
            PG8_LDB(B0, 1, 0); PG8_LDB(B1, 1, 1); PG8_SCHED; PG8_LDA(At, 1, 0); PG8_STAGE(PG8_SA(0, 1), a2 + hstep, voffA);
            PG8_WAIT_V(8); PG8_WAIT_L(0); PG8_BAR; PG8_MMA(0, 0, At, B0); PG8_MMA(0, 1, At, B1); PG8_BAR; PG8_SCHED;
            PG8_LDA(At, 1, 1); PG8_STAGE(PG8_SB(1, 0), b3, voffB); PG8_STAGE(PG8_SB(1, 1), b3 + hstep, voffB); PG8_STAGE(PG8_SA(1, 0), a3, voffA);
            PG8_WAIT_V(8); PG8_WAIT_L(0); PG8_BAR; PG8_MMA(1, 0, At, B0); PG8_MMA(1, 1, At, B1); PG8_BAR; PG8_SCHED;
            } else {
            PG8_LDB(B0, 0, 0); PG8_SCHED; PG8_LDA(At, 0, 0); PG8_STAGE(PG8_SA(1, 1), a1 + hstep, voffA);
            PG8_WAIT_L(8); PG8_BAR; PG8_WAIT_L(0); PG8_MMA(0, 0, At, B0); PG8_BAR; PG8_SCHED;
            PG8_LDB(B1, 0, 1); PG8_STAGE(PG8_SB(0, 0), b2, voffB);
            PG8_BAR; PG8_WAIT_L(0); PG8_MMA(0, 1, At, B1); PG8_BAR;
            PG8_LDA(At, 0, 1); PG8_STAGE(PG8_SA(0, 0), a2, voffA);
            PG8_BAR; PG8_WAIT_L(0); PG8_MMA(1, 0, At, B0); PG8_BAR; PG8_SCHED;
            PG8_STAGE(PG8_SB(0, 1), b2 + hstep, voffB);
            PG8_WAIT_V(6); PG8_BAR; PG8_MMA(1, 1, At, B1); PG8_BAR;
            PG8_LDB(B0, 1, 0); PG8_SCHED; PG8_LDA(At, 1, 0); PG8_STAGE(PG8_SA(0, 1), a2 + hstep, voffA);
            PG8_WAIT_L(8); PG8_BAR; PG8_WAIT_L(0); PG8_MMA(0, 0, At, B0); PG8_BAR; PG8_SCHED;
            PG8_LDB(B1, 1, 1); PG8_STAGE(PG8_SB(1, 0), b3, voffB);
            PG8_BAR; PG8_WAIT_L(0); PG8_MMA(0, 1, At, B1); PG8_BAR;
            PG8_LDA(At, 1, 1); PG8_STAGE(PG8_SA(1, 0), a3, voffA);
            PG8_BAR; PG8_WAIT_L(0); PG8_MMA(1, 0, At, B0); PG8_BAR; PG8_SCHED;
            PG8_STAGE(PG8_SB(1, 1), b3 + hstep, voffB);
            PG8_WAIT_V(6); PG8_BAR; PG8_MMA(1, 1, At, B1); PG8_BAR;
            }
        }
        if constexpr (ALIGN_EPI) { if (wr == 0) PG8_BAR; }
#ifdef PROBE_EPI2
        if constexpr (!Epi::AFTER_DRAIN) { if constexpr (Epi::I8) {
                int reps_ = 2; asm volatile("" : "+s"(reps_));
#pragma unroll 1
                for (int rep_ = 0; rep_ < reps_; ++rep_) { asm volatile("" ::: "memory"); E(acc, cur, wr, wc, fr, fq); } }
            else E(acc, cur, wr, wc, fr, fq);
            S.done(cur); }
#else
        if constexpr (!Epi::AFTER_DRAIN) { E(acc, cur, wr, wc, fr, fq); S.done(cur); }
#endif
        if (!has_next) break;
#if PG8_MFMA_ZERO
        asm volatile("s_nop 7\n\ts_nop 7" ::: "memory");
#endif
#pragma unroll
        for (int a = 0; a < 2; ++a)
#pragma unroll
            for (int b = 0; b < 2; ++b)
#pragma unroll
                for (int m = 0; m < 4; ++m)
#pragma unroll
                    for (int n = 0; n < 2; ++n) {
#if PG8_MFMA_ZERO
                        asm volatile("v_mfma_f32_4x4x4_16b_f16 %0, %1, %1, 0" : "=v"(acc[a][b][m][n]) : "v"(pg8_zero2));
#else
                        acc[a][b][m][n] = (f32x4){0.f, 0.f, 0.f, 0.f};
#endif
                    }
#if PG8_MFMA_ZERO
        asm volatile("s_nop 7\n\ts_nop 7\n\ts_nop 7" ::: "memory");
#endif
        cur = nxt; cA = nA; cB = nB; ++ui; cur.slot = ui & 1; pg8_prefetch(E, cur, wid, lane);
        if constexpr (ALIGN_EPI) { if (wr == 1) PG8_BAR; }
    }
    PG8_WAIT_V(0);
    if constexpr (!ALIGN_EPI) { if (wr == 0) PG8_BAR; }
    PG8_BAR;
    if (PG8_PRIO) __builtin_amdgcn_s_setprio(0);
    if constexpr (Epi::AFTER_DRAIN) { E.fused(acc, cur, wr, wc, fr, fq, lds, wid, lane); S.done(cur); }
#undef PG8_SA
#undef PG8_SB
#undef PG8_STAGE
#undef PG8_LDA
#undef PG8_LDB
#undef PG8_MMA
#undef PG8_WAIT_V
#undef PG8_WAIT_L
#undef PG8_BAR
#undef PG8_SCHED
}
}
#define ATT_LAS __attribute__((address_space(3)))
namespace att {
typedef unsigned short bf16;
using bf16x8 = __attribute__((ext_vector_type(8))) short;
using s16x4  = __attribute__((ext_vector_type(4))) short;
using f32x16 = __attribute__((ext_vector_type(16))) float;
using f32x4  = __attribute__((ext_vector_type(4))) float;
using u32x4  = __attribute__((ext_vector_type(4))) unsigned;
constexpr int NW = 8, QBLK = 32, KVBLK = 64;
constexpr float THR = 8.f;
#ifndef ATT_SRCC
#define ATT_SRCC 1
#endif
#define ATT_KS8 (ATT_SRCC ? 0.5f : 16.0f)
constexpr int SHM_V = KVBLK * 128 * 2;
constexpr int SHM_KMAX = KVBLK * (192 * 2 + 16);
constexpr int OFF_K = 3 * SHM_V, OFF_WS = OFF_K + 2 * SHM_KMAX, ATT_LDS = OFF_WS + NW * 64 * 4;
constexpr int OPITCH = 272;
static_assert(NW * 32 * OPITCH <= OFF_WS, "output staging fits under the K/V buffers");
#define ATT_SBAR() __builtin_amdgcn_sched_barrier(0)
template <int DQK, bool KF8 = false> __device__ __forceinline__ constexpr int kpitch() { return DQK * (KF8 ? 1 : 2) + 16; }
template <int DQK> __device__ __forceinline__ int kswz(int row, int cb) { return row * kpitch<DQK>() + cb; }
__device__ __forceinline__ int crow(int r, int hi) { return (r & 3) + 8 * (r >> 2) + 4 * hi; }
__device__ __forceinline__ unsigned cvtpk(float lo, float hi) { unsigned r; asm volatile("v_cvt_pk_bf16_f32 %0, %1, %2" : "=v"(r) : "v"(lo), "v"(hi)); return r; }
__device__ __forceinline__ float bf2f(unsigned short b) { return __uint_as_float(((unsigned)b) << 16); }

template <bool MASKABLE>
__device__ __forceinline__ void partialSM(f32x16& p0, f32x16& p1, float& m_reg, float& mn, float& alpha, const float C, const float thr_raw, const float pl2, const bool domask, const int mbase) {
  if (MASKABLE) { if (domask) {
#pragma unroll
    for (int r = 0; r < 16; ++r) { const int off = (r & 3) + 8 * (r >> 2);
      p0[r] = ((unsigned)(mbase + off) > 256u) ? -1e30f : p0[r]; p1[r] = ((unsigned)(mbase + 32 + off) > 256u) ? -1e30f : p1[r]; } } }
  float pmax = p0[0];
#pragma unroll
  for (int r = 1; r < 16; ++r) pmax = fmaxf(pmax, p0[r]);
#pragma unroll
  for (int r = 0; r < 16; ++r) pmax = fmaxf(pmax, p1[r]);
  { auto rr = __builtin_amdgcn_permlane32_swap(__float_as_uint(pmax), __float_as_uint(pmax), false, false);
    pmax = fmaxf(__uint_as_float(rr[0]), __uint_as_float(rr[1])); }
  if (__builtin_expect(__all(pmax - m_reg <= thr_raw), 1)) { mn = m_reg; alpha = 1.f; }
  else { mn = fmaxf(m_reg, pmax); alpha = __builtin_amdgcn_exp2f((m_reg - mn) * C); m_reg = mn; }
  const float mnC = pl2 - mn * C;
#pragma unroll
  for (int r = 0; r < 16; ++r) p0[r] = fmaf(p0[r], C, mnC);
#pragma unroll
  for (int r = 0; r < 16; ++r) p1[r] = fmaf(p1[r], C, mnC);
#pragma unroll
  for (int r = 0; r < 16; ++r) p0[r] = __builtin_amdgcn_exp2f(p0[r]);
}
template <bool MASKABLE, bool FIRST>
__device__ __forceinline__ void partialSM2(f32x16& p0, f32x16& p1, float& m_reg, float& alpha, const float thr_l2, const float pl2, const bool domask, const int mbase) {
  if (MASKABLE) { if (domask) {
#pragma unroll
    for (int r = 0; r < 16; ++r) { const int off = (r & 3) + 8 * (r >> 2);
      p0[r] = ((unsigned)(mbase + off) > 256u) ? -1e30f : p0[r]; p1[r] = ((unsigned)(mbase + 32 + off) > 256u) ? -1e30f : p1[r]; } } }
  float pmax = p0[0];
#pragma unroll
  for (int r = 1; r < 16; ++r) pmax = fmaxf(pmax, p0[r]);
#pragma unroll
  for (int r = 0; r < 16; ++r) pmax = fmaxf(pmax, p1[r]);
  { auto rr = __builtin_amdgcn_permlane32_swap(__float_as_uint(pmax), __float_as_uint(pmax), false, false);
    pmax = fmaxf(__uint_as_float(rr[0]), __uint_as_float(rr[1])); }
  const float rel = pmax - pl2;
  if (!FIRST && __builtin_expect(__all(rel <= thr_l2), 1)) { alpha = 1.f; }
  else { const float d = FIRST ? rel : fmaxf(rel, 0.f); alpha = FIRST ? 1.f : __builtin_amdgcn_exp2f(-d); m_reg += d;
#pragma unroll
    for (int r = 0; r < 16; ++r) { p0[r] -= d; p1[r] -= d; } }
#pragma unroll
  for (int r = 0; r < 16; ++r) p0[r] = __builtin_amdgcn_exp2f(p0[r]);
}
__device__ __forceinline__ void finishSM(f32x16& p0, f32x16& p1, float alpha, float& l_reg, bf16x8& pa0, bf16x8& pa1, bf16x8& pa2, bf16x8& pa3) {
#pragma unroll
  for (int r = 0; r < 16; ++r) p1[r] = __builtin_amdgcn_exp2f(p1[r]);
  float ps = 0;
#pragma unroll
  for (int r = 0; r < 16; ++r) ps += p0[r];
#pragma unroll
  for (int r = 0; r < 16; ++r) ps += p1[r];
  { auto rr = __builtin_amdgcn_permlane32_swap(__float_as_uint(ps), __float_as_uint(ps), false, false);
    ps = __uint_as_float(rr[0]) + __uint_as_float(rr[1]); }
  l_reg = l_reg * alpha + ps;
#define ATT_PK4(P, BASE, OUT) do { unsigned a0 = cvtpk(P[BASE + 0], P[BASE + 1]), a1 = cvtpk(P[BASE + 2], P[BASE + 3]);   \
    unsigned b0 = cvtpk(P[BASE + 4], P[BASE + 5]), b1 = cvtpk(P[BASE + 6], P[BASE + 7]);                              \
    auto r0 = __builtin_amdgcn_permlane32_swap(a0, b0, false, false); auto r1 = __builtin_amdgcn_permlane32_swap(a1, b1, false, false); \
    u32x4 w = {r0[0], r1[0], r0[1], r1[1]}; OUT = *reinterpret_cast<bf16x8*>(&w); } while (0)
  ATT_PK4(p0, 0, pa0); ATT_PK4(p0, 8, pa1); ATT_PK4(p1, 0, pa2); ATT_PK4(p1, 8, pa3);
#undef ATT_PK4
}
template <int DQK>
__device__ __forceinline__ void qkt(f32x16& p0, f32x16& p1, const char* Ks, const bf16x8* qr, int r32, int hi) {
  p0 = f32x16{}; p1 = f32x16{};
  const char* kb = Ks + r32 * kpitch<DQK>() + hi * 16;
#pragma unroll
  for (int d0 = 0; d0 < DQK / 16; ++d0) {
    const bf16x8 b0 = *reinterpret_cast<const bf16x8*>(kb + d0 * 32);
    const bf16x8 b1 = *reinterpret_cast<const bf16x8*>(kb + d0 * 32 + 32 * kpitch<DQK>());
    p0 = __builtin_amdgcn_mfma_f32_32x32x16_bf16(b0, qr[d0], p0, 0, 0, 0);
    p1 = __builtin_amdgcn_mfma_f32_32x32x16_bf16(b1, qr[d0], p1, 0, 0, 0);
    if ((d0 & 3) == 3) ATT_SBAR(); }
}
typedef int v8i __attribute__((ext_vector_type(8)));
template <int DQK>
__device__ __forceinline__ void qkt8(f32x16& p0, f32x16& p1, const char* Ks, const v8i* qf, int r32, int hi, const float cinit = 0.f) {
#pragma unroll
  for (int r = 0; r < 16; ++r) { p0[r] = cinit; p1[r] = cinit; }
  constexpr int KP = kpitch<DQK, true>();
  const char* kb = Ks + r32 * KP + hi * 32;
#pragma unroll
  for (int s = 0; s < DQK / 64; ++s) {
    typedef int v4i __attribute__((ext_vector_type(4)));
    const v4i a00 = *reinterpret_cast<const v4i*>(kb + s * 64), a01 = *reinterpret_cast<const v4i*>(kb + s * 64 + 16);
    const v4i a10 = *reinterpret_cast<const v4i*>(kb + s * 64 + 32 * KP), a11 = *reinterpret_cast<const v4i*>(kb + s * 64 + 32 * KP + 16);
    const v8i a0 = __builtin_shufflevector(a00, a01, 0, 1, 2, 3, 4, 5, 6, 7), a1 = __builtin_shufflevector(a10, a11, 0, 1, 2, 3, 4, 5, 6, 7);
    p0 = __builtin_amdgcn_mfma_scale_f32_32x32x64_f8f6f4(a0, qf[s], p0, 0, 0, 0, 0, 0, 0);
    p1 = __builtin_amdgcn_mfma_scale_f32_32x32x64_f8f6f4(a1, qf[s], p1, 0, 0, 0, 0, 0, 0); }
}
__device__ __forceinline__ int v_st(int k, int c) { const int kk = (k & ~0xC) | ((k & 4) << 1) | ((k & 8) >> 1); return ((kk >> 3) * 4 + (c >> 5)) * 512 + ((kk & 7) * 32 + (c & 31)) * 2; }
__device__ __forceinline__ int v_rd_base(int lane) { return ((lane & 3) << 3) | (((lane >> 2) & 3) << 6) | (((lane >> 4) & 1) << 5) | (((lane >> 5) & 1) << 8); }
constexpr int v_rd_off(int d0, int ks, int half) { return d0 * 512 + ks * 4096 + half * 2048; }
template <int OFF> __device__ __forceinline__ s16x4 tr_read(int vb) {
  s16x4 r; asm volatile("ds_read_b64_tr_b16 %0, %1 offset:%2" : "=&v"(r) : "v"(vb), "i"(OFF) : "memory"); return r;
}
template <int D0> __device__ __forceinline__ void pv_one(f32x16& od, int vb, bf16x8 pa0, bf16x8 pa1, bf16x8 pa2, bf16x8 pa3) {
  const s16x4 l0 = tr_read<v_rd_off(D0, 0, 0)>(vb), h0 = tr_read<v_rd_off(D0, 0, 1)>(vb), l1 = tr_read<v_rd_off(D0, 1, 0)>(vb), h1 = tr_read<v_rd_off(D0, 1, 1)>(vb);
  const s16x4 l2 = tr_read<v_rd_off(D0, 2, 0)>(vb), h2 = tr_read<v_rd_off(D0, 2, 1)>(vb), l3 = tr_read<v_rd_off(D0, 3, 0)>(vb), h3 = tr_read<v_rd_off(D0, 3, 1)>(vb);
  asm volatile("s_waitcnt lgkmcnt(0)" ::: "memory"); ATT_SBAR();
#define ATT_PK(L, H) (bf16x8){L[0], L[1], L[2], L[3], H[0], H[1], H[2], H[3]}
  od = __builtin_amdgcn_mfma_f32_32x32x16_bf16(pa0, ATT_PK(l0, h0), od, 0, 0, 0);
  od = __builtin_amdgcn_mfma_f32_32x32x16_bf16(pa1, ATT_PK(l1, h1), od, 0, 0, 0);
  od = __builtin_amdgcn_mfma_f32_32x32x16_bf16(pa2, ATT_PK(l2, h2), od, 0, 0, 0);
  od = __builtin_amdgcn_mfma_f32_32x32x16_bf16(pa3, ATT_PK(l3, h3), od, 0, 0, 0);
#undef ATT_PK
}
__device__ __forceinline__ void pv_d0(f32x16* o, int vb, bf16x8 pa0, bf16x8 pa1, bf16x8 pa2, bf16x8 pa3) {
  pv_one<0>(o[0], vb, pa0, pa1, pa2, pa3); pv_one<1>(o[1], vb, pa0, pa1, pa2, pa3); pv_one<2>(o[2], vb, pa0, pa1, pa2, pa3); pv_one<3>(o[3], vb, pa0, pa1, pa2, pa3);
}

constexpr int VT8_PITCH = 80, VT8_BYTES = 128 * VT8_PITCH;
__device__ __forceinline__ int pk4_fp8(float a, float b, float c, float d) { int t = 0; t = __builtin_amdgcn_cvt_pk_fp8_f32(a, b, t, false); t = __builtin_amdgcn_cvt_pk_fp8_f32(c, d, t, true); return t; }
__device__ __forceinline__ void finishSM8(f32x16& p0, f32x16& p1, float alpha, float& l_reg, v8i& pa) {
#pragma unroll
  for (int r = 0; r < 16; ++r) p1[r] = __builtin_amdgcn_exp2f(p1[r]);
  float ps = 0;
#pragma unroll
  for (int r = 0; r < 16; ++r) ps += p0[r];
#pragma unroll
  for (int r = 0; r < 16; ++r) ps += p1[r];
  { auto rr = __builtin_amdgcn_permlane32_swap(__float_as_uint(ps), __float_as_uint(ps), false, false);
    ps = __uint_as_float(rr[0]) + __uint_as_float(rr[1]); }
  l_reg = l_reg * alpha + ps;
#pragma unroll
  for (int i = 0; i < 4; ++i) { pa[i] = pk4_fp8(p0[4 * i], p0[4 * i + 1], p0[4 * i + 2], p0[4 * i + 3]); pa[4 + i] = pk4_fp8(p1[4 * i], p1[4 * i + 1], p1[4 * i + 2], p1[4 * i + 3]); }
}
__device__ __forceinline__ void pv8_d0(f32x16* o, const char* vp, v8i pa) {
  typedef int v4i __attribute__((ext_vector_type(4)));
#pragma unroll
  for (int d0 = 0; d0 < 4; ++d0) { const v4i x0 = *reinterpret_cast<const v4i*>(vp + d0 * 32 * VT8_PITCH), x1 = *reinterpret_cast<const v4i*>(vp + d0 * 32 * VT8_PITCH + 16);
    const v8i bf = __builtin_shufflevector(x0, x1, 0, 1, 2, 3, 4, 5, 6, 7);
    o[d0] = __builtin_amdgcn_mfma_scale_f32_32x32x64_f8f6f4(pa, bf, o[d0], 0, 0, 0, 0, 0, 0); }
}

template <int DQK> __device__ __forceinline__ constexpr float q8_scale() { return (ATT_SRCC != 0) ? (DQK == 192 ? 0.07216878364870323f : 0.08838834764831845f) * 1.4426950408889634f / ATT_KS8 : 16.0f; }
template <int DQK, bool QNORM, bool MASKABLE, bool OFP8, bool KF8, bool VF8, bool Q8IN = false>
__device__ __forceinline__ void attn_body(const bf16* __restrict__ Qlane, const float* __restrict__ gq, const float* __restrict__ rope, int qrow, int qcol,
                                          const bf16* __restrict__ K0, long ldk, const bf16* __restrict__ V0, long ldv, int a0, int nA, int b0, int nB, int jB, int qi,
                                          float sink_l2, bf16* __restrict__ Owave, long ldo, char* lds, ATT_LAS unsigned char* ldsl, const int tid) {
  constexpr float SCALE = DQK == 192 ? 0.07216878364870323f : 0.08838834764831845f;
  constexpr bool SRCC = KF8 && (ATT_SRCC != 0);
  constexpr float QKS = KF8 ? 256.0f : 1.0f;
  constexpr float C = SRCC ? 1.0f : SCALE * 1.4426950408889634f / QKS;
  constexpr float THR_RAW = (VF8 ? 2.f : THR) / SCALE * QKS;
  constexpr float THR_L2 = (VF8 ? 2.f : THR) * 1.4426950408889634f;
  constexpr float SQ8 = SRCC ? SCALE * 1.4426950408889634f / ATT_KS8 : 16.0f;
  constexpr int SHMV = VF8 ? VT8_BYTES : SHM_V;
  constexpr float PL2 = VF8 ? 5.0f : 0.0f;
  constexpr int SHM_K = KVBLK * kpitch<DQK, KF8>();
  constexpr int KP = DQK / 64;
  const int wid = __builtin_amdgcn_readfirstlane(tid >> 6), lane = tid & 63, r32 = lane & 31, hi = lane >> 5;
  char* V_lds = lds; char* K_lds = lds + OFF_K;
  float* ws = (float*)(lds + OFF_WS) + wid * 64; float* li_l = ws; float* al_l = ws + 32;
  float m_reg = (KF8 && (ATT_SRCC != 0)) ? 0.f : -1e30f, l_reg = 0; f32x16 o[4] = {}; bf16x8 qr[KF8 ? 1 : DQK / 16]; v8i qf[KF8 ? DQK / 64 : 1];
  bf16x8 qw[(KF8 && !(Q8IN && !QNORM)) ? DQK / 64 : 1][4];
  if constexpr (KF8 && !(Q8IN && !QNORM)) { const bf16* Qw0 = Qlane + hi * 32;
#pragma unroll
    for (int s_ = 0; s_ < DQK / 64; ++s_)
#pragma unroll
      for (int i = 0; i < 4; ++i) qw[s_][i] = *reinterpret_cast<const bf16x8*>(Qw0 + s_ * 64 + i * 8); }
  asm volatile("" ::: "memory");
  constexpr int KPITCH = kpitch<DQK, KF8>(), KSLOTW = SHM_K / 1024, KI = (KSLOTW + 7) / 8, KROWB = DQK * (KF8 ? 1 : 2), KES = KF8 ? 1 : 2;
  int koff[KI], voff[2];
#pragma unroll
  for (int i = 0; i < KI; ++i) { const int p = ((i * 8 + wid) * 64 + lane) * 16; const int row = p / KPITCH; int cb = p - row * KPITCH; if (cb >= KROWB) cb = 0; koff[i] = row * (int)ldk * KES + cb; }
  if constexpr (!VF8) {
#pragma unroll
  for (int i = 0; i < 2; ++i) { const int p = (i * 8 + wid) * 64 + lane; const int sub = p >> 5; const int kk = ((sub >> 2) << 3) | ((p >> 2) & 7); const int k = (kk & ~0xC) | ((kk & 4) << 1) | ((kk & 8) >> 1);
    const int c = (sub & 3) * 32 + (p & 3) * 8; voff[i] = k * (int)ldv * 2 + c * 2; }
  } else { voff[0] = (wid * 64 + lane) * 16; voff[1] = ((8 + wid) * 64 + lane) * 16; }
  const int vbase = (int)(uintptr_t)V_lds + v_rd_base(lane);
  const char* vp8 = V_lds + r32 * VT8_PITCH + hi * 32;
  const int NT = nA + nB;
#define ATT_TROW(t) ((t) < nA ? a0 + 64 * (t) : b0 + 64 * ((t) - nA))
#define ATT_DMA(t, kbsel, vbyte) do { const long r0_ = ATT_TROW(t); const char* kt_ = (const char*)K0 + r0_ * ldk * KES; const char* vt_ = VF8 ? (const char*)V0 + (r0_ >> 6) * ldv : (const char*)V0 + r0_ * ldv * 2; \
    _Pragma("unroll") for (int i_ = 0; i_ < KI; ++i_) { const int s_ = i_ * 8 + wid; if (s_ < KSLOTW) __builtin_amdgcn_global_load_lds((const unsigned*)(kt_ + koff[i_]), (ATT_LAS unsigned*)(ldsl + OFF_K + (kbsel) * SHM_K + s_ * 1024), 16, 0, 0); } \
    _Pragma("unroll") for (int i_ = 0; i_ < 2; ++i_) { if (!VF8 || i_ * 8 + wid < VT8_BYTES / 1024) __builtin_amdgcn_global_load_lds((const unsigned*)(vt_ + voff[i_]), (ATT_LAS unsigned*)(ldsl + (vbyte) + (i_ * 8 + wid) * 1024), 16, 0, 0); } } while (0)
  ATT_DMA(0, 0, 0); ATT_DMA(1, 1, SHMV);
  if constexpr (KF8 && Q8IN && !QNORM) {
    typedef int v4i_q __attribute__((ext_vector_type(4))); const char* Q8 = (const char*)Qlane + hi * 32;
#pragma unroll
    for (int s_ = 0; s_ < DQK / 64; ++s_) { const v4i_q a_ = *reinterpret_cast<const v4i_q*>(Q8 + s_ * 64), b_ = *reinterpret_cast<const v4i_q*>(Q8 + s_ * 64 + 16); qf[s_] = __builtin_shufflevector(a_, b_, 0, 1, 2, 3, 4, 5, 6, 7); }
  } else if constexpr (KF8) {
    constexpr int NS = DQK / 64; float y[NS][32];
    const bf16* Qw = Qlane + hi * 32;
#pragma unroll
    for (int s_ = 0; s_ < NS; ++s_)
#pragma unroll
      for (int i = 0; i < 4; ++i) { const bf16x8 w = qw[s_][i];
#pragma unroll
        for (int e = 0; e < 8; ++e) y[s_][i * 8 + e] = bf2f((unsigned short)w[e]); }
    if constexpr (QNORM) {
      float ss = 0.f;
#pragma unroll
      for (int s_ = 0; s_ < NS; ++s_)
#pragma unroll
        for (int e = 0; e < 32; ++e) ss = fmaf(y[s_][e], y[s_][e], ss);
      ss += __shfl_xor(ss, 32);
      const float rn = 1.0f / sqrtf(ss * (1.0f / DQK) + 1e-6f);
#pragma unroll
      for (int s_ = 0; s_ < NS; ++s_)
#pragma unroll
        for (int i = 0; i < 8; ++i) { const f32x4 g4 = *(const f32x4*)(gq + s_ * 64 + hi * 32 + i * 4);
#pragma unroll
          for (int e = 0; e < 4; ++e) y[s_][i * 4 + e] *= rn * g4[e]; }
      if (rope != nullptr && DQK == 192) {
        const int pos = hi ? qcol : qrow; const float* tp = rope + (size_t)pos * 32;
#pragma unroll
        for (int j = 0; j < 16; ++j) { const float cs = tp[2 * j], sn = tp[2 * j + 1]; const float x1 = y[NS - 1][j], x2 = y[NS - 1][16 + j];
          y[NS - 1][j] = x1 * cs - x2 * sn; y[NS - 1][16 + j] = x1 * sn + x2 * cs; }
      }
    }
#pragma unroll
    for (int s_ = 0; s_ < NS; ++s_)
#pragma unroll
      for (int i = 0; i < 8; ++i) { int t = 0; t = __builtin_amdgcn_cvt_pk_fp8_f32(y[s_][4 * i] * SQ8, y[s_][4 * i + 1] * SQ8, t, false); t = __builtin_amdgcn_cvt_pk_fp8_f32(y[s_][4 * i + 2] * SQ8, y[s_][4 * i + 3] * SQ8, t, true); qf[s_][i] = t; }
  } else
  {
    const bf16* Qw = Qlane + hi * 8;
    if constexpr (!QNORM) {
#pragma unroll
      for (int d0 = 0; d0 < DQK / 16; ++d0) qr[d0] = *reinterpret_cast<const bf16x8*>(Qw + d0 * 16);
    } else {
      float ss = 0.f;
#pragma unroll
      for (int d0 = 0; d0 < DQK / 16; ++d0) { qr[d0] = *reinterpret_cast<const bf16x8*>(Qw + d0 * 16);
#pragma unroll
        for (int e = 0; e < 8; ++e) { const float x = bf2f((unsigned short)qr[d0][e]); ss = fmaf(x, x, ss); } }
      ss += __shfl_xor(ss, 32);
      const float rn = 1.0f / sqrtf(ss * (1.0f / DQK) + 1e-6f);
      float y[DQK / 16][8];
#pragma unroll
      for (int d0 = 0; d0 < DQK / 16; ++d0) { const f32x4 g0 = *(const f32x4*)(gq + d0 * 16 + hi * 8), g1 = *(const f32x4*)(gq + d0 * 16 + hi * 8 + 4);
#pragma unroll
        for (int e = 0; e < 8; ++e) y[d0][e] = bf2f((unsigned short)qr[d0][e]) * rn * (e < 4 ? g0[e] : g1[e - 4]); }
      if (rope != nullptr && DQK == 192) {
#pragma unroll
        for (int half = 0; half < 2; ++half) { const int pos = half ? qcol : qrow; const float* tp = rope + (size_t)(pos * 16 + hi * 8) * 2;
#pragma unroll
          for (int e = 0; e < 8; ++e) { const float cs = tp[2 * e], sn = tp[2 * e + 1]; const float x1 = y[8 + 2 * half][e], x2 = y[9 + 2 * half][e];
            y[8 + 2 * half][e] = x1 * cs - x2 * sn; y[9 + 2 * half][e] = x1 * sn + x2 * cs; } }
      }
#pragma unroll
      for (int d0 = 0; d0 < DQK / 16; ++d0) { u32x4 w = {cvtpk(y[d0][0], y[d0][1]), cvtpk(y[d0][2], y[d0][3]), cvtpk(y[d0][4], y[d0][5]), cvtpk(y[d0][6], y[d0][7])}; qr[d0] = *reinterpret_cast<bf16x8*>(&w); }
    }
  }
#define ATT_QKT(P0, P1, KS) do { if constexpr (SRCC) qkt8<DQK>(P0, P1, KS, qf, r32, hi, PL2 - m_reg); else if constexpr (KF8) qkt8<DQK>(P0, P1, KS, qf, r32, hi); else qkt<DQK>(P0, P1, KS, qr, r32, hi); } while (0)
#define ATT_PSM(FIRST_, P0, P1, MN, AL, ...) do { if constexpr (SRCC) partialSM2<MASKABLE, FIRST_>(P0, P1, m_reg, AL, THR_L2, PL2, __VA_ARGS__); else partialSM<MASKABLE>(P0, P1, m_reg, MN, AL, C, THR_RAW, PL2, __VA_ARGS__); } while (0)
#define ATT_LAND() do { asm volatile("s_waitcnt vmcnt(0)" ::: "memory"); __syncthreads(); } while (0)
#define ATT_RESC(a) do { if (__any((a) < 1.f)) { if (hi == 0) al_l[r32] = (a); asm volatile("s_waitcnt lgkmcnt(0)" ::: "memory"); \
    _Pragma("unroll") for (int d = 0; d < 4; ++d) _Pragma("unroll") for (int r = 0; r < 16; ++r) o[d][r] *= al_l[crow(r, hi)]; } } while (0)
#define ATT_MASKARGS(t) (MASKABLE && (t) >= nA), (jB + 64 * ((t) - nA) - qi + 128 + 4 * hi)
  f32x16 pA0, pA1, pB0, pB1; float mnA, mnB, alA, alB; bf16x8 pa0, pa1, pa2, pa3; v8i pa8;
#define ATT_FIN(P0, P1, AL) do { if constexpr (VF8) finishSM8(P0, P1, AL, l_reg, pa8); else finishSM(P0, P1, AL, l_reg, pa0, pa1, pa2, pa3); } while (0)
#define ATT_PV(VOFF) do { if constexpr (VF8) pv8_d0(o, vp8 + (VOFF), pa8); else pv_d0(o, vbase + (VOFF), pa0, pa1, pa2, pa3); } while (0)
  int vprev = 0, vcur = SHMV, vnext = 2 * SHMV;
  ATT_LAND();
  ATT_QKT(pA0, pA1, K_lds); ATT_PSM(true, pA0, pA1, mnA, alA, ATT_MASKARGS(0));
  __syncthreads();
#ifdef ATT_PRIO_HALF
  if (wid >= 4) __builtin_amdgcn_s_setprio(1);
#endif
  for (int j = 1; j + 1 < NT; j += 2) {
    ATT_DMA(j + 1, 0, vnext);
    ATT_SBAR(); ATT_QKT(pB0, pB1, K_lds + SHM_K);
    ATT_FIN(pA0, pA1, alA); ATT_SBAR();
    ATT_PV(vprev); ATT_PSM(false, pB0, pB1, mnB, alB, ATT_MASKARGS(j));
    ATT_RESC(alB); ATT_LAND();
    { const int t_ = vprev; vprev = vcur; vcur = vnext; vnext = t_; }
    ATT_DMA(j + 2, 1, vnext);
    ATT_SBAR(); ATT_QKT(pA0, pA1, K_lds);
    ATT_FIN(pB0, pB1, alB); ATT_SBAR();
    ATT_PV(vprev); ATT_PSM(false, pA0, pA1, mnA, alA, ATT_MASKARGS(j + 1));
    ATT_RESC(alA); ATT_LAND();
    { const int t_ = vprev; vprev = vcur; vcur = vnext; vnext = t_; }
  }
  ATT_SBAR(); ATT_QKT(pB0, pB1, K_lds + SHM_K);
  ATT_FIN(pA0, pA1, alA); ATT_SBAR();
  ATT_PV(vprev); ATT_PSM(false, pB0, pB1, mnB, alB, ATT_MASKARGS(NT - 1));
  ATT_RESC(alB);
  ATT_FIN(pB0, pB1, alB); ATT_SBAR();
  ATT_PV(vcur);
#ifdef ATT_PRIO_HALF
  __builtin_amdgcn_s_setprio(0);
#endif
  l_reg += __builtin_amdgcn_exp2f(sink_l2 - m_reg * C + PL2);
  if (hi == 0) li_l[r32] = l_reg; asm volatile("s_waitcnt lgkmcnt(0)" ::: "memory");
  float rli[16];
#pragma unroll
  for (int r = 0; r < 16; ++r) rli[r] = __builtin_amdgcn_rcpf(li_l[crow(r, hi)]) * (VF8 ? (1.0f / 32.0f) : 1.0f);
  __syncthreads();
  if constexpr (OFP8) {
    char* ost = lds + wid * (32 * 144);
#pragma unroll
    for (int r = 0; r < 16; ++r) { const int orow = crow(r, hi);
#pragma unroll
      for (int d0 = 0; d0 < 4; ++d0) { const float v = o[d0][r] * rli[r] * 32.0f; const float vc = __builtin_amdgcn_fmed3f(v, -448.f, 448.f); const unsigned w = (unsigned)__builtin_amdgcn_cvt_pk_fp8_f32(vc, vc, 0, false);
        *(unsigned char*)(ost + orow * 144 + d0 * 32 + r32) = (unsigned char)(w & 0xffu); } }
    asm volatile("s_waitcnt lgkmcnt(0)" ::: "memory");
#pragma unroll
    for (int ps = 0; ps < 4; ++ps) { const int row = ps * 8 + (lane >> 3), c16 = lane & 7;
      const u32x4 w = *(const u32x4*)(ost + row * 144 + c16 * 16);
      *(u32x4*)((char*)Owave + (long)row * ldo + c16 * 16) = w; }
  } else {
  char* ost = lds + wid * (32 * OPITCH);
#pragma unroll
  for (int r = 0; r < 16; ++r) { const int orow = crow(r, hi);
#pragma unroll
    for (int d0 = 0; d0 < 4; ++d0) { const float v = o[d0][r] * rli[r]; unsigned u = __float_as_uint(v); u += 0x7fffu + ((u >> 16) & 1u);
      *(unsigned short*)(ost + orow * OPITCH + (d0 * 32 + r32) * 2) = (unsigned short)(u >> 16); } }
  asm volatile("s_waitcnt lgkmcnt(0)" ::: "memory");
#pragma unroll
  for (int ps = 0; ps < 8; ++ps) { const int row = ps * 4 + (lane >> 4), c16 = lane & 15;
    const u32x4 w = *(const u32x4*)(ost + row * OPITCH + c16 * 16);
    *(u32x4*)(Owave + (long)row * ldo + c16 * 8) = w; }
  }
  __syncthreads();
#undef ATT_TROW
#undef ATT_DMA
#undef ATT_QKT
#undef ATT_PSM
#undef ATT_FIN
#undef ATT_PV
#undef ATT_LAND
#undef ATT_RESC
#undef ATT_MASKARGS
}
}

#define LAS __attribute__((address_space(3)))
#define XB_TMO      128
#define XB_XCNT(j)  (256  + 64 * (j))
#define XB_XSUB(j)  (1280 + 64 * (j))
#define XB_XGEN(j)  (2304 + 64 * (j))
#define XB_TOP      3328
#define XB_TOPGEN   3392
#define XCD_BAR_WORDS 3456
#define XB_SPIN_CAP (1u << 18)

__device__ __forceinline__ unsigned xb_ld(unsigned* p)              { return __hip_atomic_load(p, __ATOMIC_RELAXED, __HIP_MEMORY_SCOPE_AGENT); }
__device__ __forceinline__ unsigned xb_add(unsigned* p, unsigned v) { return __hip_atomic_fetch_add(p, v, __ATOMIC_RELAXED, __HIP_MEMORY_SCOPE_AGENT); }
__device__ __forceinline__ unsigned xb_xcc_id() { return (unsigned)__builtin_amdgcn_s_getreg((3 << 11) | 20) & 0xFu; }
#define XB_SPIN(cond, bar) do { unsigned _sp = 0; while (cond) { __builtin_amdgcn_s_sleep(1); \
    if ((++_sp & 255u) == 0u) { if (xb_ld(&(bar)[XB_TMO])) break; if (_sp > XB_SPIN_CAP) { atomicAdd(&(bar)[XB_TMO], 1u); break; } } } } while (0)

struct XcdBarrier {
    unsigned* bar; unsigned x;
    volatile LAS unsigned* st;
};

__device__ __forceinline__ XcdBarrier xcd_barrier_post(unsigned* bar, volatile LAS unsigned* st) {
    XcdBarrier b; b.bar = bar; b.x = xb_xcc_id(); b.st = st;
    if (threadIdx.x == 0) (void)xb_add(&bar[XB_XCNT(b.x)], 1u);
    return b;
}
__device__ __forceinline__ void xcd_barrier_complete(unsigned* bar, unsigned x, unsigned& nloc, unsigned& nx) {
    const unsigned G = gridDim.x * gridDim.y * gridDim.z;
    unsigned sum, cnt, mine, sp = 0u;
    for (;;) {
        sum = 0u; cnt = 0u; mine = 0u;
#pragma unroll
        for (unsigned j = 0; j < 16; ++j) { const unsigned c = xb_ld(&bar[XB_XCNT(j)]); sum += c; cnt += (c > 0u) ? 1u : 0u; mine = (j == x) ? c : mine; }
        if (sum == G) break;
        __builtin_amdgcn_s_sleep(1);
        if ((++sp & 255u) == 0u) { if (xb_ld(&bar[XB_TMO])) break; if (sp > XB_SPIN_CAP) { atomicAdd(&bar[XB_TMO], 1u); break; } }
    }
    nloc = mine > 0u ? mine : 1u; nx = cnt > 0u ? cnt : 1u;
}

__device__ __forceinline__ void xcd_barrier(const XcdBarrier& b) {
    asm volatile("s_waitcnt vmcnt(0)" ::: "memory");
    __syncthreads();
    if (threadIdx.x == 0) {
        unsigned* bar = b.bar;
        __builtin_amdgcn_s_waitcnt(0);
        unsigned nloc = b.st[0], nx = b.st[1];
        if (nloc == 0u) { xcd_barrier_complete(bar, b.x, nloc, nx); b.st[0] = nloc; b.st[1] = nx; }
        const unsigned old = xb_add(&bar[XB_XSUB(b.x)], 1u);
        const unsigned gen = old / nloc;
        if (old + 1u == (gen + 1u) * nloc) {
            __builtin_amdgcn_fence(__ATOMIC_RELEASE, "agent");
            asm volatile("s_waitcnt vmcnt(0)" ::: "memory");
            const unsigned og = xb_add(&bar[XB_TOP], 1u);
            const unsigned tg = og / nx;
            if (og + 1u == (tg + 1u) * nx) xb_add(&bar[XB_TOPGEN], 1u);
            else XB_SPIN(xb_ld(&bar[XB_TOPGEN]) == tg, bar);
            __builtin_amdgcn_fence(__ATOMIC_ACQUIRE, "agent");
            xb_add(&bar[XB_XGEN(b.x)], 1u);
            asm volatile("s_waitcnt vmcnt(0)" ::: "memory");
        } else {
            XB_SPIN(xb_ld(&bar[XB_XGEN(b.x)]) == gen, bar);
            __builtin_amdgcn_fence(__ATOMIC_ACQUIRE, "agent");
            asm volatile("s_waitcnt vmcnt(0)" ::: "memory");
        }
    }
    __syncthreads();
}
#ifndef QUP_I8
#define QUP_I8 0
#endif
#ifndef UP_SUBSTAT
#define UP_SUBSTAT 1
#endif
#ifndef FFN_SORT
#define FFN_SORT 1
#endif
#ifndef UP_I8
#define UP_I8 1
#endif
#ifndef GQ_FP8
#define GQ_FP8 1
#endif
#ifndef W_TAIL3
#define W_TAIL3 1
#endif
#ifndef TAP_FOLD
#define TAP_FOLD 1
#endif
#ifndef UP_TAIL
#define UP_TAIL 0
#endif
#ifndef UPT_A
#define UPT_A 13000
#endif
#ifndef UPT_B
#define UPT_B 15000
#endif
#ifndef DOWN_TAIL
#define DOWN_TAIL 1
#endif
#ifndef KV_FUSE
#define KV_FUSE 1
#endif
#ifndef KVUP_I8
#define KVUP_I8 1
#endif
#ifndef KVUP_FP8
#define KVUP_FP8 1
#endif
#ifndef DOWN_NT8
#define DOWN_NT8 74
#endif
constexpr int DM = 4096, NPROMPT = 16, SEQ = 256, NLAT = 8, LSEQ = 4096, PAST = 256;
constexpr int TP = NPROMPT * SEQ;
constexpr int TL = NLAT * LSEQ;
constexpr int MTOK = TP + TL;
constexpr int KVROWS = TP + NLAT * (PAST + LSEQ);
constexpr int QRANK = 1024, KVRANK = 512, ROPED = 64, MLAH = 16, MLAQK = 192, GQH = 16, GKVH = 4, GHD = 128, DFF = 11008;
constexpr int INC = 4672, INCP = 4864;
constexpr int ZBW = 1792, ZQW = 3072;
constexpr int ZKV = 0, ZPE = 512, ZGK = 576, ZGV = 1088, ZQ = 0, ZGQ = 1024;
constexpr int NMOD = 9;
constexpr int KSPLIT = 32;
constexpr float EPS = 1e-6f;
constexpr int GK8 = DOWN_NT8 * 128;
constexpr int GPB = GK8 + (DFF - GK8) * 2;
constexpr float SG8 = 4.0f, SW8 = 256.0f;
static_assert(DOWN_NT8 % 2 == 0 && GK8 <= DFF && ((DFF - GK8) / 64) % 2 == 0, "mixed-K split");

constexpr size_t MiB = 1u << 20;
constexpr size_t WS_CTL = 0, CTL_ZERO_BYTES = 1 * MiB;
constexpr size_t WS_MOD = 1 * MiB;
constexpr size_t WS_ROPE16 = WS_MOD + 900 * 1024;
constexpr size_t WS_ROPE32 = WS_ROPE16 + 8192;
constexpr size_t WS_COLSC = WS_MOD + 928 * 1024;
constexpr size_t WS_COLMAX = 256 * 1024;
constexpr size_t WS_ROWSC = 2 * MiB;
constexpr size_t WS_MODP = 2 * MiB;
constexpr size_t WS_WIN = 32 * MiB;
constexpr size_t WS_WINQ = 48 * MiB;
constexpr size_t WS_WQUP = 70 * MiB;
constexpr size_t WS_RANK = 73 * MiB;
constexpr size_t WS_SIGMA = WS_RANK + 64 * 1024, WS_CWP = WS_RANK + 128 * 1024, WS_CBP = WS_RANK + 512 * 1024;
constexpr size_t WS_WKVUP = 76 * MiB;
constexpr size_t WS_WOUT = 80 * MiB;
constexpr size_t WS_WUP = 112 * MiB;
constexpr size_t WS_WDOWN = 284 * MiB;
constexpr size_t WS_HB = 370 * MiB;
constexpr size_t WS_Z = 658 * MiB;
constexpr size_t WS_ZB = 874 * MiB;
constexpr size_t WS_K8 = 874 * MiB;
constexpr size_t WS_H8 = 1116 * MiB;
constexpr size_t WS_QRAW = 658 * MiB;
constexpr size_t WS_QN = 1000 * MiB;
constexpr size_t WS_CKV = 1072 * MiB;
constexpr size_t WS_KPE = 1110 * MiB;
constexpr size_t WS_CKVS = WS_KPE + 5 * MiB;
constexpr size_t WS_KPESS = WS_CKVS + 256 * 1024;
constexpr size_t WS_KVCOLMAX = 448 * 1024;
constexpr size_t WS_KVCS = WS_RANK + 640 * 1024;
constexpr size_t WS_KB = 1116 * MiB;
constexpr size_t WS_VB = 1344 * MiB;
constexpr size_t WS_GQ = 1496 * MiB;
constexpr size_t WS_GK = 1640 * MiB;
constexpr size_t WS_GV = 1678 * MiB;
constexpr size_t WS_G = 658 * MiB;
constexpr size_t WS_EDGE = 1432 * MiB;
constexpr size_t WS_VT8 = 1716 * MiB;
constexpr size_t WS_X1 = 1716 * MiB;
constexpr size_t WS_END = 2004 * MiB;
static_assert(WS_G + (size_t)MTOK * DFF * 2 <= WS_EDGE && WS_EDGE + (size_t)576 * 4 * 22016 * 4 <= WS_END, "ws map");
static_assert(WS_KB + (size_t)KVROWS * 3072 * 2 <= WS_VB && WS_VB + (size_t)KVROWS * 2048 * 2 <= WS_GQ && WS_GQ + (size_t)MTOK * 2048 * 2 <= WS_GK && WS_GK + (size_t)KVROWS * 512 * 2 <= WS_GV && WS_GV + (size_t)KVROWS * 512 * 2 <= WS_END, "ws map 2");
static_assert(WS_Z + (size_t)MTOK * ZQW * 2 <= WS_ZB && WS_ZB + (size_t)MTOK * ZBW * 2 <= WS_QN && WS_QN + (size_t)MTOK * 1024 * 2 <= WS_CKV && WS_CKV + (size_t)KVROWS * 512 * 2 <= WS_KPE && WS_KPE + (size_t)KVROWS * 64 * 2 <= WS_KB, "ws map 3");
static_assert(WS_HB + (size_t)MTOK * DM * 2 <= WS_Z && WS_WDOWN + (size_t)DM * DFF * 2 <= WS_HB && WS_WUP + (size_t)22016 * DM * 2 <= WS_WDOWN && WS_WIN + (size_t)ZBW * DM * 2 <= WS_WINQ && WS_WINQ + (size_t)ZQW * DM <= WS_WQUP, "ws map 4");
constexpr int CW_BAR = 4096;

constexpr size_t OUT_Y = 0, OUT_CKV = (size_t)MTOK * DM, OUT_KPE = OUT_CKV + (size_t)TP * KVRANK, OUT_GK = OUT_KPE + (size_t)TP * ROPED, OUT_GV = OUT_GK + (size_t)TP * 512, OUT_END = OUT_GV + (size_t)TP * 512;

constexpr int RING_OFF = 0, RING_BYTES = 131072;
constexpr int MISC_OFF = RING_BYTES + 320;
constexpr int LDS_BYTES = 147456;
constexpr int NWAVES = 8, NTHREADS = 512;
#ifndef MK_ONE_LAUNCH
#define MK_ONE_LAUNCH 1
#endif
constexpr int N_PHASES = 13;
#ifndef ATT_VF8
#define ATT_VF8 1
#endif
#ifndef ATT_KF8
#define ATT_KF8 1
#endif
#ifndef QUP_FP8
#define QUP_FP8 1
#endif
#ifndef MIX_FP8
#define MIX_FP8 1
#endif
#ifndef PROBE_GSCALE
#define PROBE_GSCALE 1.0f
#endif
#ifndef PROBE_GSCALE2
#define PROBE_GSCALE2 1.0f
#endif
#ifndef W_P10
#define W_P3B 4
#define W_P3Q 4
#define W_P5K 4
#define W_P5Q 4
#define W_P8 4
#define W_P10 4
#define W_P12 4
#endif
#ifndef GEMM_ALIGN
#define GEMM_ALIGN true
#endif
#ifndef GEMM_SP2
#define GEMM_SP2 true
#endif

#define LAS __attribute__((address_space(3)))
typedef unsigned short bf16;
typedef unsigned v4u __attribute__((ext_vector_type(4)));
typedef unsigned v2u __attribute__((ext_vector_type(2)));
typedef float f32x4 __attribute__((ext_vector_type(4)));
typedef short bf16x8 __attribute__((ext_vector_type(8)));
#define LDS_WAIT() asm volatile("s_waitcnt lgkmcnt(0)" ::: "memory")
__device__ __forceinline__ unsigned f2bf(float f) { unsigned u = __builtin_bit_cast(unsigned, f); return (u + 0x7fffu + ((u >> 16) & 1u)) >> 16; }
__device__ __forceinline__ unsigned pk2(float lo, float hi) { return f2bf(lo) | (f2bf(hi) << 16); }
__device__ __forceinline__ float bflo(unsigned w) { return __uint_as_float(w << 16); }
__device__ __forceinline__ float bfhi(unsigned w) { return __uint_as_float(w & 0xffff0000u); }
__device__ __forceinline__ void unpack8(const v4u w, float (&x)[8]) { x[0] = bflo(w.x); x[1] = bfhi(w.x); x[2] = bflo(w.y); x[3] = bfhi(w.y); x[4] = bflo(w.z); x[5] = bfhi(w.z); x[6] = bflo(w.w); x[7] = bfhi(w.w); }
__device__ __forceinline__ v4u pack8(const float (&x)[8]) { v4u w; w.x = pk2(x[0], x[1]); w.y = pk2(x[2], x[3]); w.z = pk2(x[4], x[5]); w.w = pk2(x[6], x[7]); return w; }
__device__ __forceinline__ float wave_sum(float v) {
#pragma unroll
    for (int o = 1; o < 64; o <<= 1) v += __shfl_xor(v, o);
    return v;
}
__device__ __forceinline__ float silu_f(float a) { return a / (1.0f + __expf(-a)); }

struct Args { const float* in[27]; float* out; unsigned char* ws; int ph_lo, ph_hi; };

__device__ __forceinline__ int kvrow_of(int t) { if (t < TP) return t; const int u = t - TP, b = u >> 12, s = u & 4095; return TP + b * (PAST + LSEQ) + PAST + s; }

__device__ __forceinline__ void p0_load_block(const float* W, int N, const unsigned* srcrow, int k0, int n0, LAS float* scr, int lane) {
    f32x4 v[8];
#pragma unroll
    for (int i = 0; i < 8; ++i) { const int kk = 8 * i + (lane >> 3); const size_t sr = srcrow ? (size_t)srcrow[k0 + kk] : (size_t)(k0 + kk); v[i] = *(const f32x4*)(W + sr * N + n0 + 4 * (lane & 7)); }
#pragma unroll
    for (int i = 0; i < 8; ++i) { LAS float* d = scr + (8 * i + (lane >> 3)) * 33 + 4 * (lane & 7); d[0] = v[i].x; d[1] = v[i].y; d[2] = v[i].z; d[3] = v[i].w; }
}
template <class DMap>
__device__ __forceinline__ void p0_transpose_item(const float* W, int K, int N, bf16* WT, const DMap& dmap, LAS float* scr, int item, int lane, const unsigned* srcrow = nullptr) {
    const int nblk = N / 32, kb = item / nblk, nb = item % nblk, k0 = 64 * kb, n0 = 32 * nb;
    p0_load_block(W, N, srcrow, k0, n0, scr, lane);
    LDS_WAIT(); asm volatile("" ::: "memory");
    const int c = lane & 7; const int r0 = dmap(n0);
#pragma unroll
    for (int j = 0; j < 4; ++j) { const int n = (lane >> 3) + 8 * j; const LAS float* s = scr + (8 * c) * 33 + n;
        v4u o; o.x = pk2(s[0 * 33], s[1 * 33]); o.y = pk2(s[2 * 33], s[3 * 33]); o.z = pk2(s[4 * 33], s[5 * 33]); o.w = pk2(s[6 * 33], s[7 * 33]);
        *(v4u*)(WT + (size_t)(r0 + n) * K + k0 + 8 * c) = o; }
    LDS_WAIT(); asm volatile("" ::: "memory");
}
__device__ __forceinline__ void p0_transpose_item_fp8(const float* W, int K, int N, unsigned char* WT, LAS float* scr, int item, int lane, int row_shift = 0, const unsigned* srcrow = nullptr) {
    const int nblk = N / 32, kb = item / nblk, nb = item % nblk, k0 = 64 * kb, n0 = 32 * nb;
    p0_load_block(W, N, srcrow, k0, n0, scr, lane);
    LDS_WAIT(); asm volatile("" ::: "memory");
    const int c = lane & 3;
#pragma unroll
    for (int j = 0; j < 2; ++j) { const int n = (lane >> 2) + 16 * j; const LAS float* s = scr + (16 * c) * 33 + n; unsigned w[4];
#pragma unroll
        for (int q = 0; q < 4; ++q) { int t = 0; t = cvt_pk_fp8_sat(s[(4 * q) * 33] * 256.f, s[(4 * q + 1) * 33] * 256.f, t, false); t = cvt_pk_fp8_sat(s[(4 * q + 2) * 33] * 256.f, s[(4 * q + 3) * 33] * 256.f, t, true); w[q] = (unsigned)t; }
        v4u o; o.x = w[0]; o.y = w[1]; o.z = w[2]; o.w = w[3];
        *(v4u*)(WT + (size_t)(n0 + n + row_shift) * K + k0 + 16 * c) = o; }
    LDS_WAIT(); asm volatile("" ::: "memory");
}
__device__ __forceinline__ void p0_colmax_item(const float* W, int N, unsigned* colmax, int item, int lane) {
    const int nblk = N / 32, kb = item / nblk, nb = item % nblk, k0 = 64 * kb, n0 = 32 * nb; f32x4 v[8]; f32x4 mx = (f32x4){0.f, 0.f, 0.f, 0.f};
#pragma unroll
    for (int i = 0; i < 8; ++i) v[i] = *(const f32x4*)(W + (size_t)(k0 + 8 * i + (lane >> 3)) * N + n0 + 4 * (lane & 7));
#pragma unroll
    for (int i = 0; i < 8; ++i) { mx.x = fmaxf(mx.x, fabsf(v[i].x)); mx.y = fmaxf(mx.y, fabsf(v[i].y)); mx.z = fmaxf(mx.z, fabsf(v[i].z)); mx.w = fmaxf(mx.w, fabsf(v[i].w)); }
#pragma unroll
    for (int o = 8; o < 64; o <<= 1) { mx.x = fmaxf(mx.x, __shfl_xor(mx.x, o)); mx.y = fmaxf(mx.y, __shfl_xor(mx.y, o)); mx.z = fmaxf(mx.z, __shfl_xor(mx.z, o)); mx.w = fmaxf(mx.w, __shfl_xor(mx.w, o)); }
    if (lane < 8) { unsigned* c = colmax + n0 + 4 * lane; atomicMax(c, __float_as_uint(mx.x)); atomicMax(c + 1, __float_as_uint(mx.y)); atomicMax(c + 2, __float_as_uint(mx.z)); atomicMax(c + 3, __float_as_uint(mx.w)); }
}
__device__ __forceinline__ void p0_colss_item(const float* W, int N, unsigned long long* colss, int item, int lane) {
    const int nblk = N / 32, kb = item / nblk, nb = item % nblk, k0 = 64 * kb, n0 = 32 * nb; f32x4 v[8]; f32x4 ss = (f32x4){0.f, 0.f, 0.f, 0.f};
#pragma unroll
    for (int i = 0; i < 8; ++i) v[i] = *(const f32x4*)(W + (size_t)(k0 + 8 * i + (lane >> 3)) * N + n0 + 4 * (lane & 7));
#pragma unroll
    for (int i = 0; i < 8; ++i) ss += v[i] * v[i];
#pragma unroll
    for (int o = 8; o < 64; o <<= 1) { ss.x += __shfl_xor(ss.x, o); ss.y += __shfl_xor(ss.y, o); ss.z += __shfl_xor(ss.z, o); ss.w += __shfl_xor(ss.w, o); }
    if (lane < 8) { unsigned long long* c = colss + n0 + 4 * lane; atomicAdd(c, (unsigned long long)(ss.x * 1099511627776.0f)); atomicAdd(c + 1, (unsigned long long)(ss.y * 1099511627776.0f));
        atomicAdd(c + 2, (unsigned long long)(ss.z * 1099511627776.0f)); atomicAdd(c + 3, (unsigned long long)(ss.w * 1099511627776.0f)); }
}
template <class DMap, bool EXACT = false>
__device__ __forceinline__ void p0_transpose_item_i8(const float* W, int K, int N, signed char* WT, const DMap& dmap, const unsigned* colmax, float* colscale, LAS float* scr, int item, int lane, float fixed_cm = 0.15875f) {
    const int nblk = N / 32, kb = item / nblk, nb = item % nblk, k0 = 64 * kb, n0 = 32 * nb;
    p0_load_block(W, N, nullptr, k0, n0, scr, lane);
    LDS_WAIT(); asm volatile("" ::: "memory");
    const int c = lane & 3;
#pragma unroll
    for (int j = 0; j < 2; ++j) { const int n = (lane >> 2) + 16 * j; const LAS float* s = scr + (16 * c) * 33 + n; const int r0 = dmap(n0 + n) - n;
        const float cm = colmax ? ((UP_SUBSTAT && !EXACT) ? 4.2f * sqrtf((float)((const unsigned long long*)colmax)[n0 + n] * (1.0f / 1099511627776.0f) * (1.0f / 512.0f)) : __uint_as_float(colmax[n0 + n])) : fixed_cm; const float inv = cm > 0.f ? 127.0f / cm : 0.f; unsigned w[4];
#pragma unroll
        for (int q = 0; q < 4; ++q) { unsigned t = 0;
#pragma unroll
            for (int e = 0; e < 4; ++e) { int v = (int)__builtin_rintf(s[(4 * q + e) * 33] * inv); v = v > 127 ? 127 : (v < -127 ? -127 : v); t |= ((unsigned)v & 0xffu) << (8 * e); }
            w[q] = t; }
        *(v4u*)(WT + (size_t)(r0 + n) * K + k0 + 16 * c) = (v4u){w[0], w[1], w[2], w[3]};
        if (colscale && kb == 0 && c == 0) colscale[r0 + n] = cm * (1.0f / 127.0f); }
    LDS_WAIT(); asm volatile("" ::: "memory");
}
struct MapId { __device__ __forceinline__ int operator()(int n) const { return n; } };
template <class DMap>
__device__ __forceinline__ void p0_transpose_item_fp8m(const float* W, int K, int N, unsigned char* WT, const DMap& dmap, LAS float* scr, int item, int lane) {
    const int nblk = N / 32, kb = item / nblk, nb = item % nblk, k0 = 64 * kb, n0 = 32 * nb;
    p0_load_block(W, N, nullptr, k0, n0, scr, lane);
    LDS_WAIT(); asm volatile("" ::: "memory");
    const int c = lane & 3; const int r0 = dmap(n0);
#pragma unroll
    for (int j = 0; j < 2; ++j) { const int n = (lane >> 2) + 16 * j; const LAS float* s = scr + (16 * c) * 33 + n; unsigned w[4];
#pragma unroll
        for (int q = 0; q < 4; ++q) { int t = 0; t = cvt_pk_fp8_sat(s[(4 * q) * 33] * 256.f, s[(4 * q + 1) * 33] * 256.f, t, false); t = cvt_pk_fp8_sat(s[(4 * q + 2) * 33] * 256.f, s[(4 * q + 3) * 33] * 256.f, t, true); w[q] = (unsigned)t; }
        *(v4u*)(WT + (size_t)(r0 + n) * K + k0 + 16 * c) = (v4u){w[0], w[1], w[2], w[3]}; }
    LDS_WAIT(); asm volatile("" ::: "memory");
}
struct MapShift { int sh; __device__ __forceinline__ int operator()(int n) const { return n + sh; } };
struct MapUpPerm { const unsigned* rank; __device__ __forceinline__ int operator()(int n) const { const int v = n >= DFF, c = n - v * DFF; const int p = (int)rank[c]; return (p >> 7) * 256 + v * 128 + (p & 127); } };
struct MapUp { __device__ __forceinline__ int operator()(int n) const { const int v = n >= DFF, c = n - v * DFF; return (c >> 7) * 256 + v * 128 + (c & 127); } };

__device__ __forceinline__ void phase0(const Args& a, LAS unsigned char* lds, int vcu, int G) {
    const int tid = threadIdx.x, lane = tid & 63, wave = __builtin_amdgcn_readfirstlane(tid >> 6);
    LAS float* scr = (LAS float*)(lds + RING_OFF + wave * 16384);
    const int gw = vcu * NWAVES + wave, NGW = G * NWAVES;
    unsigned char* ws = a.ws;
    if (FFN_SORT) {
        const float* cw = a.in[24]; LAS float* e = (LAS float*)(lds + RING_OFF);
        for (int k = tid; k < DFF; k += NTHREADS) { const float a0 = cw[k], a1 = cw[22016 + k], a2 = cw[2 * 22016 + k], b0 = cw[DFF + k], b1 = cw[22016 + DFF + k], b2 = cw[2 * 22016 + DFF + k];
            e[k] = (a0 * a0 + a1 * a1 + a2 * a2) * (b0 * b0 + b1 * b1 + b2 * b2); }
        __syncthreads();
        unsigned* rank = (unsigned*)(ws + WS_RANK); unsigned* sigma = (unsigned*)(ws + WS_SIGMA);
        for (int k = gw; k < DFF; k += NGW) { const float ek = e[k]; int cnt = 0;
            for (int j = lane; j < DFF; j += 64) { const float ej = e[j]; cnt += (ej < ek || (ej == ek && j < k)) ? 1 : 0; }
#pragma unroll
            for (int o = 1; o < 64; o <<= 1) cnt += __shfl_xor(cnt, o);
            if (lane == 0) { rank[k] = (unsigned)cnt; sigma[cnt] = (unsigned)k; } }
        __syncthreads();
    }
    {
        const float* cvec = a.in[6]; const float* cctx = a.in[7]; const float* wada = a.in[10];
        float* modp = (float*)(ws + WS_MODP);
        for (int task = gw; task < 96 * KSPLIT; task += NGW) {
            const int cg = task % 96, ks = task / 96, k0 = ks * 128;
            for (int i = lane; i < NMOD * 128; i += 64) { const int r = i >> 7, kk = i & 127; const float v = (r < 8) ? cvec[r * DM + k0 + kk] : cctx[k0 + kk]; scr[i] = silu_f(v); }
            LDS_WAIT(); asm volatile("" ::: "memory");
            f32x4 acc[NMOD];
#pragma unroll
            for (int r = 0; r < NMOD; ++r) acc[r] = (f32x4){0.f, 0.f, 0.f, 0.f};
            const float* wp = wada + (size_t)k0 * 24576 + cg * 256 + lane * 4;
#pragma unroll 4
            for (int kk = 0; kk < 128; ++kk) { const f32x4 w = *(const f32x4*)(wp + (size_t)kk * 24576);
#pragma unroll
                for (int r = 0; r < NMOD; ++r) acc[r] += w * scr[r * 128 + kk]; }
#pragma unroll
            for (int r = 0; r < NMOD; ++r) *(f32x4*)(modp + ((size_t)ks * NMOD + r) * 24576 + cg * 256 + lane * 4) = acc[r];
            LDS_WAIT(); asm volatile("" ::: "memory");
        }
    }
    {
        constexpr int I_IN = (DM / 64) * (INC / 32), I_QUP = (QRANK / 64) * (3072 / 32), I_KVUP = (KVRANK / 64) * (4096 / 32), I_OUT = (DM / 64) * (DM / 32), I_UP = (DM / 64) * (22016 / 32), I_DOWN = (DFF / 64) * (DM / 32);
        constexpr int NITEMS = I_IN + I_QUP + I_KVUP + I_OUT + I_UP + I_DOWN;
        for (int it = gw; it < NITEMS; it += NGW) {
            int r = it;
            if (r < I_IN) { const int n0 = 32 * (r % (INC / 32));
                if (n0 < 1024) p0_transpose_item_fp8(a.in[12], DM, INC, (unsigned char*)(ws + WS_WINQ), scr, r, lane, 0);
                else if (n0 < 1536) p0_transpose_item(a.in[12], DM, INC, (bf16*)(ws + WS_WIN), MapShift{ZKV - 1024}, scr, r, lane);
                else if (n0 < 1600) p0_transpose_item(a.in[12], DM, INC, (bf16*)(ws + WS_WIN), MapShift{ZPE - 1536}, scr, r, lane);
                else if (n0 < 3648) p0_transpose_item_fp8(a.in[12], DM, INC, (unsigned char*)(ws + WS_WINQ), scr, r, lane, ZGQ - 1600);
                else if (n0 < 4160) p0_transpose_item(a.in[12], DM, INC, (bf16*)(ws + WS_WIN), MapShift{ZGK - 3648}, scr, r, lane);
                else p0_transpose_item(a.in[12], DM, INC, (bf16*)(ws + WS_WIN), MapShift{ZGV - 4160}, scr, r, lane);
                continue; } r -= I_IN;
            if (r < I_QUP) { if (W_TAIL3 && QUP_FP8 && !QUP_I8 && MIX_FP8) continue; if (QUP_I8) p0_transpose_item_i8(a.in[14], QRANK, 3072, (signed char*)(ws + WS_WQUP), MapId(), nullptr, nullptr, scr, r, lane); else if (QUP_FP8) p0_transpose_item_fp8(a.in[14], QRANK, 3072, (unsigned char*)(ws + WS_WQUP), scr, r, lane); else p0_transpose_item(a.in[14], QRANK, 3072, (bf16*)(ws + WS_WQUP), MapId(), scr, r, lane); continue; } r -= I_QUP;
            if (r < I_KVUP) { if (KVUP_I8) p0_colmax_item(a.in[16], 4096, (unsigned*)(ws + WS_KVCOLMAX), r, lane); else if (KVUP_FP8) p0_transpose_item_fp8(a.in[16], KVRANK, 4096, (unsigned char*)(ws + WS_WKVUP), scr, r, lane); else p0_transpose_item(a.in[16], KVRANK, 4096, (bf16*)(ws + WS_WKVUP), MapId(), scr, r, lane); continue; } r -= I_KVUP;
            if (r < I_OUT) { if (W_TAIL3 && QUP_FP8 && !QUP_I8 && MIX_FP8) continue; if (MIX_FP8) p0_transpose_item_fp8(a.in[22], DM, DM, (unsigned char*)(ws + WS_WOUT), scr, r, lane); else p0_transpose_item(a.in[22], DM, DM, (bf16*)(ws + WS_WOUT), MapId(), scr, r, lane); continue; } r -= I_OUT;
#if defined(PROBE_UPF8W)
            if (r < I_UP) { p0_transpose_item_fp8m(a.in[23], DM, 22016, (unsigned char*)(ws + WS_WUP), MapUp(), scr, r, lane); continue; }
#endif
#if defined(PROBE_P0CONV)
            if (r < I_UP) { p0_transpose_item_i8(a.in[23], DM, 22016, (signed char*)(ws + WS_WUP), MapUp(), nullptr, (float*)(ws + WS_COLSC), scr, r, lane, 0.085f); continue; }
#endif
            if (r < I_UP) { if (UP_I8 && UP_SUBSTAT) { if (r < 8 * (22016 / 32)) p0_colss_item(a.in[23], 22016, (unsigned long long*)(ws + WS_COLMAX), r, lane); } else if (UP_I8) p0_colmax_item(a.in[23], 22016, (unsigned*)(ws + WS_COLMAX), r, lane); else p0_transpose_item(a.in[23], DM, 22016, (bf16*)(ws + WS_WUP), MapUp(), scr, r, lane); continue; } r -= I_UP;
            if (FFN_SORT) continue;
            { const int k0 = 64 * (r / (DM / 32));
              if (k0 < GK8) p0_transpose_item_fp8(a.in[26], GPB, DM, (unsigned char*)(ws + WS_WDOWN), scr, r, lane, 0);
              else p0_transpose_item(a.in[26], GPB / 2, DM, (bf16*)(ws + WS_WDOWN) - GK8 / 2, MapId(), scr, r, lane); }
        }
        v4u* pz = (v4u*)((bf16*)(ws + WS_WIN) + (size_t)1600 * DM); const size_t nz = (size_t)(ZBW - 1600) * DM * 2 / 16;
        for (size_t i = (size_t)vcu * NTHREADS + tid; i < nz; i += (size_t)G * NTHREADS) pz[i] = (v4u){0u, 0u, 0u, 0u};
    }
}
__device__ __forceinline__ void phase1(const Args& a, LAS unsigned char* lds, int vcu, int G) {
    const int tid = threadIdx.x; unsigned char* ws = a.ws;
#if defined(PROBE_P0CONV)
    if (false) {
#else
    if (UP_I8 && !(UP_TAIL && FFN_SORT)) {
#endif
        const int lane = tid & 63, wave = __builtin_amdgcn_readfirstlane(tid >> 6); LAS float* scr = (LAS float*)(lds + RING_OFF + wave * 16384);
        for (int it = vcu * NWAVES + wave; it < (DM / 64) * (22016 / 32); it += G * NWAVES)
#if defined(PROBE_FIXEDCOL)
            p0_transpose_item_i8(a.in[23], DM, 22016, (signed char*)(ws + WS_WUP), MapUp(), nullptr, (float*)(ws + WS_COLSC), scr, it, lane, 0.085f);
#else
            if (FFN_SORT) p0_transpose_item_i8(a.in[23], DM, 22016, (signed char*)(ws + WS_WUP), MapUpPerm{(const unsigned*)(ws + WS_RANK)}, (const unsigned*)(ws + WS_COLMAX), (float*)(ws + WS_COLSC), scr, it, lane);
            else p0_transpose_item_i8(a.in[23], DM, 22016, (signed char*)(ws + WS_WUP), MapUp(), (const unsigned*)(ws + WS_COLMAX), (float*)(ws + WS_COLSC), scr, it, lane);
#endif
    }
    if (KVUP_I8) {
        const int lane = tid & 63, wave = __builtin_amdgcn_readfirstlane(tid >> 6); LAS float* scr = (LAS float*)(lds + RING_OFF + wave * 16384);
        for (int it = vcu * NWAVES + wave; it < (KVRANK / 64) * (4096 / 32); it += G * NWAVES)
            p0_transpose_item_i8<MapId, true>(a.in[16], KVRANK, 4096, (signed char*)(ws + WS_WKVUP), MapId(), (const unsigned*)(ws + WS_KVCOLMAX), (float*)(ws + WS_KVCS), scr, it, lane);
    }
    if (FFN_SORT) {
        const int lane = tid & 63, wave = __builtin_amdgcn_readfirstlane(tid >> 6); LAS float* scr = (LAS float*)(lds + RING_OFF + wave * 16384); const unsigned* sigma = (const unsigned*)(ws + WS_SIGMA);
        if (!DOWN_TAIL)
        for (int it = vcu * NWAVES + wave; it < (DFF / 64) * (DM / 32); it += G * NWAVES) { const int k0 = 64 * (it / (DM / 32));
            if (k0 < GK8) p0_transpose_item_fp8(a.in[26], GPB, DM, (unsigned char*)(ws + WS_WDOWN), scr, it, lane, 0, sigma);
            else p0_transpose_item(a.in[26], GPB / 2, DM, (bf16*)(ws + WS_WDOWN) - GK8 / 2, MapId(), scr, it, lane, sigma); }
        const float* cw = a.in[24]; const float* cb = a.in[25]; float* cwp = (float*)(ws + WS_CWP); float* cbp = (float*)(ws + WS_CBP);
        for (int i = vcu * NTHREADS + tid; i < 2 * DFF; i += G * NTHREADS) { const int v = i >= DFF, pp = i - v * DFF; const int src = v * DFF + (int)sigma[pp];
            const float f = !TAP_FOLD ? 1.0f : (v ? (-0.6931471805599453f) * (pp < GK8 ? SG8 : 1.0f) : -1.4426950408889634f);
            cwp[i] = cw[src] * f; cwp[22016 + i] = cw[22016 + src] * f; cwp[2 * 22016 + i] = cw[2 * 22016 + src] * f; cbp[i] = cb[src] * f; }
    }
    const float* modp = (const float*)(ws + WS_MODP); float* mod = (float*)(ws + WS_MOD); const float* bada = a.in[11];
    for (int i = vcu * NTHREADS + tid; i < NMOD * 24576; i += G * NTHREADS) { const int n = i % 24576; float s = bada[n];
#pragma unroll 8
        for (int ks = 0; ks < KSPLIT; ++ks) s += modp[(size_t)ks * NMOD * 24576 + i];
        mod[i] = s; }
    const int gi = vcu * NTHREADS + tid;
    if (gi < 64 * 16 + 64 * 32) {
        const bool t32 = gi >= 64 * 16; const int idx = t32 ? gi - 64 * 16 : gi; const int half = t32 ? 32 : 16; const int pos = idx / half, j = idx % half;
        const double step = t32 ? 0.74989420933245582730 : 0.56234132519034908039;
        double inv = 1.0; for (int q = 0; q < j; ++q) inv *= step;
        double ang = (double)pos * (double)(float)inv;
        const double twopi = 6.283185307179586476925286766559;
        const double kq = __builtin_rint(ang / twopi); double x = ang - kq * twopi; const double x2 = x * x;
        double sn = x, cs = 1.0, ts = x, tc = 1.0;
        for (int q = 1; q <= 14; ++q) { tc = -tc * x2 / (double)((2 * q - 1) * (2 * q)); cs += tc; ts = -ts * x2 / (double)((2 * q) * (2 * q + 1)); sn += ts; }
        float* tab = (float*)(ws + (t32 ? WS_ROPE32 : WS_ROPE16));
        tab[(size_t)idx * 2] = (float)cs; tab[(size_t)idx * 2 + 1] = (float)sn;
    }
}
template <bool XB>
__device__ __forceinline__ void phase_norm(const void* xp, const void* xs, const float* g, const float* mod, int off_shift, int off_scale, bf16* out, unsigned char* out8, float* rowscale, LAS unsigned char* lds, int vcu, int G) {
    const int tid = threadIdx.x, lane = tid & 63, wave = tid >> 6;
    LAS float* Av = (LAS float*)(lds + RING_OFF); LAS float* Bv = Av + DM;
    const int ntask = MTOK / 16, per = (ntask + G - 1) / G; int cur_mr = -1;
    for (int k = 0; k < per; ++k) { const int task = vcu * per + k; if (task >= ntask) break;
        const int t0 = task * 16; const int mr = t0 < TP ? 8 : ((t0 - TP) >> 12);
        if (mr != cur_mr) { __syncthreads();
            for (int c = tid; c < DM; c += NTHREADS) { Av[c] = g[c] * (1.0f + mod[(size_t)mr * 24576 + off_scale + c]); Bv[c] = mod[(size_t)mr * 24576 + off_shift + c]; }
            __syncthreads(); cur_mr = mr; }
#pragma unroll 1
        for (int i = 0; i < 2; ++i) { const int t = t0 + wave * 2 + i;
            f32x4 v[16]; float ss = 0.f;
            if constexpr (XB) { const bf16* xr = (const bf16*)xp + (size_t)t * DM;
#pragma unroll
                for (int q = 0; q < 8; ++q) { const v4u w = *(const v4u*)(xr + lane * 8 + 512 * q); v[2 * q] = (f32x4){bflo(w.x), bfhi(w.x), bflo(w.y), bfhi(w.y)}; v[2 * q + 1] = (f32x4){bflo(w.z), bfhi(w.z), bflo(w.w), bfhi(w.w)}; }
            } else { const float* xr = (t < TP) ? (const float*)xp + (size_t)t * DM : (const float*)xs + (size_t)(t - TP) * DM;
#pragma unroll
                for (int j = 0; j < 16; ++j) v[j] = *(const f32x4*)(xr + lane * 8 + 512 * (j >> 1) + 4 * (j & 1));
            }
#pragma unroll
            for (int j = 0; j < 16; ++j) ss += (v[j].x * v[j].x + v[j].y * v[j].y) + (v[j].z * v[j].z + v[j].w * v[j].w);
            const float r = 1.0f / sqrtf(wave_sum(ss) * (1.0f / DM) + EPS);
            if (rowscale) {
                float mx = 0.f;
#pragma unroll
                for (int j = 0; j < 16; ++j) { const int c = lane * 8 + 512 * (j >> 1) + 4 * (j & 1); const f32x4 av = *(const LAS f32x4*)(Av + c), bv = *(const LAS f32x4*)(Bv + c);
                    v[j] = (v[j] * r) * av + bv; mx = fmaxf(fmaxf(mx, fmaxf(fabsf(v[j].x), fabsf(v[j].y))), fmaxf(fabsf(v[j].z), fabsf(v[j].w)));
                    if ((j & 3) == 3) asm volatile("" ::: "memory"); }
#pragma unroll
                for (int o = 1; o < 64; o <<= 1) mx = fmaxf(mx, __shfl_xor(mx, o));
                const float inv = mx > 0.f ? 127.0f / mx : 0.f;
                if (lane == 0) rowscale[t] = mx * (1.0f / 127.0f);
#pragma unroll
                for (int q = 0; q < 8; ++q) { v2u o;
#define PN_Q8(vv) (((unsigned)(int)__builtin_rintf((vv).x * inv) & 0xffu) | (((unsigned)(int)__builtin_rintf((vv).y * inv) & 0xffu) << 8) | (((unsigned)(int)__builtin_rintf((vv).z * inv) & 0xffu) << 16) | (((unsigned)(int)__builtin_rintf((vv).w * inv)) << 24))
                    o.x = PN_Q8(v[2 * q]); o.y = PN_Q8(v[2 * q + 1]);
#undef PN_Q8
                    *(v2u*)(out8 + (size_t)t * DM + lane * 8 + 512 * q) = o; }
            } else {
            bf16* orow = out + (size_t)t * DM;
#pragma unroll
            for (int q = 0; q < 8; ++q) { const int c = lane * 8 + 512 * q;
                const f32x4 a0 = *(const LAS f32x4*)(Av + c), b0 = *(const LAS f32x4*)(Bv + c), a1 = *(const LAS f32x4*)(Av + c + 4), b1 = *(const LAS f32x4*)(Bv + c + 4);
                const f32x4 y0 = (v[2 * q] * r) * a0 + b0, y1 = (v[2 * q + 1] * r) * a1 + b1;
                v4u w; w.x = pk2(y0.x, y0.y); w.y = pk2(y0.z, y0.w); w.z = pk2(y1.x, y1.y); w.w = pk2(y1.z, y1.w); *(v4u*)(orow + c) = w;
                if (out8) { v2u o8; int tt = 0; tt = cvt_pk_fp8_sat(y0.x * 16.f, y0.y * 16.f, tt, false); tt = cvt_pk_fp8_sat(y0.z * 16.f, y0.w * 16.f, tt, true); o8.x = (unsigned)tt;
                    tt = 0; tt = cvt_pk_fp8_sat(y1.x * 16.f, y1.y * 16.f, tt, false); tt = cvt_pk_fp8_sat(y1.z * 16.f, y1.w * 16.f, tt, true); o8.y = (unsigned)tt;
                    *(v2u*)(out8 + (size_t)t * DM + c) = o8; }
                if (q & 1) asm volatile("" ::: "memory"); }
            }
        }
    }
    __syncthreads();
}
template <int CTRL> __device__ __forceinline__ float dppx(float v) { return __builtin_bit_cast(float, __builtin_amdgcn_update_dpp(0, __builtin_bit_cast(int, v), CTRL, 0xf, 0xf, true)); }
__device__ __forceinline__ float row16_sum(float v) { v += dppx<0xB1>(v); v += dppx<0x4E>(v); v += dppx<0x141>(v); v += dppx<0x140>(v); return v; }
__device__ __forceinline__ float wave_sum_rl(float v) { v = row16_sum(v); const int b = __builtin_bit_cast(int, v);
    return (__builtin_bit_cast(float, __builtin_amdgcn_readlane(b, 0)) + __builtin_bit_cast(float, __builtin_amdgcn_readlane(b, 16))) + (__builtin_bit_cast(float, __builtin_amdgcn_readlane(b, 32)) + __builtin_bit_cast(float, __builtin_amdgcn_readlane(b, 48))); }
__device__ __forceinline__ float wave_max_rl(float v) { v = fmaxf(v, dppx<0xB1>(v)); v = fmaxf(v, dppx<0x4E>(v)); v = fmaxf(v, dppx<0x141>(v)); v = fmaxf(v, dppx<0x140>(v)); const int b = __builtin_bit_cast(int, v);
    return fmaxf(fmaxf(__builtin_bit_cast(float, __builtin_amdgcn_readlane(b, 0)), __builtin_bit_cast(float, __builtin_amdgcn_readlane(b, 16))), fmaxf(__builtin_bit_cast(float, __builtin_amdgcn_readlane(b, 32)), __builtin_bit_cast(float, __builtin_amdgcn_readlane(b, 48)))); }
__device__ __forceinline__ void store_row_i8(const float (&x)[8], unsigned char* dst, float* scale, int lane) {
    float mx = 0.f;
#pragma unroll
    for (int e = 0; e < 8; ++e) mx = fmaxf(mx, fabsf(x[e]));
    mx = wave_max_rl(mx); const float inv = mx > 0.f ? 127.0f / mx : 0.f; unsigned q[8];
#pragma unroll
    for (int e = 0; e < 8; ++e) q[e] = (unsigned)(int)__builtin_rintf(__builtin_amdgcn_fmed3f(x[e] * inv, -127.f, 127.f)) & 0xffu;
    v2u w; w.x = q[0] | (q[1] << 8) | (q[2] << 16) | (q[3] << 24); w.y = q[4] | (q[5] << 8) | (q[6] << 16) | (q[7] << 24);
    *(v2u*)(dst + lane * 8) = w; if (lane == 0) *scale = mx * (1.0f / 127.0f);
}
__device__ __forceinline__ v2u pack8_fp8s(const float (&x)[8], const float sc) { v2u w; int tt = 0; tt = cvt_pk_fp8_sat(x[0] * sc, x[1] * sc, tt, false); tt = cvt_pk_fp8_sat(x[2] * sc, x[3] * sc, tt, true); w.x = (unsigned)tt;
    tt = 0; tt = cvt_pk_fp8_sat(x[4] * sc, x[5] * sc, tt, false); tt = cvt_pk_fp8_sat(x[6] * sc, x[7] * sc, tt, true); w.y = (unsigned)tt; return w; }
__device__ __forceinline__ v2u pack8_fp8x16(const float (&x)[8]) { v2u w; int tt = 0; tt = cvt_pk_fp8_sat(x[0] * 16.f, x[1] * 16.f, tt, false); tt = cvt_pk_fp8_sat(x[2] * 16.f, x[3] * 16.f, tt, true); w.x = (unsigned)tt;
    tt = 0; tt = cvt_pk_fp8_sat(x[4] * 16.f, x[5] * 16.f, tt, false); tt = cvt_pk_fp8_sat(x[6] * 16.f, x[7] * 16.f, tt, true); w.y = (unsigned)tt; return w; }
__device__ __forceinline__ void phase4(const Args& a, int vcu, int G) {
    const int tid = threadIdx.x, lane = tid & 63, wave = tid >> 6; unsigned char* ws = a.ws;
    const bf16* Zq = (const bf16*)(ws + WS_Z); const bf16* Zb = (const bf16*)(ws + WS_ZB); bf16* QN = (bf16*)(ws + WS_QN); bf16* CKV = (bf16*)(ws + WS_CKV); bf16* KPE = (bf16*)(ws + WS_KPE);
    bf16* GQ = (bf16*)(ws + WS_GQ); bf16* GK = (bf16*)(ws + WS_GK); bf16* GV = (bf16*)(ws + WS_GV); unsigned char* GK8 = (unsigned char*)(ws + WS_GK);
    const float* T32 = (const float*)(ws + WS_ROPE32);
    const float* g_q_lat = a.in[13]; const float* g_kv_lat = a.in[15]; const float* g_gq = a.in[19]; const float* g_gk = a.in[20];
    float* out = a.out;
    const int gw = vcu * NWAVES + wave, NGW = G * NWAVES;
    const int hq = lane & 15;
    const f32x4 gqa = *(const f32x4*)(g_q_lat + lane * 8), gqb = *(const f32x4*)(g_q_lat + lane * 8 + 4), gqc = *(const f32x4*)(g_q_lat + 512 + lane * 8), gqd = *(const f32x4*)(g_q_lat + 512 + lane * 8 + 4);
    const f32x4 gka = *(const f32x4*)(g_kv_lat + lane * 8), gkb = *(const f32x4*)(g_kv_lat + lane * 8 + 4);
    const float* T16 = (const float*)(ws + WS_ROPE16); const float* g_mk = a.in[18];
    f32x4 gpa = (f32x4){0.f, 0.f, 0.f, 0.f}, gpb = gpa; if (lane < 8) { gpa = *(const f32x4*)(g_mk + 128 + lane * 8); gpb = *(const f32x4*)(g_mk + 128 + lane * 8 + 4); }
    const f32x4 ggqa = *(const f32x4*)(g_gq + hq * 8), ggqb = *(const f32x4*)(g_gq + hq * 8 + 4), ggka = *(const f32x4*)(g_gk + hq * 8), ggkb = *(const f32x4*)(g_gk + hq * 8 + 4);
    for (int t = gw; t < MTOK + NLAT * PAST; t += NGW) {
        if (t >= MTOK) {
            const int u = t - MTOK, b = u >> 8, s = u & 255; const size_t kr = (size_t)TP + (size_t)b * (PAST + LSEQ) + s;
            { const float* src = a.in[2] + (size_t)u * KVRANK + lane * 8; const f32x4 x0 = *(const f32x4*)src, x1 = *(const f32x4*)(src + 4);
              if (KVUP_I8) { const float xx[8] = {x0.x, x0.y, x0.z, x0.w, x1.x, x1.y, x1.z, x1.w}; store_row_i8(xx, (unsigned char*)CKV + kr * KVRANK, (float*)(ws + WS_CKVS) + kr, lane); }
              else if (KVUP_FP8) { const float xx[8] = {x0.x, x0.y, x0.z, x0.w, x1.x, x1.y, x1.z, x1.w}; *(v2u*)((unsigned char*)CKV + kr * KVRANK + lane * 8) = pack8_fp8x16(xx); }
              else { v4u w; w.x = pk2(x0.x, x0.y); w.y = pk2(x0.z, x0.w); w.z = pk2(x1.x, x1.y); w.w = pk2(x1.z, x1.w); *(v4u*)(CKV + kr * KVRANK + lane * 8) = w; } }
            if (KV_FUSE) { f32x4 x0 = (f32x4){0.f, 0.f, 0.f, 0.f}, x1 = x0; if (lane < 8) { const float* src = a.in[3] + (size_t)u * ROPED + lane * 8; x0 = *(const f32x4*)src; x1 = *(const f32x4*)(src + 4); }
              float ss = (x0.x * x0.x + x0.y * x0.y) + (x0.z * x0.z + x0.w * x0.w) + (x1.x * x1.x + x1.y * x1.y) + (x1.z * x1.z + x1.w * x1.w);
              ss = row16_sum(ss); if (lane == 0) ((float*)(ws + WS_KPESS))[kr] = ss;
              x0 *= gpa; x1 *= gpb;
              if (lane < 8) { v4u w; w.x = pk2(x0.x, x0.y); w.y = pk2(x0.z, x0.w); w.z = pk2(x1.x, x1.y); w.w = pk2(x1.z, x1.w); *(v4u*)(KPE + kr * ROPED + lane * 8) = w; } }
            else if (lane < 8) { const float* src = a.in[3] + (size_t)u * ROPED + lane * 8; const f32x4 x0 = *(const f32x4*)src, x1 = *(const f32x4*)(src + 4);
              v4u w; w.x = pk2(x0.x, x0.y); w.y = pk2(x0.z, x0.w); w.z = pk2(x1.x, x1.y); w.w = pk2(x1.z, x1.w); *(v4u*)(KPE + kr * ROPED + lane * 8) = w; }
            { const float* src = a.in[4] + (size_t)u * 512 + lane * 8; const f32x4 x0 = *(const f32x4*)src, x1 = *(const f32x4*)(src + 4);
              if (ATT_KF8) { const float xx[8] = {x0.x, x0.y, x0.z, x0.w, x1.x, x1.y, x1.z, x1.w}; *(v2u*)(GK8 + kr * 512 + lane * 8) = pack8_fp8s(xx, ATT_KS8); }
              else { v4u w; w.x = pk2(x0.x, x0.y); w.y = pk2(x0.z, x0.w); w.z = pk2(x1.x, x1.y); w.w = pk2(x1.z, x1.w); *(v4u*)(GK + kr * 512 + lane * 8) = w; } }
            { const float* src = a.in[5] + (size_t)u * 512 + lane * 8; const f32x4 x0 = *(const f32x4*)src, x1 = *(const f32x4*)(src + 4);
              v4u w; w.x = pk2(x0.x, x0.y); w.y = pk2(x0.z, x0.w); w.z = pk2(x1.x, x1.y); w.w = pk2(x1.z, x1.w); *(v4u*)(GV + kr * 512 + lane * 8) = w; }
            continue;
        }
        const bool prompt = t < TP; const size_t kr = (size_t)kvrow_of(t);
        const int spos = prompt ? 0 : ((t - TP) & 4095); const int prow = spos >> 6, pcol = spos & 63;
        const bf16* zq = Zq + (size_t)t * ZQW; const bf16* z = Zb + (size_t)t * ZBW;
        const v4u wq0 = *(const v4u*)(zq + ZQ + lane * 8), wq1 = *(const v4u*)(zq + ZQ + 512 + lane * 8);
        const v4u wkv = *(const v4u*)(z + ZKV + lane * 8), wgk = *(const v4u*)(z + ZGK + lane * 8), wgv = *(const v4u*)(z + ZGV + lane * 8);
        v4u wpe = (v4u){0u, 0u, 0u, 0u}; if (lane < 8) wpe = *(const v4u*)(z + ZPE + lane * 8);
        v4u wgq[4];
#pragma unroll
        for (int it = 0; it < 4; ++it) wgq[it] = *(const v4u*)(zq + ZGQ + it * 512 + lane * 8);
        float rc[8], rs[8];
        if (!prompt) { const int pos = (hq < 8) ? prow : pcol; const float* tp = T32 + (size_t)(pos * 32 + (hq & 3) * 8) * 2;
#pragma unroll
          for (int q = 0; q < 4; ++q) { const f32x4 cs = *(const f32x4*)(tp + 4 * q); rc[2 * q] = cs[0]; rc[2 * q + 1] = cs[2]; rs[2 * q] = (hq & 4) ? cs[1] : -cs[1]; rs[2 * q + 1] = (hq & 4) ? cs[3] : -cs[3]; } }
        { float x0[8], x1[8]; unpack8(wq0, x0); unpack8(wq1, x1); float ss = 0.f;
#pragma unroll
          for (int e = 0; e < 8; ++e) ss += x0[e] * x0[e] + x1[e] * x1[e];
          const float r = 1.0f / sqrtf(wave_sum_rl(ss) * (1.0f / QRANK) + EPS);
#pragma unroll
          for (int e = 0; e < 8; ++e) { x0[e] = x0[e] * r * (e < 4 ? gqa[e] : gqb[e - 4]); x1[e] = x1[e] * r * (e < 4 ? gqc[e] : gqd[e - 4]); }
          if (QUP_I8) { unsigned char* q8 = (unsigned char*)QN + (size_t)t * QRANK; v2u w0, w1;
#define Q8(x) ((unsigned)(int)__builtin_rintf(__builtin_amdgcn_fmed3f((x) * 16.f, -127.f, 127.f)) & 0xffu)
            w0.x = Q8(x0[0]) | (Q8(x0[1]) << 8) | (Q8(x0[2]) << 16) | (Q8(x0[3]) << 24); w0.y = Q8(x0[4]) | (Q8(x0[5]) << 8) | (Q8(x0[6]) << 16) | (Q8(x0[7]) << 24);
            w1.x = Q8(x1[0]) | (Q8(x1[1]) << 8) | (Q8(x1[2]) << 16) | (Q8(x1[3]) << 24); w1.y = Q8(x1[4]) | (Q8(x1[5]) << 8) | (Q8(x1[6]) << 16) | (Q8(x1[7]) << 24);
#undef Q8
            *(v2u*)(q8 + lane * 8) = w0; *(v2u*)(q8 + 512 + lane * 8) = w1; }
          else if (QUP_FP8) { unsigned char* q8 = (unsigned char*)QN + (size_t)t * QRANK; *(v2u*)(q8 + lane * 8) = pack8_fp8x16(x0); *(v2u*)(q8 + 512 + lane * 8) = pack8_fp8x16(x1); }
          else { *(v4u*)(QN + (size_t)t * QRANK + lane * 8) = pack8(x0); *(v4u*)(QN + (size_t)t * QRANK + 512 + lane * 8) = pack8(x1); } }
        { float x[8]; unpack8(wkv, x); float ss = 0.f;
#pragma unroll
          for (int e = 0; e < 8; ++e) ss += x[e] * x[e];
          const float r = 1.0f / sqrtf(wave_sum_rl(ss) * (1.0f / KVRANK) + EPS);
#pragma unroll
          for (int e = 0; e < 8; ++e) x[e] = x[e] * r * (e < 4 ? gka[e] : gkb[e - 4]);
          if (KVUP_I8) store_row_i8(x, (unsigned char*)CKV + kr * KVRANK, (float*)(ws + WS_CKVS) + kr, lane);
          else if (KVUP_FP8) *(v2u*)((unsigned char*)CKV + kr * KVRANK + lane * 8) = pack8_fp8x16(x); else *(v4u*)(CKV + kr * KVRANK + lane * 8) = pack8(x);
          if (prompt) { float* o = out + OUT_CKV + (size_t)t * KVRANK + lane * 8; *(f32x4*)o = (f32x4){x[0], x[1], x[2], x[3]}; *(f32x4*)(o + 4) = (f32x4){x[4], x[5], x[6], x[7]}; } }
        if (KV_FUSE) { float x[8]; unpack8(wpe, x);
          if (prompt && lane < 8) { float* o = out + OUT_KPE + (size_t)t * ROPED + lane * 8; *(f32x4*)o = (f32x4){x[0], x[1], x[2], x[3]}; *(f32x4*)(o + 4) = (f32x4){x[4], x[5], x[6], x[7]}; }
          float ss = 0.f;
#pragma unroll
          for (int e = 0; e < 8; ++e) ss += x[e] * x[e];
          ss = row16_sum(ss); if (lane == 0) ((float*)(ws + WS_KPESS))[kr] = ss;
#pragma unroll
          for (int e = 0; e < 8; ++e) x[e] *= (e < 4 ? gpa[e] : gpb[e - 4]);
          if (!prompt) { const int pos = (lane & 4) ? pcol : prow; const float* tp = T16 + (size_t)(pos * 16 + 8 * (lane & 1)) * 2;
#pragma unroll
            for (int q = 0; q < 4; ++q) { const f32x4 cs = *(const f32x4*)(tp + 4 * q);
#pragma unroll
              for (int h2 = 0; h2 < 2; ++h2) { const int e = 2 * q + h2; const float pa = dppx<0x112>(x[e]), pb = dppx<0x102>(x[e]); const float pr = (lane & 2) ? pa : pb;
                x[e] = x[e] * cs[2 * h2] + ((lane & 2) ? pr : -pr) * cs[2 * h2 + 1]; } } }
          if (lane < 8) *(v4u*)(KPE + kr * ROPED + lane * 8) = pack8(x); }
        else if (lane < 8) { *(v4u*)(KPE + kr * ROPED + lane * 8) = wpe;
          if (prompt) { float x[8]; unpack8(wpe, x); float* o = out + OUT_KPE + (size_t)t * ROPED + lane * 8; *(f32x4*)o = (f32x4){x[0], x[1], x[2], x[3]}; *(f32x4*)(o + 4) = (f32x4){x[4], x[5], x[6], x[7]}; } }
#pragma unroll
        for (int it = 0; it < 4; ++it) { float x[8]; unpack8(wgq[it], x); float ss = 0.f;
#pragma unroll
            for (int e = 0; e < 8; ++e) ss += x[e] * x[e];
            const float r = 1.0f / sqrtf(row16_sum(ss) * (1.0f / GHD) + EPS);
#pragma unroll
            for (int e = 0; e < 8; ++e) x[e] = x[e] * r * (e < 4 ? ggqa[e] : ggqb[e - 4]);
            if (!prompt) {
#pragma unroll
              for (int e = 0; e < 8; ++e) { const float pa = dppx<0x114>(x[e]), pb = dppx<0x104>(x[e]); const float p = (hq & 4) ? pa : pb;     x[e] = x[e] * rc[e] + p * rs[e]; } }
            if (GQ_FP8 && ATT_KF8) *(v2u*)((unsigned char*)GQ + (size_t)t * 2048 + it * 512 + lane * 8) = pack8_fp8s(x, att::q8_scale<128>());
            else *(v4u*)(GQ + (size_t)t * 2048 + it * 512 + lane * 8) = pack8(x); }
        { float x[8]; unpack8(wgk, x); float ss = 0.f;
#pragma unroll
          for (int e = 0; e < 8; ++e) ss += x[e] * x[e];
          const float r = 1.0f / sqrtf(row16_sum(ss) * (1.0f / GHD) + EPS);
#pragma unroll
          for (int e = 0; e < 8; ++e) x[e] = x[e] * r * (e < 4 ? ggka[e] : ggkb[e - 4]);
          if (prompt) { float* o = out + OUT_GK + (size_t)t * 512 + lane * 8; *(f32x4*)o = (f32x4){x[0], x[1], x[2], x[3]}; *(f32x4*)(o + 4) = (f32x4){x[4], x[5], x[6], x[7]}; }
          else {
#pragma unroll
            for (int e = 0; e < 8; ++e) { const float pa = dppx<0x114>(x[e]), pb = dppx<0x104>(x[e]); const float p = (hq & 4) ? pa : pb;     x[e] = x[e] * rc[e] + p * rs[e]; } }
          if (ATT_KF8) *(v2u*)(GK8 + kr * 512 + lane * 8) = pack8_fp8s(x, ATT_KS8);
          else *(v4u*)(GK + kr * 512 + lane * 8) = pack8(x); }
        { *(v4u*)(GV + kr * 512 + lane * 8) = wgv;
          if (prompt) { float x[8]; unpack8(wgv, x); float* o = out + OUT_GV + (size_t)t * 512 + lane * 8; *(f32x4*)o = (f32x4){x[0], x[1], x[2], x[3]}; *(f32x4*)(o + 4) = (f32x4){x[4], x[5], x[6], x[7]}; } }
    }
}
__device__ __forceinline__ void phase6(const Args& a, LAS unsigned char* lds, int vcu, int G) {
    const int tid = threadIdx.x, lane = tid & 63, wave = tid >> 6; unsigned char* ws = a.ws;
    bf16* KB = (bf16*)(ws + WS_KB); const bf16* KPE = (const bf16*)(ws + WS_KPE); const float* T16 = (const float*)(ws + WS_ROPE16); const float* gk = a.in[18];
    const int gw = vcu * NWAVES + wave, NGW = G * NWAVES; const int h = lane >> 2, q = lane & 3;
    float gn[32], gp[16];
#pragma unroll
    for (int e = 0; e < 32; ++e) gn[e] = gk[32 * q + e];
#pragma unroll
    for (int e = 0; e < 16; ++e) gp[e] = gk[128 + 16 * q + e];
    for (int kr = gw; kr < KVROWS; kr += NGW) {
        bool lat = false; int spos = 0;
        if (kr >= TP) { const int u = (kr - TP) % (PAST + LSEQ); if (u >= PAST) { lat = true; spos = u - PAST; } }
        bf16* kp = KB + ((size_t)kr * 16 + h) * 192; const bf16* pp = KPE + (size_t)kr * ROPED + 16 * q;
        f32x4 tq[8];
        if (lat) { const int pos = (q < 2) ? (spos >> 6) : (spos & 63); const float* tp = T16 + (size_t)pos * 32;
#pragma unroll
            for (int i = 0; i < 8; ++i) tq[i] = *(const f32x4*)(tp + 4 * i); }
        float xn[32], xp[16];
#pragma unroll
        for (int i = 0; i < 4; ++i) { float t8[8]; unpack8(*(const v4u*)(kp + 32 * q + 8 * i), t8);
#pragma unroll
            for (int e = 0; e < 8; ++e) xn[8 * i + e] = t8[e]; }
#pragma unroll
        for (int i = 0; i < 2; ++i) { float t8[8]; unpack8(*(const v4u*)(pp + 8 * i), t8);
#pragma unroll
            for (int e = 0; e < 8; ++e) xp[8 * i + e] = t8[e]; }
        float ss = 0.f;
#pragma unroll
        for (int e = 0; e < 32; ++e) ss += xn[e] * xn[e];
#pragma unroll
        for (int e = 0; e < 16; ++e) ss += xp[e] * xp[e];
        ss += dppx<0xB1>(ss); ss += dppx<0x4E>(ss);
        const float r = 1.0f / sqrtf(ss * (1.0f / MLAQK) + EPS);
#pragma unroll
        for (int e = 0; e < 32; ++e) xn[e] = xn[e] * r * gn[e];
#pragma unroll
        for (int e = 0; e < 16; ++e) xp[e] = xp[e] * r * gp[e];
        if (lat) {
#pragma unroll
            for (int e = 0; e < 16; ++e) { const float p = dppx<0xB1>(xp[e]); const float cs = tq[e >> 1][2 * (e & 1)], sn = tq[e >> 1][2 * (e & 1) + 1]; xp[e] = xp[e] * cs + ((q & 1) ? p : -p) * sn; } }
        if (ATT_KF8) { unsigned char* k8 = (unsigned char*)(ws + WS_K8) + ((size_t)kr * 16 + h) * 192; unsigned wn[8], wp[4];
#pragma unroll
            for (int i = 0; i < 8; ++i) { int tt = 0; tt = cvt_pk_fp8_sat(xn[4 * i] * ATT_KS8, xn[4 * i + 1] * ATT_KS8, tt, false); tt = cvt_pk_fp8_sat(xn[4 * i + 2] * ATT_KS8, xn[4 * i + 3] * ATT_KS8, tt, true); wn[i] = (unsigned)tt; }
#pragma unroll
            for (int i = 0; i < 4; ++i) { int tt = 0; tt = cvt_pk_fp8_sat(xp[4 * i] * ATT_KS8, xp[4 * i + 1] * ATT_KS8, tt, false); tt = cvt_pk_fp8_sat(xp[4 * i + 2] * ATT_KS8, xp[4 * i + 3] * ATT_KS8, tt, true); wp[i] = (unsigned)tt; }
            *(v4u*)(k8 + 32 * q) = (v4u){wn[0], wn[1], wn[2], wn[3]}; *(v4u*)(k8 + 32 * q + 16) = (v4u){wn[4], wn[5], wn[6], wn[7]}; *(v4u*)(k8 + 128 + 16 * q) = (v4u){wp[0], wp[1], wp[2], wp[3]};
        } else {
#pragma unroll
        for (int i = 0; i < 4; ++i) { float t8[8];
#pragma unroll
            for (int e = 0; e < 8; ++e) t8[e] = xn[8 * i + e];
            *(v4u*)(kp + 32 * q + 8 * i) = pack8(t8); }
#pragma unroll
        for (int i = 0; i < 2; ++i) { float t8[8];
#pragma unroll
            for (int e = 0; e < 8; ++e) t8[e] = xp[8 * i + e];
            *(v4u*)(kp + 128 + 16 * q + 8 * i) = pack8(t8); }
        }
    }
}
__device__ __forceinline__ void phase6_vt(const Args& a, LAS unsigned char* lds, int vcu, int G) {
    const int tid = threadIdx.x, lane = tid & 63, wave = __builtin_amdgcn_readfirstlane(tid >> 6); unsigned char* ws = a.ws;
    const bf16* VB = (const bf16*)(ws + WS_VB); const bf16* GV = (const bf16*)(ws + WS_GV); unsigned char* VT8 = ws + WS_VT8;
    LAS unsigned short* scr = (LAS unsigned short*)(lds + RING_OFF + wave * 16384);
    const int gw = vcu * NWAVES + wave, NGW = G * NWAVES;
    for (int it4 = gw; it4 < (KVROWS / 64) * 4; it4 += NGW) {
        const int T = it4 >> 2, hd = 16 + (it4 & 3), it = T * 20 + hd;
        const bf16* src = (hd < 16) ? VB + ((size_t)T * 64 * 16 + hd) * 128 : GV + ((size_t)T * 64 * 4 + (hd - 16)) * 128; const size_t rs = (hd < 16) ? 2048 : 512;
#pragma unroll 4
        for (int i = 0; i < 16; ++i) { const int row = 4 * i + (lane >> 4), c8 = (lane & 15) * 8; const v4u w = *(const v4u*)(src + (size_t)row * rs + c8); *(LAS v4u*)(scr + row * 128 + c8) = w; }
        LDS_WAIT(); asm volatile("" ::: "memory");
        unsigned char* dst = VT8 + (size_t)it * 10240;
#pragma unroll
        for (int cc = 0; cc < 2; ++cc) { const int c = lane + 64 * cc;
#pragma unroll
            for (int k4 = 0; k4 < 4; ++k4) { unsigned wd[4];
#pragma unroll
                for (int q4 = 0; q4 < 4; ++q4) { const int q = 4 * k4 + q4, hi2 = q >> 3, b0 = (4 * q) & 31; float v[4];
#pragma unroll
                    for (int j = 0; j < 4; ++j) { const int b = b0 + j, key = 32 * (b >> 4) + 8 * ((b & 15) >> 2) + 4 * hi2 + (b & 3); v[j] = __uint_as_float(((unsigned)scr[key * 128 + c]) << 16) * 32.f; }
                    int tt = 0; tt = cvt_pk_fp8_sat(v[0], v[1], tt, false); tt = cvt_pk_fp8_sat(v[2], v[3], tt, true); wd[q4] = (unsigned)tt; }
                *(v4u*)(dst + c * 80 + 16 * k4) = (v4u){wd[0], wd[1], wd[2], wd[3]}; } }
        LDS_WAIT(); asm volatile("" ::: "memory");
    }
}
__device__ __forceinline__ void phase7(const Args& a, LAS unsigned char* ldsl, char* lds, int vcu, int G) {
    unsigned char* ws = a.ws;
    constexpr long KES = ATT_KF8 ? 1 : 2;
    const char* VT8 = (const char*)(ws + WS_VT8); constexpr long VTS = 20 * 10240;
    const bf16* QRAW = (const bf16*)(ws + WS_QRAW); const char* KB = (const char*)(ws + (ATT_KF8 ? WS_K8 : WS_KB)); const bf16* VB = (const bf16*)(ws + WS_VB);
    const bf16* GQ = (const bf16*)(ws + WS_GQ); const char* GK = (const char*)(ws + WS_GK); const bf16* GV = (const bf16*)(ws + WS_GV);
    constexpr long MIXS = MIX_FP8 ? 1 : 2; constexpr long LDO = DM;
    bf16* MIX = (bf16*)(ws + WS_HB); const float* T16 = (const float*)(ws + WS_ROPE16); const float* gmq = a.in[17]; const float* sink = a.in[21];
    constexpr float NOSINK = -1e30f, L2E = 1.4426950408889634f;
    constexpr int U_ML = NLAT * MLAH * (LSEQ / 256), U_GL = NLAT * GKVH * (LSEQ / 128) * 2, U_MC = NPROMPT * MLAH, U_GC = NPROMPT * GQH;
#ifndef ATT_ONLY
#define ATT_ONLY 15
#endif
#define ATT_TID() int tid = threadIdx.x; asm volatile("" : "+v"(tid)); const int wave = __builtin_amdgcn_readfirstlane(tid >> 6), r32 = tid & 31
    if (ATT_ONLY & 1) for (int u = vcu; u < U_ML; u += G) {
        ATT_TID();
        const int qt = u & 15, h = (u >> 4) & 15, b = u >> 8; const int qpos = qt * 256 + wave * 32 + r32; const size_t trow = (size_t)TP + (size_t)b * LSEQ + qpos;
        const size_t kr0 = (size_t)TP + (size_t)b * (PAST + LSEQ);
        att::attn_body<192, true, false, MIX_FP8, ATT_KF8, ATT_VF8>(QRAW + trow * 3072 + h * 192, gmq, T16, qpos >> 6, qpos & 63, (const bf16*)(KB + (kr0 * 16 + h) * 192 * KES), 3072, ATT_VF8 ? (const bf16*)(VT8 + ((kr0 >> 6) * 20 + h) * 10240) : VB + (kr0 * 16 + h) * 128, ATT_VF8 ? VTS : 2048,
                                         0, (PAST + LSEQ) / 64, 0, 0, 0, 0, NOSINK, (bf16*)((char*)MIX + (((size_t)TP + (size_t)b * LSEQ + qt * 256 + wave * 32) * DM + h * 128) * MIXS), LDO, lds, ldsl, tid);
    }
    if (ATT_ONLY & 2) for (int v = vcu; v < U_GL; v += G) {
        ATT_TID();
        const int gp = v & 1, c = (v >> 1) & 31, n = (v >> 6) & 3, b = v >> 8; const int h = 4 * n + 2 * gp + (wave >> 2);
        const int q0 = 128 * c + 32 * (wave & 3), qi = q0 + r32; const size_t trow = (size_t)TP + (size_t)b * LSEQ + qi;
        const size_t kr0 = (size_t)TP + (size_t)b * (PAST + LSEQ);
        const int js = c > 0 ? 128 * (c - 1) : 0, je = (c < 31) ? 128 * (c + 2) : LSEQ;
        att::attn_body<128, false, true, MIX_FP8, ATT_KF8, ATT_VF8, (GQ_FP8 && ATT_KF8)>((GQ_FP8 && ATT_KF8) ? (const bf16*)((const unsigned char*)GQ + (trow * 16 + h) * 128) : GQ + (trow * 16 + h) * 128, nullptr, nullptr, 0, 0, (const bf16*)(GK + (kr0 * 4 + n) * 128 * KES), 512, ATT_VF8 ? (const bf16*)(VT8 + ((kr0 >> 6) * 20 + 16 + n) * 10240) : GV + (kr0 * 4 + n) * 128, ATT_VF8 ? VTS : 512,
                                         0, PAST / 64, PAST + js, (je - js) / 64, js, qi, sink[h] * L2E, (bf16*)((char*)MIX + (((size_t)TP + (size_t)b * LSEQ + q0) * DM + 2048 + h * 128) * MIXS), LDO, lds, ldsl, tid);
    }
    if (ATT_ONLY & 4) for (int v = vcu; v < U_MC; v += G) {
        ATT_TID();
        const int h = v & 15, p = v >> 4; const size_t trow = (size_t)p * SEQ + wave * 32 + r32; const size_t kr0 = (size_t)p * SEQ;
        att::attn_body<192, true, false, MIX_FP8, ATT_KF8, ATT_VF8>(QRAW + trow * 3072 + h * 192, gmq, nullptr, 0, 0, (const bf16*)(KB + (kr0 * 16 + h) * 192 * KES), 3072, ATT_VF8 ? (const bf16*)(VT8 + ((kr0 >> 6) * 20 + h) * 10240) : VB + (kr0 * 16 + h) * 128, ATT_VF8 ? VTS : 2048,
                                         0, SEQ / 64, 0, 0, 0, 0, NOSINK, (bf16*)((char*)MIX + (((size_t)p * SEQ + wave * 32) * DM + h * 128) * MIXS), LDO, lds, ldsl, tid);
    }
    if (ATT_ONLY & 8) for (int v = vcu; v < U_GC; v += G) {
        ATT_TID();
        const int h = v & 15, p = v >> 4; const size_t trow = (size_t)p * SEQ + wave * 32 + r32; const size_t kr0 = (size_t)p * SEQ;
        att::attn_body<128, false, false, MIX_FP8, ATT_KF8, ATT_VF8, (GQ_FP8 && ATT_KF8)>((GQ_FP8 && ATT_KF8) ? (const bf16*)((const unsigned char*)GQ + (trow * 16 + h) * 128) : GQ + (trow * 16 + h) * 128, nullptr, nullptr, 0, 0, (const bf16*)(GK + (kr0 * 4 + (h >> 2)) * 128 * KES), 512, ATT_VF8 ? (const bf16*)(VT8 + ((kr0 >> 6) * 20 + 16 + (h >> 2)) * 10240) : GV + (kr0 * 4 + (h >> 2)) * 128, ATT_VF8 ? VTS : 512,
                                          0, SEQ / 64, 0, 0, 0, 0, sink[h] * L2E, (bf16*)((char*)MIX + (((size_t)p * SEQ + wave * 32) * DM + 2048 + h * 128) * MIXS), LDO, lds, ldsl, tid);
    }
}
#undef ATT_TID
__device__ __forceinline__ void wup_convert_dyn(const Args& a, LAS unsigned char* lds, unsigned* ctr, unsigned lo, unsigned hi) {
    const int tid = threadIdx.x, lane = tid & 63, wave = __builtin_amdgcn_readfirstlane(tid >> 6); unsigned char* ws = a.ws;
    LAS float* scr = (LAS float*)(lds + RING_OFF + wave * 16384);
    for (;;) { unsigned it0 = 0; if (lane == 0) it0 = atomicAdd(ctr, 4u); it0 = lo + __builtin_amdgcn_readfirstlane(it0); if (it0 >= hi) break;
        for (unsigned it = it0; it < it0 + 4u && it < hi; ++it)
            p0_transpose_item_i8(a.in[23], DM, 22016, (signed char*)(ws + WS_WUP), MapUpPerm{(const unsigned*)(ws + WS_RANK)}, (const unsigned*)(ws + WS_COLMAX), (float*)(ws + WS_COLSC), scr, (int)it, lane); }
}
__device__ __forceinline__ void wqo_convert_dyn(const Args& a, LAS unsigned char* lds, unsigned* ctr) {
    const int tid = threadIdx.x, lane = tid & 63, wave = __builtin_amdgcn_readfirstlane(tid >> 6); unsigned char* ws = a.ws;
    LAS float* scr = (LAS float*)(lds + RING_OFF + wave * 16384);
    constexpr unsigned NQ = (QRANK / 64) * (3072 / 32), NO = (DM / 64) * (DM / 32);
    for (;;) { unsigned it0 = 0; if (lane == 0) it0 = atomicAdd(ctr, 4u); it0 = __builtin_amdgcn_readfirstlane(it0); if (it0 >= NQ + NO) break;
        for (unsigned it = it0; it < it0 + 4u && it < NQ + NO; ++it) {
            if (it < NQ) p0_transpose_item_fp8(a.in[14], QRANK, 3072, (unsigned char*)(ws + WS_WQUP), scr, (int)it, lane);
            else p0_transpose_item_fp8(a.in[22], DM, DM, (unsigned char*)(ws + WS_WOUT), scr, (int)(it - NQ), lane); } }
}
__device__ __forceinline__ void wdown_convert_dyn(const Args& a, LAS unsigned char* lds, unsigned* ctr) {
    const int tid = threadIdx.x, lane = tid & 63, wave = __builtin_amdgcn_readfirstlane(tid >> 6); unsigned char* ws = a.ws;
    LAS float* scr = (LAS float*)(lds + RING_OFF + wave * 16384); const unsigned* sigma = (const unsigned*)(ws + WS_SIGMA);
    constexpr unsigned NIT = (DFF / 64) * (DM / 32);
    for (;;) { unsigned it0 = 0; if (lane == 0) it0 = atomicAdd(ctr, 4u); it0 = __builtin_amdgcn_readfirstlane(it0); if (it0 >= NIT) break;
        for (unsigned it = it0; it < it0 + 4u && it < NIT; ++it) { const int k0 = 64 * (int)(it / (DM / 32));
            if (k0 < GK8) p0_transpose_item_fp8(a.in[26], GPB, DM, (unsigned char*)(ws + WS_WDOWN), scr, (int)it, lane, 0, sigma);
            else p0_transpose_item(a.in[26], GPB / 2, DM, (bf16*)(ws + WS_WDOWN) - GK8 / 2, MapId(), scr, (int)it, lane, sigma); } }
}
__device__ __forceinline__ void phase11(const Args& a, int vcu, int G) {
    const int tid = threadIdx.x; unsigned char* ws = a.ws;
    const float* edge = (const float*)(ws + WS_EDGE); bf16* Gb = (bf16*)(ws + WS_G); const float* cw = FFN_SORT ? (const float*)(ws + WS_CWP) : a.in[24];
    const int nrun = MTOK / 64; const size_t total = (size_t)nrun * 2 * (DFF / 4);
    for (size_t i = (size_t)vcu * NTHREADS + tid; i < total; i += (size_t)G * NTHREADS) {
        const int c4 = (int)(i % (DFF / 4)); const int rr = (int)(i / (DFF / 4)); const int rho = rr >> 1, last = rr & 1; const int c = c4 * 4;
        const int t = rho * 64 + (last ? 63 : 0); const int L = (t < TP) ? SEQ : LSEQ;
        const float* e = edge + ((size_t)rho * 4 + (last ? 2 : 0)) * 22016;
        f32x4 pg = *(const f32x4*)(e + c), pv = *(const f32x4*)(e + DFF + c);
        const bool has = last ? (((t + 1) % L) != 0) : ((t % L) != 0);
        if (has) { const float* ne = edge + ((size_t)(last ? rho + 1 : rho - 1) * 4 + (last ? 1 : 3)) * 22016; const float* w = cw + (last ? 2 * 22016 : 0);
            pg += *(const f32x4*)(w + c) * *(const f32x4*)(ne + c); pv += *(const f32x4*)(w + DFF + c) * *(const f32x4*)(ne + DFF + c); }
        auto gate = [](float a_, float b_) __attribute__((always_inline)) { return (TAP_FOLD && FFN_SORT) ? (a_ * __builtin_amdgcn_rcpf(1.0f + __builtin_amdgcn_exp2f(a_))) * b_ : silu_f(a_) * b_; };
        const float g0 = gate(pg.x, pv.x), g1 = gate(pg.y, pv.y), g2 = gate(pg.z, pv.z), g3 = gate(pg.w, pv.w);
        unsigned char* grow = (unsigned char*)Gb + (size_t)t * GPB; const float s8 = (TAP_FOLD && FFN_SORT) ? 1.0f : SG8;
        if (c < GK8) { int tt = 0; tt = cvt_pk_fp8_sat(g0 * s8, g1 * s8, tt, false); tt = cvt_pk_fp8_sat(g2 * s8, g3 * s8, tt, true); *(unsigned*)(grow + c) = (unsigned)tt; }
        else { v2u o; o.x = pk2(g0, g1); o.y = pk2(g2, g3); *(v2u*)(grow + GK8 + (size_t)(c - GK8) * 2) = o; }
    }
}

#ifndef LB2
#define LB2 2
#endif
__global__ void __launch_bounds__(NTHREADS, LB2) mk_fwd(Args args) {
    extern __shared__ __attribute__((aligned(16))) unsigned char lds_raw[];
    LAS unsigned char* lds = (LAS unsigned char*)lds_raw;
    volatile LAS unsigned* MISC = (volatile LAS unsigned*)(lds + MISC_OFF);
    const int tid = threadIdx.x;
    const int G = gridDim.x; const int bx = blockIdx.x; const int vcu = (G % 8 == 0) ? (bx % 8) * (G / 8) + bx / 8 : bx;
    unsigned char* ws = args.ws;
    unsigned* ctl = (unsigned*)(ws + WS_CTL);
    { int tz = tid; asm volatile("" : "+v"(tz));
      for (int u = tz; u < (LDS_BYTES - RING_BYTES) / 4; u += NTHREADS) ((LAS unsigned*)(lds + RING_BYTES))[u] = 0u; }
    __syncthreads();
    XcdBarrier bar; bar.bar = ctl + CW_BAR; bar.x = 0; bar.st = nullptr;
    if (MK_ONE_LAUNCH) bar = xcd_barrier_post(ctl + CW_BAR, MISC + 8);
    const int lo = args.ph_lo, hi = args.ph_hi;
#ifndef PH_MASK
#define PH_MASK 0x1fff
#endif
#define IN(k) (((PH_MASK >> (k)) & 1) && lo <= (k) && (k) < hi)
#ifndef DUP_MASK
#define DUP_MASK 0
#endif
#define DUPQ(k) ((DUP_MASK >> (k)) & 1)
#define SEAM(k) do { if (IN(k) && IN((k) + 1)) xcd_barrier(bar); } while (0)
    const float* mod = (const float*)(ws + WS_MOD);
    bf16* HB = (bf16*)(ws + WS_HB);
    float* Y = args.out + OUT_Y; bf16* X1 = (bf16*)(ws + WS_X1);

    auto run3 = [&]() __attribute__((always_inline)) {
        { pg8::Gemm g{HB, (const bf16*)(ws + WS_WIN), MTOK, ZBW, DM}; pg8::StaticOrder S; S.init(MTOK, ZBW, G, bx, W_P3B);
          pg8::EpiBf16 E{(bf16*)(ws + WS_ZB), ZBW, 1.0f};
          pg8::gemm_phase<pg8::EpiBf16, pg8::StaticOrder, GEMM_ALIGN, GEMM_SP2>(lds + RING_OFF, g, S, E); }
        __syncthreads();
        { pg8::Gemm g{(const bf16*)(ws + WS_H8), (const bf16*)(ws + WS_WINQ), MTOK, ZQW, DM / 2}; pg8::StaticOrder S; S.init(MTOK, ZQW, G, bx, W_P3Q);
          pg8::EpiBf16T<true> E{(bf16*)(ws + WS_Z), ZQW, 1.0f / 4096.0f};
          pg8::gemm_phase<pg8::EpiBf16T<true>, pg8::StaticOrder, GEMM_ALIGN, GEMM_SP2>(lds + RING_OFF, g, S, E); } };
    auto run5 = [&]() __attribute__((always_inline)) {
        { pg8::Gemm g{(const bf16*)(ws + WS_CKV), (const bf16*)(ws + WS_WKVUP), KVROWS, 4096, (KVUP_FP8 || KVUP_I8) ? KVRANK / 2 : KVRANK}; pg8::StaticOrder S; S.init(KVROWS, 4096, G, bx, W_P5K);
          if constexpr (KV_FUSE) { static_assert(!KV_FUSE || (KVUP_I8 && ATT_VF8 && ATT_KF8 && GEMM_ALIGN), "KV_FUSE needs the int8 kv-up GEMM, fp8 keys / V images and aligned epilogues");
            typedef pg8::EpiKVFuse<WS_K8, WS_VT8, WS_CKVS, WS_KVCS, WS_KPESS, WS_KPE> EKF;
            EKF E{ws, args.in[18], (LAS float*)(lds + RING_BYTES + 4096), ATT_KS8};
            pg8::gemm_phase<EKF, pg8::StaticOrder, GEMM_ALIGN, GEMM_SP2>(lds + RING_OFF, g, S, E); }
          else {
          typedef pg8::EpiKVT<ATT_VF8, KVUP_FP8 && !KVUP_I8, KVUP_I8> EKV;
          EKV E{(bf16*)(ws + WS_KB), (bf16*)(ws + WS_VB), ws + WS_VT8, (const float*)(ws + WS_CKVS), (const float*)(ws + WS_KVCS)};
          pg8::gemm_phase<EKV, pg8::StaticOrder, GEMM_ALIGN, GEMM_SP2>(lds + RING_OFF, g, S, E); } }
        __syncthreads();
        { pg8::Gemm g{(const bf16*)(ws + WS_QN), (const bf16*)(ws + WS_WQUP), MTOK, 3072, (QUP_FP8 || QUP_I8) ? QRANK / 2 : QRANK}; pg8::StaticOrder S; S.init(MTOK, 3072, G, bx, W_P5Q);
          pg8::EpiBf16T<QUP_FP8 && !QUP_I8, QUP_I8> E{(bf16*)(ws + WS_QRAW), 3072, QUP_I8 ? (1.0f / 16.0f) * (0.15875f / 127.0f) : (QUP_FP8 ? 1.0f / 4096.0f : 1.0f)};
          pg8::gemm_phase<pg8::EpiBf16T<QUP_FP8 && !QUP_I8, QUP_I8>, pg8::StaticOrder, GEMM_ALIGN, GEMM_SP2>(lds + RING_OFF, g, S, E); } };
    auto run8 = [&]() __attribute__((always_inline)) {
        pg8::Gemm g{HB, (const bf16*)(ws + WS_WOUT), MTOK, DM, MIX_FP8 ? DM / 2 : DM}; pg8::StaticOrder S; S.init(MTOK, DM, G, bx, W_P8);
        pg8::EpiResT<MIX_FP8, false, true> E{args.in[0], args.in[1], X1, mod + 2 * 4096, MIX_FP8 ? PROBE_GSCALE * (1.0f / 8192.0f) : PROBE_GSCALE, 1.0f};
        pg8::gemm_phase<pg8::EpiResT<MIX_FP8, false, true>, pg8::StaticOrder, GEMM_ALIGN, GEMM_SP2>(lds + RING_OFF, g, S, E); };
    auto run10 = [&]() __attribute__((always_inline)) {
        pg8::Gemm g{HB, (const bf16*)(ws + WS_WUP), MTOK, 22016, UP_I8 ? DM / 2 : DM}; pg8::StaticOrder S; S.init(MTOK, 22016, G, bx, W_P10);
        pg8::EpiUpT<(UP_I8 && !PROBE_UPF8), (TAP_FOLD && FFN_SORT)> E{(LAS float*)(lds + RING_BYTES + 4096), (unsigned char*)(ws + WS_G), FFN_SORT ? (const float*)(ws + WS_CWP) : args.in[24], FFN_SORT ? (const float*)(ws + WS_CBP) : args.in[25], (float*)(ws + WS_EDGE), GK8, GPB, SG8, (const float*)(ws + WS_ROWSC), (const float*)(ws + WS_COLSC)};
        pg8::gemm_phase<pg8::EpiUpT<(UP_I8 && !PROBE_UPF8), (TAP_FOLD && FFN_SORT)>, pg8::StaticOrder, GEMM_ALIGN, GEMM_SP2>(lds + RING_OFF, g, S, E); };
    auto run12 = [&]() __attribute__((always_inline)) {
        pg8::Gemm g{(const bf16*)(ws + WS_G), (const bf16*)(ws + WS_WDOWN), MTOK, DM, GPB / 2}; pg8::StaticOrder S; S.init(MTOK, DM, G, bx, W_P12);
        pg8::EpiResT<false, true, false, DOWN_NT8> E{X1, X1 + (size_t)TP * DM, Y, mod + 5 * 4096, PROBE_GSCALE2, 1.0f / (SG8 * SW8)};
        pg8::gemm_phase<pg8::EpiResT<false, true, false, DOWN_NT8>, pg8::StaticOrder, GEMM_ALIGN, GEMM_SP2>(lds + RING_OFF, g, S, E); };
    if (IN(0)) { phase0(args, lds, vcu, G); if (DUPQ(0)) { __syncthreads(); phase0(args, lds, vcu, G); } } SEAM(0);
    if (IN(1)) { phase1(args, lds, vcu, G); if (DUPQ(1)) phase1(args, lds, vcu, G); } SEAM(1);
    if (IN(2)) { phase_norm<false>(args.in[0], args.in[1], args.in[8], mod, 0, 4096, HB, (unsigned char*)(ws + WS_H8), nullptr, lds, vcu, G); if (DUPQ(2)) phase_norm<false>(args.in[0], args.in[1], args.in[8], mod, 0, 4096, HB, (unsigned char*)(ws + WS_H8), nullptr, lds, vcu, G); } SEAM(2);
    constexpr unsigned UP_ITEMS = (DM / 64) * (22016 / 32);
    if (IN(3)) { run3(); if (DUPQ(3)) { __syncthreads(); run3(); }
        if (UP_TAIL && UP_I8 && FFN_SORT) { __syncthreads(); wup_convert_dyn(args, lds, ctl + 16448, 0u, UPT_A); }
        if (W_TAIL3 && QUP_FP8 && !QUP_I8 && MIX_FP8) { __syncthreads(); wqo_convert_dyn(args, lds, ctl + 16640); } } SEAM(3);
    if (IN(4)) { phase4(args, vcu, G); if (DUPQ(4)) phase4(args, vcu, G); } SEAM(4);
    if (IN(5)) { run5(); if (DUPQ(5)) { __syncthreads(); run5(); }
        if (KV_FUSE && ATT_VF8 && ((PH_MASK >> 6) & 1)) { __syncthreads(); phase6_vt(args, lds, vcu, G); }
        if (UP_TAIL && UP_I8 && FFN_SORT) { __syncthreads(); wup_convert_dyn(args, lds, ctl + 16512, UPT_A, UPT_B); } }
    if (!KV_FUSE) SEAM(5);
    if (IN(6)) { if (!KV_FUSE) { phase6(args, lds, vcu, G); if (ATT_VF8) phase6_vt(args, lds, vcu, G); if (DUPQ(6)) { phase6(args, lds, vcu, G); if (ATT_VF8) phase6_vt(args, lds, vcu, G); } } } SEAM(6);
    if (IN(7)) { phase7(args, lds, (char*)lds_raw, vcu, G); if (DUPQ(7)) { __syncthreads(); phase7(args, lds, (char*)lds_raw, vcu, G); } } SEAM(7);
    if (IN(8)) { run8(); if (DUPQ(8)) { __syncthreads(); run8(); } } SEAM(8);
    if (IN(9)) { phase_norm<true>(X1, X1, args.in[9], mod, 3 * 4096, 4 * 4096, HB, UP_I8 ? (unsigned char*)HB : nullptr, UP_I8 ? (float*)(ws + WS_ROWSC) : nullptr, lds, vcu, G); if (DUPQ(9)) phase_norm<true>(X1, X1, args.in[9], mod, 3 * 4096, 4 * 4096, HB, UP_I8 ? (unsigned char*)HB : nullptr, UP_I8 ? (float*)(ws + WS_ROWSC) : nullptr, lds, vcu, G);
        if (UP_TAIL && UP_I8 && FFN_SORT) { __syncthreads(); wup_convert_dyn(args, lds, ctl + 16576, UPT_B, UP_ITEMS); } } SEAM(9);
    if (IN(10)) { run10(); if (DUPQ(10)) { __syncthreads(); run10(); }
        if (DOWN_TAIL && FFN_SORT) { __syncthreads(); wdown_convert_dyn(args, lds, ctl + 16384); } } SEAM(10);
    if (IN(11)) { phase11(args, vcu, G); if (DUPQ(11)) phase11(args, vcu, G); } SEAM(11);
    if (IN(12)) { run12(); if (DUPQ(12)) { __syncthreads(); run12(); } }
#undef IN
#undef SEAM
}

extern "C" void kernel_launch(void* const* d_in, const int* in_sizes, int n_in, void* d_out, int out_size, void* d_ws, size_t ws_size, hipStream_t stream) {
    static int grid = 0;
    if (grid == 0) {
        if (n_in != 27 || in_sizes[0] != TP * DM || in_sizes[1] != TL * DM || (size_t)out_size != OUT_END || ws_size < WS_END) {
            fprintf(stderr, "kernel_launch: shape mismatch: n_in %d in0 %d in1 %d out %d ws %zu (need >= %zu); nothing launched\n", n_in, n_in > 0 ? in_sizes[0] : -1, n_in > 1 ? in_sizes[1] : -1, out_size, ws_size, (size_t)WS_END); grid = -1; return; }
        int dev = 0, cus = 0, per_cu = 0;
        if (hipGetDevice(&dev) != hipSuccess || hipDeviceGetAttribute(&cus, hipDeviceAttributeMultiprocessorCount, dev) != hipSuccess) { fprintf(stderr, "kernel_launch: device query failed\n"); grid = -1; return; }
        if (hipFuncSetAttribute((const void*)mk_fwd, hipFuncAttributeMaxDynamicSharedMemorySize, LDS_BYTES) != hipSuccess) { fprintf(stderr, "kernel_launch: hipFuncSetAttribute failed\n"); grid = -1; return; }
        if (hipOccupancyMaxActiveBlocksPerMultiprocessor(&per_cu, (const void*)mk_fwd, NTHREADS, LDS_BYTES) != hipSuccess || per_cu < 1) { fprintf(stderr, "kernel_launch: occupancy query says %d blocks per CU\n", per_cu); }
        (void)hipGetLastError();
        grid = cus;
    }
    if (grid < 0) return;
    if (hipMemsetAsync((char*)d_ws + WS_CTL, 0, CTL_ZERO_BYTES, stream) != hipSuccess) { fprintf(stderr, "kernel_launch: memset failed\n"); return; }
    Args a{};
    for (int i = 0; i < 27; ++i) a.in[i] = (const float*)d_in[i];
    a.out = (float*)d_out; a.ws = (unsigned char*)d_ws;
#if MK_ONE_LAUNCH
    a.ph_lo = 0; a.ph_hi = N_PHASES;
    hipLaunchKernelGGL(mk_fwd, dim3(grid), dim3(NTHREADS), LDS_BYTES, stream, a);
#else
    for (int p = 0; p < N_PHASES; ++p) { a.ph_lo = p; a.ph_hi = p + 1; hipLaunchKernelGGL(mk_fwd, dim3(grid), dim3(NTHREADS), LDS_BYTES, stream, a); }
#endif
    const hipError_t le = hipPeekAtLastError();
    if (le != hipSuccess) fprintf(stderr, "kernel_launch: launch failed: %s\n", hipGetErrorName(le));
}
```

```cpp
#include <hip/hip_runtime.h>
#include <cstdio>
#include <cstdint>
__device__ __forceinline__ int cvt_pk_fp8_sat(float a, float b, int old, bool hi) { a = __builtin_amdgcn_fmed3f(a, -448.f, 448.f); b = __builtin_amdgcn_fmed3f(b, -448.f, 448.f); return hi ? __builtin_amdgcn_cvt_pk_fp8_f32(a, b, old, true) : __builtin_amdgcn_cvt_pk_fp8_f32(a, b, old, false); }
#ifndef PG8_WGM
#define PG8_WGM 8
#endif
namespace pg8 {
#define PG8_LAS __attribute__((address_space(3)))
typedef unsigned short bf16_t;
typedef short bf16x8 __attribute__((ext_vector_type(8)));
typedef float f32x4 __attribute__((ext_vector_type(4)));
typedef unsigned u32x4 __attribute__((ext_vector_type(4)));
constexpr int BM = 256, BK = 64, HALF = 128, HTB = HALF * BK * 2  , STAGE_BYTES = 8 * HTB, NXCD = 8, WGM = PG8_WGM;

__host__ __device__ __forceinline__ int lds_byte(int r, int c) { const int st = (r >> 4) * 2 + (c >> 5), rr = r & 15, cc = c & 31, ob = rr * 64 + cc * 2; return st * 1024 + (ob ^ (((ob >> 9) & 1) << 5)); }
__host__ __device__ __forceinline__ void stage_rc(int b, int& R, int& C) { const int st = b / 1024, sb = b % 1024, swz = sb ^ (((sb >> 9) & 1) << 5); R = (st >> 1) * 16 + swz / 64; C = (st & 1) * 32 + (swz % 64) / 2; }
__host__ __device__ __forceinline__ int perm32(int rho) { const int n = rho >> 4, i = rho & 15; return 8 * (i >> 2) + 4 * n + (i & 3); }

struct Unit { int pm, pn, slot; };
struct Gemm { const bf16_t* A; const bf16_t* Bt; int M, N, K; };

struct StaticOrder {
    int nM, nN, nwg, G, c, wgm;
    __host__ __device__ void init(int M, int N, int G_, int c_, int wgm_ = WGM) { nM = M / BM; nN = N / BM; nwg = nM * nN; G = G_; c = c_; wgm = wgm_; }
    __host__ __device__ bool next(int i, Unit& u) const {
        const long L = (long)i * G + c; if (L >= nwg) return false;
        int wgid = (int)L; { const int q = nwg / NXCD, r = nwg % NXCD, xcd = wgid % NXCD, off = wgid / NXCD; wgid = (xcd < r ? xcd * (q + 1) : r * (q + 1) + (xcd - r) * q) + off; }
        const int nig = wgm * nN, gid = wgid / nig, fm = gid * wgm, gsz = (nM - fm) < wgm ? (nM - fm) : wgm;
        u.pm = fm + ((wgid % nig) % gsz); u.pn = (wgid % nig) / gsz; return true;
    }
    __device__ __forceinline__ void a_ready(const Unit&) const {}
    __device__ __forceinline__ void done(const Unit&) const {}
};

__device__ __forceinline__ unsigned cvt_pk_bf16(float lo, float hi) { unsigned r; asm volatile("v_cvt_pk_bf16_f32 %0, %1, %2" : "=v"(r) : "v"(lo), "v"(hi)); return r; }
#ifndef PROBE_QPERMA
#define PROBE_QPERMA false
#endif
template <bool F8, bool I8_ = false> struct EpiBf16T {
    static constexpr bool PERM = true, AFTER_DRAIN = false, PERMA = I8_ && PROBE_QPERMA, FP8 = F8; static constexpr int NT8 = 0; static constexpr bool I8 = I8_;
    bf16_t* O; int ldc; float scale;
    __device__ __forceinline__ void operator()(const f32x4 (&acc)[2][2][4][2], const Unit& u, int wr, int wc, int fr, int fq) const {
        const int row0 = u.pm * BM + wr * 64, col0 = u.pn * BM + wc * 32 + 8 * fq;
#pragma unroll
        for (int ai = 0; ai < 2; ++ai)
#pragma unroll
            for (int m = 0; m < 4; ++m) { bf16_t* rowp = O + (size_t)(row0 + ai * HALF + (PERMA ? 4 * fr + m : m * 16 + fr)) * ldc + col0;
#pragma unroll
                for (int bj = 0; bj < 2; ++bj) { f32x4 v0, v1;
                    if constexpr (I8) { typedef int i32x4_ __attribute__((ext_vector_type(4))); v0 = __builtin_convertvector(__builtin_bit_cast(i32x4_, acc[ai][bj][m][0]), f32x4) * scale; v1 = __builtin_convertvector(__builtin_bit_cast(i32x4_, acc[ai][bj][m][1]), f32x4) * scale; }
                    else { v0 = acc[ai][bj][m][0] * scale; v1 = acc[ai][bj][m][1] * scale; }
                    u32x4 w; w.x = cvt_pk_bf16(v0[0], v0[1]); w.y = cvt_pk_bf16(v0[2], v0[3]); w.z = cvt_pk_bf16(v1[0], v1[1]); w.w = cvt_pk_bf16(v1[2], v1[3]);
                    *(u32x4*)(rowp + bj * HALF) = w; } }
    }
};
typedef EpiBf16T<false> EpiBf16;
template <bool VIMG, bool F8 = false, bool I8_ = false> struct EpiKVT {
    static constexpr bool PERM = true, AFTER_DRAIN = false, PERMA = VIMG, FP8 = F8; static constexpr int NT8 = 0; static constexpr bool I8 = I8_;
    bf16_t* Kb; bf16_t* Vb; unsigned char* Vt8; const float* rowscale; const float* colscale;
    __device__ __forceinline__ void operator()(const f32x4 (&accr)[2][2][4][2], const Unit& u, int wr, int wc, int fr, int fq) const {
        const int col0 = wc * 32 + 8 * fq;
        f32x4 acc[2][2][4][2];
        if constexpr (I8) { typedef int i32x4_ __attribute__((ext_vector_type(4))); f32x4 cs[2][2];
#pragma unroll
            for (int bj = 0; bj < 2; ++bj)
#pragma unroll
                for (int n = 0; n < 2; ++n) cs[bj][n] = *(const f32x4*)(colscale + u.pn * 256 + bj * 128 + col0 + 4 * n);
#pragma unroll
            for (int ai = 0; ai < 2; ++ai)
#pragma unroll
                for (int m = 0; m < 4; ++m) { const float rs = rowscale[(size_t)(u.pm * BM + ai * HALF + wr * 64 + (VIMG ? 4 * fr + m : 16 * m + fr))];
#pragma unroll
                    for (int bj = 0; bj < 2; ++bj)
#pragma unroll
                        for (int n = 0; n < 2; ++n) acc[ai][bj][m][n] = __builtin_convertvector(__builtin_bit_cast(i32x4_, accr[ai][bj][m][n]), f32x4) * (cs[bj][n] * rs); } }
        else {
#pragma unroll
            for (int ai = 0; ai < 2; ++ai)
#pragma unroll
                for (int bj = 0; bj < 2; ++bj)
#pragma unroll
                    for (int m = 0; m < 4; ++m)
#pragma unroll
                        for (int n = 0; n < 2; ++n) acc[ai][bj][m][n] = accr[ai][bj][m][n]; }
#pragma unroll
        for (int ai = 0; ai < 2; ++ai) {
#pragma unroll
            for (int m = 0; m < 4; ++m) { const size_t row = (size_t)(u.pm * BM + ai * HALF + wr * 64 + (VIMG ? 4 * fr + m : 16 * m + fr));
                { const f32x4 v0 = acc[ai][0][m][0] * (F8 ? 1.0f / 4096.0f : 1.0f), v1 = acc[ai][0][m][1] * (F8 ? 1.0f / 4096.0f : 1.0f); u32x4 w; w.x = cvt_pk_bf16(v0[0], v0[1]); w.y = cvt_pk_bf16(v0[2], v0[3]); w.z = cvt_pk_bf16(v1[0], v1[1]); w.w = cvt_pk_bf16(v1[2], v1[3]);
                  *(u32x4*)(Kb + row * 3072 + u.pn * 192 + col0) = w; }
                if constexpr (!VIMG) { const f32x4 v0 = acc[ai][1][m][0] * (F8 ? 1.0f / 4096.0f : 1.0f), v1 = acc[ai][1][m][1] * (F8 ? 1.0f / 4096.0f : 1.0f); u32x4 w; w.x = cvt_pk_bf16(v0[0], v0[1]); w.y = cvt_pk_bf16(v0[2], v0[3]); w.z = cvt_pk_bf16(v1[0], v1[1]); w.w = cvt_pk_bf16(v1[2], v1[3]);
                  *(u32x4*)(Vb + row * 2048 + u.pn * 128 + col0) = w; } }
            if constexpr (VIMG) { const int T = u.pm * 4 + ai * 2 + wr;
                unsigned char* img = Vt8 + ((size_t)T * 20 + u.pn) * 10240 + (fr & 1) * 32 + (fr >> 3) * 16 + ((fr >> 1) & 3) * 4;
#pragma unroll
                for (int n = 0; n < 2; ++n)
#pragma unroll
                    for (int j = 0; j < 4; ++j) { int t = 0; constexpr float vs = F8 ? 32.f / 4096.f : 32.f; t = cvt_pk_fp8_sat(acc[ai][1][0][n][j] * vs, acc[ai][1][1][n][j] * vs, t, false); t = cvt_pk_fp8_sat(acc[ai][1][2][n][j] * vs, acc[ai][1][3][n][j] * vs, t, true);
                        *(unsigned*)(img + (col0 + 4 * n + j) * 80) = (unsigned)t; } }
        }
    }
};
template <size_t O_K8, size_t O_VT8, size_t O_ROWSC, size_t O_COLSC, size_t O_KPESS, size_t O_KPER>
struct EpiKVFuse {
    static constexpr bool PERM = true, AFTER_DRAIN = false, PERMA = true, FP8 = false; static constexpr int NT8 = 0; static constexpr bool I8 = true;
    unsigned char* wsb; const float* gk; PG8_LAS float* part; float ks8;
    static constexpr bool PREFETCH = true;
    __device__ __forceinline__ void prefetch(const Unit& u, int wid, int lane) const {
        if (wid < 4) { const float* src = wid == 0 ? (const float*)(wsb + O_ROWSC) + u.pm * BM + lane * 4 : (wid == 1 ? (const float*)(wsb + O_COLSC) + u.pn * 256 + lane * 4 : (wid == 2 ? (const float*)(wsb + O_KPESS) + u.pm * BM + lane * 4 : gk + (lane & 31) * 4));
            __builtin_amdgcn_global_load_lds((const unsigned*)src, (PG8_LAS unsigned*)(part + 1024 + u.slot * 1024 + wid * 256), 16, 0, 0); }
    }
    __device__ __forceinline__ void operator()(const f32x4 (&accr)[2][2][4][2], const Unit& u, int wr, int wc, int fr, int fq) const {
        typedef int i32x4_ __attribute__((ext_vector_type(4))); typedef unsigned u32x2k __attribute__((ext_vector_type(2)));
        unsigned char* K8 = wsb + O_K8; unsigned char* Vt8 = wsb + O_VT8; const PG8_LAS float* P = part + 1024 + u.slot * 1024;
        const bf16_t* kper = (const bf16_t*)(wsb + O_KPER);
        const int col0 = wc * 32 + 8 * fq;
        f32x4 cs[2][2]; float rsv[2][4];
#pragma unroll
        for (int bj = 0; bj < 2; ++bj)
#pragma unroll
            for (int n = 0; n < 2; ++n) cs[bj][n] = *(const PG8_LAS f32x4*)(P + 256 + bj * 128 + col0 + 4 * n);
#pragma unroll
        for (int ai = 0; ai < 2; ++ai)
#pragma unroll
            for (int m = 0; m < 4; ++m) rsv[ai][m] = P[ai * HALF + wr * 64 + 4 * fr + m];
#pragma unroll
        for (int ai = 0; ai < 2; ++ai) { const int T = u.pm * 4 + ai * 2 + wr;
            unsigned char* img = Vt8 + ((size_t)T * 20 + u.pn) * 10240 + (fr & 1) * 32 + (fr >> 3) * 16 + ((fr >> 1) & 3) * 4;
#pragma unroll
            for (int n = 0; n < 2; ++n) { f32x4 vv[4];
#pragma unroll
                for (int m = 0; m < 4; ++m) vv[m] = __builtin_convertvector(__builtin_bit_cast(i32x4_, accr[ai][1][m][n]), f32x4) * (cs[1][n] * (rsv[ai][m] * 32.f));
#pragma unroll
                for (int j = 0; j < 4; ++j) { int t = 0; t = cvt_pk_fp8_sat(vv[0][j], vv[1][j], t, false); t = cvt_pk_fp8_sat(vv[2][j], vv[3][j], t, true);
                    *(unsigned*)(img + (col0 + 4 * n + j) * 80) = (unsigned)t; } } }
        f32x4 kf[2][4][2]; float ssq[2][4];
#pragma unroll
        for (int ai = 0; ai < 2; ++ai)
#pragma unroll
            for (int m = 0; m < 4; ++m) { float s_ = 0.f;
#pragma unroll
                for (int n = 0; n < 2; ++n) { const f32x4 k4 = __builtin_convertvector(__builtin_bit_cast(i32x4_, accr[ai][0][m][n]), f32x4) * (cs[0][n] * rsv[ai][m]); kf[ai][m][n] = k4;
                    s_ += (k4[0] * k4[0] + k4[1] * k4[1]) + (k4[2] * k4[2] + k4[3] * k4[3]); }
                s_ += __shfl_xor(s_, 16); s_ += __shfl_xor(s_, 32); ssq[ai][m] = s_; }
        if (fq == 0) {
#pragma unroll
            for (int ai = 0; ai < 2; ++ai)
#pragma unroll
                for (int m = 0; m < 4; ++m) part[((wr * 2 + ai) * 64 + 4 * fr + m) * 4 + wc] = ssq[ai][m]; }
        u32x2k kw[2][4];
#pragma unroll
        for (int ai = 0; ai < 2; ++ai)
#pragma unroll
            for (int m = 0; m < 4; ++m) kw[ai][m] = *(const u32x2k*)(kper + (size_t)(u.pm * BM + ai * HALF + wr * 64 + 4 * fr + m) * 64 + wc * 16 + fq * 4);
        asm volatile("s_waitcnt lgkmcnt(0)" ::: "memory"); __builtin_amdgcn_s_barrier(); asm volatile("" ::: "memory");
        const f32x4 g0 = *(const PG8_LAS f32x4*)(P + 768 + col0), g1 = *(const PG8_LAS f32x4*)(P + 768 + col0 + 4);
#pragma unroll
        for (int ai = 0; ai < 2; ++ai)
#pragma unroll
            for (int m = 0; m < 4; ++m) { const size_t row = (size_t)(u.pm * BM + ai * HALF + wr * 64 + 4 * fr + m);
                const f32x4 pp = *(const PG8_LAS f32x4*)(part + ((wr * 2 + ai) * 64 + 4 * fr + m) * 4);
                const float ss = ((pp[0] + pp[1]) + (pp[2] + pp[3])) + P[512 + ai * HALF + wr * 64 + 4 * fr + m]; const float r = ks8 / sqrtf(ss * (1.0f / 192.0f) + 1e-6f);
                unsigned char* kd = K8 + (row * 16 + u.pn) * 192;
                const f32x4 v0 = kf[ai][m][0] * (g0 * r), v1 = kf[ai][m][1] * (g1 * r); int t0 = 0, t1 = 0;
                t0 = cvt_pk_fp8_sat(v0[0], v0[1], t0, false); t0 = cvt_pk_fp8_sat(v0[2], v0[3], t0, true); t1 = cvt_pk_fp8_sat(v1[0], v1[1], t1, false); t1 = cvt_pk_fp8_sat(v1[2], v1[3], t1, true);
                *(u32x2k*)(kd + col0) = (u32x2k){(unsigned)t0, (unsigned)t1};
                const u32x2k w = kw[ai][m]; int t2 = 0;
                t2 = cvt_pk_fp8_sat(__uint_as_float(w.x << 16) * r, __uint_as_float(w.x & 0xffff0000u) * r, t2, false); t2 = cvt_pk_fp8_sat(__uint_as_float(w.y << 16) * r, __uint_as_float(w.y & 0xffff0000u) * r, t2, true);
                *(unsigned*)(kd + 128 + wc * 16 + fq * 4) = (unsigned)t2; }
    }
};
template <bool F8, bool BB, bool OB, int NT8_ = 0> struct EpiResT {
    static constexpr bool PERM = true, AFTER_DRAIN = false, PERMA = false, FP8 = F8; static constexpr int NT8 = NT8_; static constexpr bool I8 = false;
    __device__ __forceinline__ float mix_rescale() const { return mixrs; }
    const void* base_p; const void* base_s; void* out; const float* gate; float gscale; float mixrs;
    __device__ __forceinline__ void operator()(const f32x4 (&acc)[2][2][4][2], const Unit& u, int wr, int wc, int fr, int fq) const {
        const int mr = u.pm < 16 ? 8 : ((u.pm - 16) >> 4);
        const int col0 = u.pn * BM + wc * 32 + 8 * fq;
        const float* gp = gate + (size_t)mr * 24576 + col0;
        f32x4 gv[2][2];
#pragma unroll
        for (int bj = 0; bj < 2; ++bj)
#pragma unroll
            for (int n = 0; n < 2; ++n) gv[bj][n] = *(const f32x4*)(gp + bj * HALF + n * 4) * gscale;
        const int rt = u.pm * BM + wr * 64 + fr;
        const size_t rb = (u.pm < 16) ? (size_t)rt : (size_t)(rt - 4096);
        const char* bb = (const char*)((u.pm < 16) ? base_p : base_s) + rb * 4096 * (BB ? 2 : 4);
        char* ob = (char*)out + (size_t)rt * 4096 * (OB ? 2 : 4);
#pragma unroll
        for (int ai = 0; ai < 2; ++ai)
#pragma unroll
            for (int m = 0; m < 4; ++m) { const size_t off = (size_t)(ai * HALF + m * 16) * 4096 + col0;
#pragma unroll
                for (int bj = 0; bj < 2; ++bj) { f32x4 b0, b1;
                    if constexpr (BB) { const u32x4 w = *(const u32x4*)(bb + (off + bj * HALF) * 2);
                        b0 = (f32x4){__uint_as_float(w.x << 16), __uint_as_float(w.x & 0xffff0000u), __uint_as_float(w.y << 16), __uint_as_float(w.y & 0xffff0000u)};
                        b1 = (f32x4){__uint_as_float(w.z << 16), __uint_as_float(w.z & 0xffff0000u), __uint_as_float(w.w << 16), __uint_as_float(w.w & 0xffff0000u)}; }
                    else { b0 = *(const f32x4*)(bb + (off + bj * HALF) * 4); b1 = *(const f32x4*)(bb + (off + bj * HALF) * 4 + 16); }
                    const f32x4 o0 = b0 + gv[bj][0] * acc[ai][bj][m][0], o1 = b1 + gv[bj][1] * acc[ai][bj][m][1];
                    if constexpr (OB) { u32x4 w; w.x = cvt_pk_bf16(o0[0], o0[1]); w.y = cvt_pk_bf16(o0[2], o0[3]); w.z = cvt_pk_bf16(o1[0], o1[1]); w.w = cvt_pk_bf16(o1[2], o1[3]); *(u32x4*)(ob + (off + bj * HALF) * 2) = w; }
                    else { *(f32x4*)(ob + (off + bj * HALF) * 4) = o0; *(f32x4*)(ob + (off + bj * HALF) * 4 + 16) = o1; } }
                asm volatile("" ::: "memory"); }
    }
};
__device__ __forceinline__ float dpp_from_prev_lane(float v) { return __builtin_bit_cast(float, __builtin_amdgcn_update_dpp(0, __builtin_bit_cast(int, v), 0x111, 0xf, 0xf, true)); }
__device__ __forceinline__ float dpp_from_next_lane(float v) { return __builtin_bit_cast(float, __builtin_amdgcn_update_dpp(0, __builtin_bit_cast(int, v), 0x101, 0xf, 0xf, true)); }
#ifndef PROBE_UPF8
#define PROBE_UPF8 false
#endif
template <bool I8_, bool FOLD = false> struct EpiUpT {
    static constexpr bool PERM = true, AFTER_DRAIN = false, PERMA = true, FP8 = PROBE_UPF8; static constexpr int NT8 = 0; static constexpr bool I8 = I8_;
    static constexpr bool PREFETCH = true;
    PG8_LAS float* prm;
    __device__ __forceinline__ void prefetch(const Unit& u, int wid, int lane) const {
        if (wid < (I8 ? 6 : 4)) { const int ci = (lane < 32) ? u.pn * 128 + lane * 4 : 11008 + u.pn * 128 + (lane - 32) * 4;
            const float* src = wid < 3 ? cw + wid * 22016 + ci : (wid == 3 ? cb + ci : (wid == 4 ? colscale + u.pn * 256 + lane * 4 : rowscale + u.pm * BM + lane * 4));
            __builtin_amdgcn_global_load_lds((const unsigned*)src, (PG8_LAS unsigned*)(prm + u.slot * 1536 + wid * 256), 16, 0, 0); }
    }
    unsigned char* G; const float* cw; const float* cb; float* edge; int k8; int gpb; float sg; const float* rowscale; const float* colscale;
    __device__ __forceinline__ void operator()(const f32x4 (&acc)[2][2][4][2], const Unit& u, int wr, int wc, int fr, int fq) const {
        const int colg = u.pn * 128 + wc * 32 + 8 * fq;
        const bool g8 = u.pn * 128 < k8;
        unsigned gw[2][4][4]; int gw8[2][4][2];
        f32x4 rs4[2] = {(f32x4){1.f, 1.f, 1.f, 1.f}, (f32x4){1.f, 1.f, 1.f, 1.f}};
        const PG8_LAS float* P = prm + u.slot * 1536;
        if constexpr (I8) { rs4[0] = *(const PG8_LAS f32x4*)(P + 1280 + wr * 64 + 4 * fr); rs4[1] = *(const PG8_LAS f32x4*)(P + 1280 + HALF + wr * 64 + 4 * fr); }
#pragma unroll
        for (int n = 0; n < 2; ++n) {
            f32x4 W0[2], W1[2], W2[2], Bv[2], cs4[2];
#pragma unroll
            for (int bj = 0; bj < 2; ++bj) { const int uc = bj * 11008 + colg + 4 * n;
                const int pe = bj * 128 + wc * 32 + 8 * fq + 4 * n;
                W0[bj] = *(const PG8_LAS f32x4*)(P + pe); W1[bj] = *(const PG8_LAS f32x4*)(P + 256 + pe); W2[bj] = *(const PG8_LAS f32x4*)(P + 512 + pe); Bv[bj] = *(const PG8_LAS f32x4*)(P + 768 + pe);
                cs4[bj] = (f32x4){1.f, 1.f, 1.f, 1.f};
                if constexpr (I8) { cs4[bj] = *(const PG8_LAS f32x4*)(P + 1024 + pe); W0[bj] *= cs4[bj]; W1[bj] *= cs4[bj]; W2[bj] *= cs4[bj]; } }
#pragma unroll
            for (int ai = 0; ai < 2; ++ai) {
                const int rho = u.pm * 4 + ai * 2 + wr;
                float* e0 = edge + ((size_t)rho * 4 + 0) * 22016;
                f32x4 Pf[2], Pl[2], Uf[2], Ul[2];
                f32x4 uv[2][4];
#pragma unroll
                for (int bj = 0; bj < 2; ++bj)
#pragma unroll
                    for (int m = 0; m < 4; ++m) {
                        if constexpr (I8) { typedef int i32x4_ __attribute__((ext_vector_type(4))); uv[bj][m] = __builtin_convertvector(__builtin_bit_cast(i32x4_, acc[ai][bj][m][n]), f32x4) * rs4[ai][m]; }
                        else uv[bj][m] = acc[ai][bj][m][n] * (FP8 ? (1.0f / 4096.0f) : 1.0f); }
                f32x4 Cc[2][4];
#pragma unroll
                for (int bj = 0; bj < 2; ++bj) {
                    const f32x4 U0 = uv[bj][0], U1 = uv[bj][1], U2 = uv[bj][2], U3 = uv[bj][3];
                    f32x4 pv, nx;
#pragma unroll
                    for (int j = 0; j < 4; ++j) { pv[j] = dpp_from_prev_lane(U3[j]); nx[j] = dpp_from_next_lane(U0[j]); }
                    Uf[bj] = U0; Ul[bj] = U3;
                    Cc[bj][0] = W1[bj] * U0 + (W0[bj] * pv + (W2[bj] * U1 + Bv[bj]));
                    Cc[bj][1] = W1[bj] * U1 + (W0[bj] * U0 + (W2[bj] * U2 + Bv[bj]));
                    Cc[bj][2] = W1[bj] * U2 + (W0[bj] * U1 + (W2[bj] * U3 + Bv[bj]));
                    Cc[bj][3] = W1[bj] * U3 + (W0[bj] * U2 + (W2[bj] * nx + Bv[bj]));
                    Pf[bj] = Cc[bj][0]; Pl[bj] = Cc[bj][3];
                }
#pragma unroll
                for (int m = 0; m < 4; ++m) { const f32x4 av = Cc[0][m], bv = Cc[1][m]; const f32x4 ea = FOLD ? av : av * (-1.4426950408889634f); f32x4 sv;
#pragma unroll
                    for (int j = 0; j < 4; ++j) sv[j] = __builtin_amdgcn_rcpf(1.0f + __builtin_amdgcn_exp2f(ea[j]));
                    const f32x4 gv4 = (av * sv) * bv;
                    if (g8) { const f32x4 gs = FOLD ? gv4 : gv4 * sg; int t = 0; t = cvt_pk_fp8_sat(gs[0], gs[1], t, false); t = cvt_pk_fp8_sat(gs[2], gs[3], t, true); gw8[ai][m][n] = t; }
                    else { gw[ai][m][n * 2] = cvt_pk_bf16(gv4[0], gv4[1]); gw[ai][m][n * 2 + 1] = cvt_pk_bf16(gv4[2], gv4[3]); } }
                if (fr == 0) {
#pragma unroll
                    for (int bj = 0; bj < 2; ++bj) { const int uc = bj * 11008 + colg + 4 * n; *(f32x4*)(e0 + uc) = Pf[bj]; *(f32x4*)(e0 + 22016 + uc) = Uf[bj] * cs4[bj]; } }
                if (fr == 15) {
#pragma unroll
                    for (int bj = 0; bj < 2; ++bj) { const int uc = bj * 11008 + colg + 4 * n; *(f32x4*)(e0 + 2 * 22016 + uc) = Pl[bj]; *(f32x4*)(e0 + 3 * 22016 + uc) = Ul[bj] * cs4[bj]; } }
            }
        }
#pragma unroll
        for (int ai = 0; ai < 2; ++ai) {
            const int row0 = u.pm * BM + ai * HALF + wr * 64 + 4 * fr;
#pragma unroll
            for (int m = 0; m < 4; ++m) { unsigned char* grow = G + (size_t)(row0 + m) * gpb;
                if (g8) { typedef unsigned u32x2 __attribute__((ext_vector_type(2))); *(u32x2*)(grow + colg) = (u32x2){(unsigned)gw8[ai][m][0], (unsigned)gw8[ai][m][1]}; }
                else { u32x4 w; w.x = gw[ai][m][0]; w.y = gw[ai][m][1]; w.z = gw[ai][m][2]; w.w = gw[ai][m][3]; *(u32x4*)(grow + k8 + (size_t)(colg - k8) * 2) = w; } }
        }
    }
};

typedef int pg8_v8i __attribute__((ext_vector_type(8)));
__device__ __forceinline__ pg8_v8i pg8_cat(bf16x8 a, bf16x8 b) { typedef short s16 __attribute__((ext_vector_type(16))); const s16 c = __builtin_shufflevector(a, b, 0, 1, 2, 3, 4, 5, 6, 7, 8, 9, 10, 11, 12, 13, 14, 15); return __builtin_bit_cast(pg8_v8i, c); }
__device__ __forceinline__ bf16x8 pg8_lo(pg8_v8i v) { typedef int v4i_ __attribute__((ext_vector_type(4))); return __builtin_bit_cast(bf16x8, (v4i_)__builtin_shufflevector(v, v, 0, 1, 2, 3)); }
__device__ __forceinline__ bf16x8 pg8_hi(pg8_v8i v) { typedef int v4i_ __attribute__((ext_vector_type(4))); return __builtin_bit_cast(bf16x8, (v4i_)__builtin_shufflevector(v, v, 4, 5, 6, 7)); }
template <class T, class = void> struct pg8_has_prefetch { static constexpr bool value = false; };
template <class T> struct pg8_has_prefetch<T, decltype((void)T::PREFETCH)> { static constexpr bool value = true; };
template <class Epi> __device__ __forceinline__ void pg8_prefetch(const Epi& E, const Unit& u, int wid, int lane) { if constexpr (pg8_has_prefetch<Epi>::value) E.prefetch(u, wid, lane); }
template <class Epi, class Sched, bool ALIGN_EPI = false, bool SP2 = false>
__device__ __forceinline__ void gemm_phase(PG8_LAS unsigned char* lds, const Gemm g, const Sched& S, const Epi& E) {
    const int tid = threadIdx.x, wid = __builtin_amdgcn_readfirstlane(tid >> 6), lane = tid & 63, wr = wid >> 2, wc = wid & 3, fr = lane & 15, fq = lane >> 4;
    const int K = g.K, nt = K / BK;
    unsigned voffA[2], voffB[2];
#pragma unroll
    for (int i = 0; i < 2; ++i) { int R, C; stage_rc(tid * 16 + i * 8192, R, C); const int Rb = Epi::PERM ? ((R & ~31) + perm32(R & 31)) : R;
        const int Ra = Epi::PERMA ? ((R & ~63) | ((R & 15) << 2) | ((R >> 4) & 3)) : R;
        voffA[i] = (unsigned)(Ra * K + C) * 2u; voffB[i] = (unsigned)(Rb * K + C) * 2u; }
    const size_t kstep = (size_t)(BK * 2);
    const size_t hstep = (size_t)HALF * K * 2;
    const size_t tstep = 2 * hstep;
    const unsigned ldsw = (unsigned)wid * 1024u;
    const int aoff = lds_byte(wr * 64 + fr, fq * 8), boff = lds_byte(wc * 32 + fr, fq * 8);
#define PG8_SA(b, h) (((b) * 2 + (h)) * HTB)
#define PG8_SB(b, h) ((4 + (b) * 2 + (h)) * HTB)
#define PG8_STAGE(bufoff, gbase, voff) do { _Pragma("unroll") for (int _i = 0; _i < 2; ++_i) \
        __builtin_amdgcn_global_load_lds((const unsigned*)((const char*)(gbase) + (voff)[_i]), (PG8_LAS unsigned*)(lds + (bufoff) + ldsw + _i * 8192), 16, 0, 0); } while (0)
#define PG8_LDA(dst, b, h) do { if constexpr (Epi::FP8 || Epi::NT8 > 0) { _Pragma("unroll") for (int m = 0; m < 4; ++m) dst##8[m] = pg8_cat(*(const PG8_LAS bf16x8*)(lds + PG8_SA(b, h) + aoff + m * 2048), *(const PG8_LAS bf16x8*)(lds + PG8_SA(b, h) + aoff + m * 2048 + 1024)); } \
        else { _Pragma("unroll") for (int m = 0; m < 4; ++m) _Pragma("unroll") for (int k = 0; k < 2; ++k) dst[m][k] = *(const PG8_LAS bf16x8*)(lds + PG8_SA(b, h) + aoff + m * 2048 + k * 1024); } } while (0)
#define PG8_LDB(dst, b, h) do { if constexpr (Epi::FP8 || Epi::NT8 > 0) { _Pragma("unroll") for (int n = 0; n < 2; ++n) dst##8[n] = pg8_cat(*(const PG8_LAS bf16x8*)(lds + PG8_SB(b, h) + boff + n * 2048), *(const PG8_LAS bf16x8*)(lds + PG8_SB(b, h) + boff + n * 2048 + 1024)); } \
        else { _Pragma("unroll") for (int n = 0; n < 2; ++n) _Pragma("unroll") for (int k = 0; k < 2; ++k) dst[n][k] = *(const PG8_LAS bf16x8*)(lds + PG8_SB(b, h) + boff + n * 2048 + k * 1024); } } while (0)
#define PG8_MMA8(ai, bj, At, Bt) do { _Pragma("unroll") for (int m = 0; m < 4; ++m) _Pragma("unroll") for (int n = 0; n < 2; ++n) \
        asm volatile("v_mfma_f32_16x16x128_f8f6f4 %0, %1, %2, %0" : "+v"(acc[ai][bj][m][n]) : "v"(Bt##8[n]), "v"(At##8[m])); } while (0)
#ifndef PG8_PRIO
#define PG8_PRIO 1
#endif
#ifndef PG8_PRIO_MMA
#define PG8_PRIO_MMA 1
#endif
#ifndef PG8_PRIO_AFTER
#define PG8_PRIO_AFTER 3
#endif
#define PG8_MMA(ai, bj, At, Bt) do { if (PG8_PRIO) __builtin_amdgcn_s_setprio(PG8_PRIO_MMA); if constexpr (Epi::FP8) { PG8_MMA8(ai, bj, At, Bt); } \
        else if constexpr (Epi::NT8 > 0) { if constexpr (f8now) { PG8_MMA8(ai, bj, At, Bt); } else { _Pragma("unroll") for (int m = 0; m < 4; ++m) _Pragma("unroll") for (int n = 0; n < 2; ++n) { \
            asm volatile("v_mfma_f32_16x16x32_bf16 %0, %1, %2, %0" : "+v"(acc[ai][bj][m][n]) : "v"(pg8_lo(Bt##8[n])), "v"(pg8_lo(At##8[m]))); \
            asm volatile("v_mfma_f32_16x16x32_bf16 %0, %1, %2, %0" : "+v"(acc[ai][bj][m][n]) : "v"(pg8_hi(Bt##8[n])), "v"(pg8_hi(At##8[m]))); } } } \
        else if constexpr (Epi::I8) { _Pragma("unroll") for (int m = 0; m < 4; ++m) _Pragma("unroll") for (int n = 0; n < 2; ++n) _Pragma("unroll") for (int k = 0; k < 2; ++k) \
        asm volatile("v_mfma_i32_16x16x64_i8 %0, %1, %2, %0" : "+v"(acc[ai][bj][m][n]) : "v"(Bt[n][k]), "v"(At[m][k])); } \
        else { _Pragma("unroll") for (int m = 0; m < 4; ++m) _Pragma("unroll") for (int n = 0; n < 2; ++n) _Pragma("unroll") for (int k = 0; k < 2; ++k) \
        acc[ai][bj][m][n] = __builtin_amdgcn_mfma_f32_16x16x32_bf16(Bt[n][k], At[m][k], acc[ai][bj][m][n], 0, 0, 0); } if (PG8_PRIO) __builtin_amdgcn_s_setprio(PG8_PRIO_AFTER); } while (0)
#define PG8_WAIT_V(n) asm volatile("s_waitcnt vmcnt(" #n ")" ::: "memory")
#define PG8_WAIT_L(n) asm volatile("s_waitcnt lgkmcnt(" #n ")" ::: "memory")
#define PG8_BAR __builtin_amdgcn_s_barrier()
#define PG8_SCHED __builtin_amdgcn_sched_barrier(0)
    Unit cur, nxt; int ui = 0;
    if (!S.next(0, cur)) return;
    cur.slot = 0; pg8_prefetch(E, cur, wid, lane);
    f32x4 acc[2][2][4][2];
#pragma unroll
    for (int a = 0; a < 2; ++a)
#pragma unroll
        for (int b = 0; b < 2; ++b)
#pragma unroll
            for (int m = 0; m < 4; ++m)
#pragma unroll
                for (int n = 0; n < 2; ++n) acc[a][b][m][n] = (f32x4){0.f, 0.f, 0.f, 0.f};
    bf16x8 At[4][2], B0[2][2], B1[2][2]; pg8_v8i At8[4], B08[2], B18[2];
    const char* cA = (const char*)g.A + (size_t)cur.pm * tstep; const char* cB = (const char*)g.Bt + (size_t)cur.pn * tstep;
    S.a_ready(cur);
    if constexpr (SP2) {
        PG8_STAGE(PG8_SB(0, 0), cB, voffB); PG8_STAGE(PG8_SB(0, 1), cB + hstep, voffB); PG8_STAGE(PG8_SA(0, 0), cA, voffA); PG8_STAGE(PG8_SA(0, 1), cA + hstep, voffA);
        if (wr == 1) PG8_BAR;
        PG8_WAIT_V(2); PG8_BAR;
        PG8_STAGE(PG8_SB(1, 0), cB + kstep, voffB); PG8_STAGE(PG8_SA(1, 0), cA + kstep, voffA); PG8_STAGE(PG8_SB(1, 1), cB + hstep + kstep, voffB);
        PG8_WAIT_V(6); PG8_BAR;
    } else {
        PG8_STAGE(PG8_SB(0, 0), cB, voffB); PG8_STAGE(PG8_SA(0, 0), cA, voffA); PG8_STAGE(PG8_SB(0, 1), cB + hstep, voffB); PG8_STAGE(PG8_SA(0, 1), cA + hstep, voffA);
        if (wr == 1) PG8_BAR;
        PG8_WAIT_V(4); PG8_BAR;
        PG8_STAGE(PG8_SB(1, 0), cB + kstep, voffB); PG8_STAGE(PG8_SA(1, 0), cA + kstep, voffA); PG8_STAGE(PG8_SB(1, 1), cB + hstep + kstep, voffB);
        PG8_WAIT_V(6); PG8_BAR;
    }
    for (;;) {
        const bool has_next = S.next(ui + 1, nxt);
        const char* nA = has_next ? (const char*)g.A + (size_t)nxt.pm * tstep : cA; const char* nB = has_next ? (const char*)g.Bt + (size_t)nxt.pn * tstep : cB;
        for (int t = 0; t < (Epi::NT8 > 0 ? Epi::NT8 : 0); t += 2) {
            const bool last = (t == nt - 2);
            constexpr bool f8now = true; (void)f8now;
            const char* a1 = cA + (size_t)(t + 1) * kstep;
            const char* a2 = last ? nA : cA + (size_t)(t + 2) * kstep; const char* b2 = last ? nB : cB + (size_t)(t + 2) * kstep;
            const char* a3 = a2 + kstep; const char* b3 = b2 + kstep;
            if (last && has_next) S.a_ready(nxt);
            if constexpr (SP2) {
            PG8_LDB(B0, 0, 0); PG8_LDB(B1, 0, 1); PG8_SCHED; PG8_LDA(At, 0, 0); PG8_STAGE(PG8_SA(1, 1), a1 + hstep, voffA);
            PG8_WAIT_V(8); PG8_WAIT_L(0); PG8_BAR; PG8_MMA(0, 0, At, B0); PG8_MMA(0, 1, At, B1); PG8_BAR; PG8_SCHED;
            PG8_LDA(At, 0, 1); PG8_STAGE(PG8_SB(0, 0), b2, voffB); PG8_STAGE(PG8_SB(0, 1), b2 + hstep, voffB); PG8_STAGE(PG8_SA(0, 0), a2, voffA);
            PG8_WAIT_V(8); PG8_WAIT_L(0); PG8_BAR; PG8_MMA(1, 0, At, B0); PG8_MMA(1, 1, At, B1); PG8_BAR; PG8_SCHED;
            PG8_LDB(B0, 1, 0); PG8_LDB(B1, 1, 1); PG8_SCHED; PG8_LDA(At, 1, 0); PG8_STAGE(PG8_SA(0, 1), a2 + hstep, voffA);
            PG8_WAIT_V(8); PG8_WAIT_L(0); PG8_BAR; PG8_MMA(0, 0, At, B0); PG8_MMA(0, 1, At, B1); PG8_BAR; PG8_SCHED;
            PG8_LDA(At, 1, 1); PG8_STAGE(PG8_SB(1, 0), b3, voffB); PG8_STAGE(PG8_SB(1, 1), b3 + hstep, voffB); PG8_STAGE(PG8_SA(1, 0), a3, voffA);
            PG8_WAIT_V(8); PG8_WAIT_L(0); PG8_BAR; PG8_MMA(1, 0, At, B0); PG8_MMA(1, 1, At, B1); PG8_BAR; PG8_SCHED;
            } else {
            PG8_LDB(B0, 0, 0); PG8_SCHED; PG8_LDA(At, 0, 0); PG8_STAGE(PG8_SA(1, 1), a1 + hstep, voffA);
            PG8_WAIT_L(8); PG8_BAR; PG8_WAIT_L(0); PG8_MMA(0, 0, At, B0); PG8_BAR; PG8_SCHED;
            PG8_LDB(B1, 0, 1); PG8_STAGE(PG8_SB(0, 0), b2, voffB);
            PG8_BAR; PG8_WAIT_L(0); PG8_MMA(0, 1, At, B1); PG8_BAR;
            PG8_LDA(At, 0, 1); PG8_STAGE(PG8_SA(0, 0), a2, voffA);
            PG8_BAR; PG8_WAIT_L(0); PG8_MMA(1, 0, At, B0); PG8_BAR; PG8_SCHED;
            PG8_STAGE(PG8_SB(0, 1), b2 + hstep, voffB);
            PG8_WAIT_V(6); PG8_BAR; PG8_MMA(1, 1, At, B1); PG8_BAR;
            PG8_LDB(B0, 1, 0); PG8_SCHED; PG8_LDA(At, 1, 0); PG8_STAGE(PG8_SA(0, 1), a2 + hstep, voffA);
            PG8_WAIT_L(8); PG8_BAR; PG8_WAIT_L(0); PG8_MMA(0, 0, At, B0); PG8_BAR; PG8_SCHED;
            PG8_LDB(B1, 1, 1); PG8_STAGE(PG8_SB(1, 0), b3, voffB);
            PG8_BAR; PG8_WAIT_L(0); PG8_MMA(0, 1, At, B1); PG8_BAR;
            PG8_LDA(At, 1, 1); PG8_STAGE(PG8_SA(1, 0), a3, voffA);
            PG8_BAR; PG8_WAIT_L(0); PG8_MMA(1, 0, At, B0); PG8_BAR; PG8_SCHED;
            PG8_STAGE(PG8_SB(1, 1), b3 + hstep, voffB);
            PG8_WAIT_V(6); PG8_BAR; PG8_MMA(1, 1, At, B1); PG8_BAR;
            }
        }
        if constexpr (Epi::NT8 > 0) { const float rs_ = E.mix_rescale();
#pragma unroll
            for (int a_ = 0; a_ < 2; ++a_)
#pragma unroll
                for (int b_ = 0; b_ < 2; ++b_)
#pragma unroll
                    for (int m_ = 0; m_ < 4; ++m_)
#pragma unroll
                        for (int n_ = 0; n_ < 2; ++n_) acc[a_][b_][m_][n_] *= rs_; }
        for (int t = (Epi::NT8 > 0 ? Epi::NT8 : 0); t < nt; t += 2) {
            const bool last = (t == nt - 2);
            constexpr bool f8now = false; (void)f8now;
            const char* a1 = cA + (size_t)(t + 1) * kstep;
            const char* a2 = last ? nA : cA + (size_t)(t + 2) * kstep; const char* b2 = last ? nB : cB + (size_t)(t + 2) * kstep;
            const char* a3 = a2 + kstep; const char* b3 = b2 + kstep;
            if (last && has_next) S.a_ready(nxt);
            if constexpr (SP2) {
            PG8_LDB(B0, 0, 0); PG8_LDB(B1, 0, 1); PG8_SCHED; PG8_LDA(At, 0, 0); PG8_STAGE(PG8_SA(1, 1), a1 + hstep, voffA);
            PG8_WAIT_V(8); PG8_WAIT_L(0); PG8_BAR; PG8_MMA(0, 0, At, B0); PG8_MMA(0, 1, At, B1); PG8_BAR; PG8_SCHED;
            PG8_LDA(At, 0, 1); PG8_STAGE(PG8_SB(0, 0), b2, voffB); PG8_STAGE(PG8_SB(0, 1), b2 + hstep, voffB); PG8_STAGE(PG8_SA(0, 0), a2, voffA);
            PG8_WAIT_V(8); PG8_WAIT_L(0); PG8_BAR; PG8_MMA(1, 0, At, B0); PG8_MMA(1, 1, At, B1); PG8_BAR; PG8_SCHED;
            PG8_LDB(B0, 1, 0); PG8_LDB(B1, 1, 1); PG8_SCHED; PG8_LDA(At, 1, 0); PG8_STAGE(PG8_SA(0, 1), a2 + hstep, voffA);
            PG8_WAIT_V(8); PG8_WAIT_L(0); PG8_BAR; PG8_MMA(0, 0, At, B0); PG8_MMA(0, 1, At, B1); PG8_BAR; PG8_SCHED;
            PG8_LDA(At, 1, 1); PG8_STAGE(PG8_SB(1, 0), b3, voffB); PG8_STAGE(PG8_SB(1, 1), b3 + hstep, voffB); PG8_STAGE(PG8_SA(1, 0), a3, voffA);
            PG8_WAIT_V(8); PG8_WAIT_L(0); PG8_BAR; PG8_MMA(1, 0, At, B0); PG8_MMA(1, 1, At, B1); PG8_BAR; PG8_SCHED;
            } else {
            PG8_LDB(B0, 0, 0); PG8_SCHED; PG8_LDA(At, 0, 0); PG8_STAGE(PG8_SA(1, 1), a1 + hstep, voffA);
            PG8_WAIT_L(8); PG8_BAR; PG8_WAIT_L(0); PG8_MMA(0, 0, At, B0); PG8_BAR; PG8_SCHED;
            PG8_LDB(B1, 0, 1); PG8_STAGE(PG8_SB(0, 0), b2, voffB);
            PG8_BAR; PG8_WAIT_L(0); PG8_MMA(0, 1, At, B1); PG8_BAR;
            PG8_LDA(At, 0, 1); PG8_STAGE(PG8_SA(0, 0), a2, voffA);
            PG8_BAR; PG8_WAIT_L(0); PG8_MMA(1, 0, At, B0); PG8_BAR; PG8_SCHED;
            PG8_STAGE(PG8_SB(0, 1), b2 + hstep, voffB);
            PG8_WAIT_V(6); PG8_BAR; PG8_MMA(1, 1, At, B1); PG8_BAR;
            PG8_LDB(B0, 1, 0); PG8_SCHED; PG8_LDA(At, 1, 0); PG8_STAGE(PG8_SA(0, 1), a2 + hstep, voffA);
            PG8_WAIT_L(8); PG8_BAR; PG8_WAIT_L(0); PG8_MMA(0, 0, At, B0); PG8_BAR; PG8_SCHED;
            PG8_LDB(B1, 1, 1); PG8_STAGE(PG8_SB(1, 0), b3, voffB);
            PG8_BAR; PG8_WAIT_L(0); PG8_MMA(0, 1, At, B1); PG8_BAR;
            PG8_LDA(At, 1, 1); PG8_STAGE(PG8_SA(1, 0), a3, voffA);
            PG8_BAR; PG8_WAIT_L(0); PG8_MMA(1, 0, At, B0); PG8_BAR; PG8_SCHED;
            PG8_STAGE(PG8_SB(1, 1), b3 + hstep, voffB);
            PG8_WAIT_V(6); PG8_BAR; PG8_MMA(1, 1, At, B1); PG8_BAR;
            }
        }
        if constexpr (ALIGN_EPI) { if (wr == 0) PG8_BAR; }
#ifdef PROBE_EPI2
        if constexpr (!Epi::AFTER_DRAIN) { if constexpr (Epi::I8) {
                int reps_ = 2; asm volatile("" : "+s"(reps_));
#pragma unroll 1
                for (int rep_ = 0; rep_ < reps_; ++rep_) { asm volatile("" ::: "memory"); E(acc, cur, wr, wc, fr, fq); } }
            else E(acc, cur, wr, wc, fr, fq);
            S.done(cur); }
#else
        if constexpr (!Epi::AFTER_DRAIN) { E(acc, cur, wr, wc, fr, fq); S.done(cur); }
#endif
        if (!has_next) break;
#pragma unroll
        for (int a = 0; a < 2; ++a)
#pragma unroll
            for (int b = 0; b < 2; ++b)
#pragma unroll
                for (int m = 0; m < 4; ++m)
#pragma unroll
                    for (int n = 0; n < 2; ++n) acc[a][b][m][n] = (f32x4){0.f, 0.f, 0.f, 0.f};
        cur = nxt; cA = nA; cB = nB; ++ui; cur.slot = ui & 1; pg8_prefetch(E, cur, wid, lane);
        if constexpr (ALIGN_EPI) { if (wr == 1) PG8_BAR; }
    }
    PG8_WAIT_V(0);
    if constexpr (!ALIGN_EPI) { if (wr == 0) PG8_BAR; }
    PG8_BAR;
    if (PG8_PRIO) __builtin_amdgcn_s_setprio(0);
    if constexpr (Epi::AFTER_DRAIN) { E.fused(acc, cur, wr, wc, fr, fq, lds, wid, lane); S.done(cur); }
#undef PG8_SA
#undef PG8_SB
#undef PG8_STAGE
#undef PG8_LDA
#undef PG8_LDB
#undef PG8_MMA
#undef PG8_WAIT_V
#undef PG8_WAIT_L
#undef PG8_BAR
#undef PG8_SCHED
}
}
#define ATT_LAS __attribute__((address_space(3)))
namespace att {
typedef unsigned short bf16;
using bf16x8 = __attribute__((ext_vector_type(8))) short;
using s16x4  = __attribute__((ext_vector_type(4))) short;
using f32x16 = __attribute__((ext_vector_type(16))) float;
using f32x4  = __attribute__((ext_vector_type(4))) float;
using u32x4  = __attribute__((ext_vector_type(4))) unsigned;
constexpr int NW = 8, QBLK = 32, KVBLK = 64;
constexpr float THR = 8.f;
#ifndef ATT_SRCC
#define ATT_SRCC 1
#endif
#define ATT_KS8 (ATT_SRCC ? 0.5f : 16.0f)
constexpr int SHM_V = KVBLK * 128 * 2;
constexpr int SHM_KMAX = KVBLK * (192 * 2 + 16);
constexpr int OFF_K = 3 * SHM_V, OFF_WS = OFF_K + 2 * SHM_KMAX, ATT_LDS = OFF_WS + NW * 64 * 4;
constexpr int OPITCH = 272;
static_assert(NW * 32 * OPITCH <= OFF_WS, "output staging fits under the K/V buffers");
#define ATT_SBAR() __builtin_amdgcn_sched_barrier(0)
template <int DQK, bool KF8 = false> __device__ __forceinline__ constexpr int kpitch() { return DQK * (KF8 ? 1 : 2) + 16; }
template <int DQK> __device__ __forceinline__ int kswz(int row, int cb) { return row * kpitch<DQK>() + cb; }
__device__ __forceinline__ int crow(int r, int hi) { return (r & 3) + 8 * (r >> 2) + 4 * hi; }
__device__ __forceinline__ unsigned cvtpk(float lo, float hi) { unsigned r; asm volatile("v_cvt_pk_bf16_f32 %0, %1, %2" : "=v"(r) : "v"(lo), "v"(hi)); return r; }
__device__ __forceinline__ float bf2f(unsigned short b) { return __uint_as_float(((unsigned)b) << 16); }

template <bool MASKABLE>
__device__ __forceinline__ void partialSM(f32x16& p0, f32x16& p1, float& m_reg, float& mn, float& alpha, const float C, const float thr_raw, const float pl2, const bool domask, const int mbase) {
  if (MASKABLE) { if (domask) {
#pragma unroll
    for (int r = 0; r < 16; ++r) { const int off = (r & 3) + 8 * (r >> 2);
      p0[r] = ((unsigned)(mbase + off) > 256u) ? -1e30f : p0[r]; p1[r] = ((unsigned)(mbase + 32 + off) > 256u) ? -1e30f : p1[r]; } } }
  float pmax = p0[0];
#pragma unroll
  for (int r = 1; r < 16; ++r) pmax = fmaxf(pmax, p0[r]);
#pragma unroll
  for (int r = 0; r < 16; ++r) pmax = fmaxf(pmax, p1[r]);
  { auto rr = __builtin_amdgcn_permlane32_swap(__float_as_uint(pmax), __float_as_uint(pmax), false, false);
    pmax = fmaxf(__uint_as_float(rr[0]), __uint_as_float(rr[1])); }
  if (__builtin_expect(__all(pmax - m_reg <= thr_raw), 1)) { mn = m_reg; alpha = 1.f; }
  else { mn = fmaxf(m_reg, pmax); alpha = __builtin_amdgcn_exp2f((m_reg - mn) * C); m_reg = mn; }
  const float mnC = pl2 - mn * C;
#pragma unroll
  for (int r = 0; r < 16; ++r) p0[r] = fmaf(p0[r], C, mnC);
#pragma unroll
  for (int r = 0; r < 16; ++r) p1[r] = fmaf(p1[r], C, mnC);
#pragma unroll
  for (int r = 0; r < 16; ++r) p0[r] = __builtin_amdgcn_exp2f(p0[r]);
}
template <bool MASKABLE, bool FIRST>
__device__ __forceinline__ void partialSM2(f32x16& p0, f32x16& p1, float& m_reg, float& alpha, const float thr_l2, const float pl2, const bool domask, const int mbase) {
  if (MASKABLE) { if (domask) {
#pragma unroll
    for (int r = 0; r < 16; ++r) { const int off = (r & 3) + 8 * (r >> 2);
      p0[r] = ((unsigned)(mbase + off) > 256u) ? -1e30f : p0[r]; p1[r] = ((unsigned)(mbase + 32 + off) > 256u) ? -1e30f : p1[r]; } } }
  float pmax = p0[0];
#pragma unroll
  for (int r = 1; r < 16; ++r) pmax = fmaxf(pmax, p0[r]);
#pragma unroll
  for (int r = 0; r < 16; ++r) pmax = fmaxf(pmax, p1[r]);
  { auto rr = __builtin_amdgcn_permlane32_swap(__float_as_uint(pmax), __float_as_uint(pmax), false, false);
    pmax = fmaxf(__uint_as_float(rr[0]), __uint_as_float(rr[1])); }
  const float rel = pmax - pl2;
  if (!FIRST && __builtin_expect(__all(rel <= thr_l2), 1)) { alpha = 1.f; }
  else { const float d = FIRST ? rel : fmaxf(rel, 0.f); alpha = FIRST ? 1.f : __builtin_amdgcn_exp2f(-d); m_reg += d;
#pragma unroll
    for (int r = 0; r < 16; ++r) { p0[r] -= d; p1[r] -= d; } }
#pragma unroll
  for (int r = 0; r < 16; ++r) p0[r] = __builtin_amdgcn_exp2f(p0[r]);
}
__device__ __forceinline__ void finishSM(f32x16& p0, f32x16& p1, float alpha, float& l_reg, bf16x8& pa0, bf16x8& pa1, bf16x8& pa2, bf16x8& pa3) {
#pragma unroll
  for (int r = 0; r < 16; ++r) p1[r] = __builtin_amdgcn_exp2f(p1[r]);
  float ps = 0;
#pragma unroll
  for (int r = 0; r < 16; ++r) ps += p0[r];
#pragma unroll
  for (int r = 0; r < 16; ++r) ps += p1[r];
  { auto rr = __builtin_amdgcn_permlane32_swap(__float_as_uint(ps), __float_as_uint(ps), false, false);
    ps = __uint_as_float(rr[0]) + __uint_as_float(rr[1]); }
  l_reg = l_reg * alpha + ps;
#define ATT_PK4(P, BASE, OUT) do { unsigned a0 = cvtpk(P[BASE + 0], P[BASE + 1]), a1 = cvtpk(P[BASE + 2], P[BASE + 3]);   \
    unsigned b0 = cvtpk(P[BASE + 4], P[BASE + 5]), b1 = cvtpk(P[BASE + 6], P[BASE + 7]);                              \
    auto r0 = __builtin_amdgcn_permlane32_swap(a0, b0, false, false); auto r1 = __builtin_amdgcn_permlane32_swap(a1, b1, false, false); \
    u32x4 w = {r0[0], r1[0], r0[1], r1[1]}; OUT = *reinterpret_cast<bf16x8*>(&w); } while (0)
  ATT_PK4(p0, 0, pa0); ATT_PK4(p0, 8, pa1); ATT_PK4(p1, 0, pa2); ATT_PK4(p1, 8, pa3);
#undef ATT_PK4
}
template <int DQK>
__device__ __forceinline__ void qkt(f32x16& p0, f32x16& p1, const char* Ks, const bf16x8* qr, int r32, int hi) {
  p0 = f32x16{}; p1 = f32x16{};
  const char* kb = Ks + r32 * kpitch<DQK>() + hi * 16;
#pragma unroll
  for (int d0 = 0; d0 < DQK / 16; ++d0) {
    const bf16x8 b0 = *reinterpret_cast<const bf16x8*>(kb + d0 * 32);
    const bf16x8 b1 = *reinterpret_cast<const bf16x8*>(kb + d0 * 32 + 32 * kpitch<DQK>());
    p0 = __builtin_amdgcn_mfma_f32_32x32x16_bf16(b0, qr[d0], p0, 0, 0, 0);
    p1 = __builtin_amdgcn_mfma_f32_32x32x16_bf16(b1, qr[d0], p1, 0, 0, 0);
    if ((d0 & 3) == 3) ATT_SBAR(); }
}
typedef int v8i __attribute__((ext_vector_type(8)));
template <int DQK>
__device__ __forceinline__ void qkt8(f32x16& p0, f32x16& p1, const char* Ks, const v8i* qf, int r32, int hi, const float cinit = 0.f) {
#pragma unroll
  for (int r = 0; r < 16; ++r) { p0[r] = cinit; p1[r] = cinit; }
  constexpr int KP = kpitch<DQK, true>();
  const char* kb = Ks + r32 * KP + hi * 32;
#pragma unroll
  for (int s = 0; s < DQK / 64; ++s) {
    typedef int v4i __attribute__((ext_vector_type(4)));
    const v4i a00 = *reinterpret_cast<const v4i*>(kb + s * 64), a01 = *reinterpret_cast<const v4i*>(kb + s * 64 + 16);
    const v4i a10 = *reinterpret_cast<const v4i*>(kb + s * 64 + 32 * KP), a11 = *reinterpret_cast<const v4i*>(kb + s * 64 + 32 * KP + 16);
    const v8i a0 = __builtin_shufflevector(a00, a01, 0, 1, 2, 3, 4, 5, 6, 7), a1 = __builtin_shufflevector(a10, a11, 0, 1, 2, 3, 4, 5, 6, 7);
    p0 = __builtin_amdgcn_mfma_scale_f32_32x32x64_f8f6f4(a0, qf[s], p0, 0, 0, 0, 0, 0, 0);
    p1 = __builtin_amdgcn_mfma_scale_f32_32x32x64_f8f6f4(a1, qf[s], p1, 0, 0, 0, 0, 0, 0); }
}
__device__ __forceinline__ int v_st(int k, int c) { const int kk = (k & ~0xC) | ((k & 4) << 1) | ((k & 8) >> 1); return ((kk >> 3) * 4 + (c >> 5)) * 512 + ((kk & 7) * 32 + (c & 31)) * 2; }
__device__ __forceinline__ int v_rd_base(int lane) { return ((lane & 3) << 3) | (((lane >> 2) & 3) << 6) | (((lane >> 4) & 1) << 5) | (((lane >> 5) & 1) << 8); }
constexpr int v_rd_off(int d0, int ks, int half) { return d0 * 512 + ks * 4096 + half * 2048; }
template <int OFF> __device__ __forceinline__ s16x4 tr_read(int vb) {
  s16x4 r; asm volatile("ds_read_b64_tr_b16 %0, %1 offset:%2" : "=&v"(r) : "v"(vb), "i"(OFF) : "memory"); return r;
}
template <int D0> __device__ __forceinline__ void pv_one(f32x16& od, int vb, bf16x8 pa0, bf16x8 pa1, bf16x8 pa2, bf16x8 pa3) {
  const s16x4 l0 = tr_read<v_rd_off(D0, 0, 0)>(vb), h0 = tr_read<v_rd_off(D0, 0, 1)>(vb), l1 = tr_read<v_rd_off(D0, 1, 0)>(vb), h1 = tr_read<v_rd_off(D0, 1, 1)>(vb);
  const s16x4 l2 = tr_read<v_rd_off(D0, 2, 0)>(vb), h2 = tr_read<v_rd_off(D0, 2, 1)>(vb), l3 = tr_read<v_rd_off(D0, 3, 0)>(vb), h3 = tr_read<v_rd_off(D0, 3, 1)>(vb);
  asm volatile("s_waitcnt lgkmcnt(0)" ::: "memory"); ATT_SBAR();
#define ATT_PK(L, H) (bf16x8){L[0], L[1], L[2], L[3], H[0], H[1], H[2], H[3]}
  od = __builtin_amdgcn_mfma_f32_32x32x16_bf16(pa0, ATT_PK(l0, h0), od, 0, 0, 0);
  od = __builtin_amdgcn_mfma_f32_32x32x16_bf16(pa1, ATT_PK(l1, h1), od, 0, 0, 0);
  od = __builtin_amdgcn_mfma_f32_32x32x16_bf16(pa2, ATT_PK(l2, h2), od, 0, 0, 0);
  od = __builtin_amdgcn_mfma_f32_32x32x16_bf16(pa3, ATT_PK(l3, h3), od, 0, 0, 0);
#undef ATT_PK
}
__device__ __forceinline__ void pv_d0(f32x16* o, int vb, bf16x8 pa0, bf16x8 pa1, bf16x8 pa2, bf16x8 pa3) {
  pv_one<0>(o[0], vb, pa0, pa1, pa2, pa3); pv_one<1>(o[1], vb, pa0, pa1, pa2, pa3); pv_one<2>(o[2], vb, pa0, pa1, pa2, pa3); pv_one<3>(o[3], vb, pa0, pa1, pa2, pa3);
}

constexpr int VT8_PITCH = 80, VT8_BYTES = 128 * VT8_PITCH;
__device__ __forceinline__ int pk4_fp8(float a, float b, float c, float d) { int t = 0; t = __builtin_amdgcn_cvt_pk_fp8_f32(a, b, t, false); t = __builtin_amdgcn_cvt_pk_fp8_f32(c, d, t, true); return t; }
__device__ __forceinline__ void finishSM8(f32x16& p0, f32x16& p1, float alpha, float& l_reg, v8i& pa) {
#pragma unroll
  for (int r = 0; r < 16; ++r) p1[r] = __builtin_amdgcn_exp2f(p1[r]);
  float ps = 0;
#pragma unroll
  for (int r = 0; r < 16; ++r) ps += p0[r];
#pragma unroll
  for (int r = 0; r < 16; ++r) ps += p1[r];
  { auto rr = __builtin_amdgcn_permlane32_swap(__float_as_uint(ps), __float_as_uint(ps), false, false);
    ps = __uint_as_float(rr[0]) + __uint_as_float(rr[1]); }
  l_reg = l_reg * alpha + ps;
#pragma unroll
  for (int i = 0; i < 4; ++i) { pa[i] = pk4_fp8(p0[4 * i], p0[4 * i + 1], p0[4 * i + 2], p0[4 * i + 3]); pa[4 + i] = pk4_fp8(p1[4 * i], p1[4 * i + 1], p1[4 * i + 2], p1[4 * i + 3]); }
}
__device__ __forceinline__ void pv8_d0(f32x16* o, const char* vp, v8i pa) {
  typedef int v4i __attribute__((ext_vector_type(4)));
#pragma unroll
  for (int d0 = 0; d0 < 4; ++d0) { const v4i x0 = *reinterpret_cast<const v4i*>(vp + d0 * 32 * VT8_PITCH), x1 = *reinterpret_cast<const v4i*>(vp + d0 * 32 * VT8_PITCH + 16);
    const v8i bf = __builtin_shufflevector(x0, x1, 0, 1, 2, 3, 4, 5, 6, 7);
    o[d0] = __builtin_amdgcn_mfma_scale_f32_32x32x64_f8f6f4(pa, bf, o[d0], 0, 0, 0, 0, 0, 0); }
}

template <int DQK> __device__ __forceinline__ constexpr float q8_scale() { return (ATT_SRCC != 0) ? (DQK == 192 ? 0.07216878364870323f : 0.08838834764831845f) * 1.4426950408889634f / ATT_KS8 : 16.0f; }
template <int DQK, bool QNORM, bool MASKABLE, bool OFP8, bool KF8, bool VF8, bool Q8IN = false>
__device__ __forceinline__ void attn_body(const bf16* __restrict__ Qlane, const float* __restrict__ gq, const float* __restrict__ rope, int qrow, int qcol,
                                          const bf16* __restrict__ K0, long ldk, const bf16* __restrict__ V0, long ldv, int a0, int nA, int b0, int nB, int jB, int qi,
                                          float sink_l2, bf16* __restrict__ Owave, long ldo, char* lds, ATT_LAS unsigned char* ldsl, const int tid) {
  constexpr float SCALE = DQK == 192 ? 0.07216878364870323f : 0.08838834764831845f;
  constexpr bool SRCC = KF8 && (ATT_SRCC != 0);
  constexpr float QKS = KF8 ? 256.0f : 1.0f;
  constexpr float C = SRCC ? 1.0f : SCALE * 1.4426950408889634f / QKS;
  constexpr float THR_RAW = (VF8 ? 2.f : THR) / SCALE * QKS;
  constexpr float THR_L2 = (VF8 ? 2.f : THR) * 1.4426950408889634f;
  constexpr float SQ8 = SRCC ? SCALE * 1.4426950408889634f / ATT_KS8 : 16.0f;
  constexpr int SHMV = VF8 ? VT8_BYTES : SHM_V;
  constexpr float PL2 = VF8 ? 5.0f : 0.0f;
  constexpr int SHM_K = KVBLK * kpitch<DQK, KF8>();
  constexpr int KP = DQK / 64;
  const int wid = __builtin_amdgcn_readfirstlane(tid >> 6), lane = tid & 63, r32 = lane & 31, hi = lane >> 5;
  char* V_lds = lds; char* K_lds = lds + OFF_K;
  float* ws = (float*)(lds + OFF_WS) + wid * 64; float* li_l = ws; float* al_l = ws + 32;
  float m_reg = (KF8 && (ATT_SRCC != 0)) ? 0.f : -1e30f, l_reg = 0; f32x16 o[4] = {}; bf16x8 qr[KF8 ? 1 : DQK / 16]; v8i qf[KF8 ? DQK / 64 : 1];
  bf16x8 qw[(KF8 && !(Q8IN && !QNORM)) ? DQK / 64 : 1][4];
  if constexpr (KF8 && !(Q8IN && !QNORM)) { const bf16* Qw0 = Qlane + hi * 32;
#pragma unroll
    for (int s_ = 0; s_ < DQK / 64; ++s_)
#pragma unroll
      for (int i = 0; i < 4; ++i) qw[s_][i] = *reinterpret_cast<const bf16x8*>(Qw0 + s_ * 64 + i * 8); }
  asm volatile("" ::: "memory");
  constexpr int KPITCH = kpitch<DQK, KF8>(), KSLOTW = SHM_K / 1024, KI = (KSLOTW + 7) / 8, KROWB = DQK * (KF8 ? 1 : 2), KES = KF8 ? 1 : 2;
  int koff[KI], voff[2];
#pragma unroll
  for (int i = 0; i < KI; ++i) { const int p = ((i * 8 + wid) * 64 + lane) * 16; const int row = p / KPITCH; int cb = p - row * KPITCH; if (cb >= KROWB) cb = 0; koff[i] = row * (int)ldk * KES + cb; }
  if constexpr (!VF8) {
#pragma unroll
  for (int i = 0; i < 2; ++i) { const int p = (i * 8 + wid) * 64 + lane; const int sub = p >> 5; const int kk = ((sub >> 2) << 3) | ((p >> 2) & 7); const int k = (kk & ~0xC) | ((kk & 4) << 1) | ((kk & 8) >> 1);
    const int c = (sub & 3) * 32 + (p & 3) * 8; voff[i] = k * (int)ldv * 2 + c * 2; }
  } else { voff[0] = (wid * 64 + lane) * 16; voff[1] = ((8 + wid) * 64 + lane) * 16; }
  const int vbase = (int)(uintptr_t)V_lds + v_rd_base(lane);
  const char* vp8 = V_lds + r32 * VT8_PITCH + hi * 32;
  const int NT = nA + nB;
#define ATT_TROW(t) ((t) < nA ? a0 + 64 * (t) : b0 + 64 * ((t) - nA))
#define ATT_DMA(t, kbsel, vbyte) do { const long r0_ = ATT_TROW(t); const char* kt_ = (const char*)K0 + r0_ * ldk * KES; const char* vt_ = VF8 ? (const char*)V0 + (r0_ >> 6) * ldv : (const char*)V0 + r0_ * ldv * 2; \
    _Pragma("unroll") for (int i_ = 0; i_ < KI; ++i_) { const int s_ = i_ * 8 + wid; if (s_ < KSLOTW) __builtin_amdgcn_global_load_lds((const unsigned*)(kt_ + koff[i_]), (ATT_LAS unsigned*)(ldsl + OFF_K + (kbsel) * SHM_K + s_ * 1024), 16, 0, 0); } \
    _Pragma("unroll") for (int i_ = 0; i_ < 2; ++i_) { if (!VF8 || i_ * 8 + wid < VT8_BYTES / 1024) __builtin_amdgcn_global_load_lds((const unsigned*)(vt_ + voff[i_]), (ATT_LAS unsigned*)(ldsl + (vbyte) + (i_ * 8 + wid) * 1024), 16, 0, 0); } } while (0)
  ATT_DMA(0, 0, 0); ATT_DMA(1, 1, SHMV);
  if constexpr (KF8 && Q8IN && !QNORM) {
    typedef int v4i_q __attribute__((ext_vector_type(4))); const char* Q8 = (const char*)Qlane + hi * 32;
#pragma unroll
    for (int s_ = 0; s_ < DQK / 64; ++s_) { const v4i_q a_ = *reinterpret_cast<const v4i_q*>(Q8 + s_ * 64), b_ = *reinterpret_cast<const v4i_q*>(Q8 + s_ * 64 + 16); qf[s_] = __builtin_shufflevector(a_, b_, 0, 1, 2, 3, 4, 5, 6, 7); }
  } else if constexpr (KF8) {
    constexpr int NS = DQK / 64; float y[NS][32];
    const bf16* Qw = Qlane + hi * 32;
#pragma unroll
    for (int s_ = 0; s_ < NS; ++s_)
#pragma unroll
      for (int i = 0; i < 4; ++i) { const bf16x8 w = qw[s_][i];
#pragma unroll
        for (int e = 0; e < 8; ++e) y[s_][i * 8 + e] = bf2f((unsigned short)w[e]); }
    if constexpr (QNORM) {
      float ss = 0.f;
#pragma unroll
      for (int s_ = 0; s_ < NS; ++s_)
#pragma unroll
        for (int e = 0; e < 32; ++e) ss = fmaf(y[s_][e], y[s_][e], ss);
      ss += __shfl_xor(ss, 32);
      const float rn = 1.0f / sqrtf(ss * (1.0f / DQK) + 1e-6f);
#pragma unroll
      for (int s_ = 0; s_ < NS; ++s_)
#pragma unroll
        for (int i = 0; i < 8; ++i) { const f32x4 g4 = *(const f32x4*)(gq + s_ * 64 + hi * 32 + i * 4);
#pragma unroll
          for (int e = 0; e < 4; ++e) y[s_][i * 4 + e] *= rn * g4[e]; }
      if (rope != nullptr && DQK == 192) {
        const int pos = hi ? qcol : qrow; const float* tp = rope + (size_t)pos * 32;
#pragma unroll
        for (int j = 0; j < 16; ++j) { const float cs = tp[2 * j], sn = tp[2 * j + 1]; const float x1 = y[NS - 1][j], x2 = y[NS - 1][16 + j];
          y[NS - 1][j] = x1 * cs - x2 * sn; y[NS - 1][16 + j] = x1 * sn + x2 * cs; }
      }
    }
#pragma unroll
    for (int s_ = 0; s_ < NS; ++s_)
#pragma unroll
      for (int i = 0; i < 8; ++i) { int t = 0; t = __builtin_amdgcn_cvt_pk_fp8_f32(y[s_][4 * i] * SQ8, y[s_][4 * i + 1] * SQ8, t, false); t = __builtin_amdgcn_cvt_pk_fp8_f32(y[s_][4 * i + 2] * SQ8, y[s_][4 * i + 3] * SQ8, t, true); qf[s_][i] = t; }
  } else
  {
    const bf16* Qw = Qlane + hi * 8;
    if constexpr (!QNORM) {
#pragma unroll
      for (int d0 = 0; d0 < DQK / 16; ++d0) qr[d0] = *reinterpret_cast<const bf16x8*>(Qw + d0 * 16);
    } else {
      float ss = 0.f;
#pragma unroll
      for (int d0 = 0; d0 < DQK / 16; ++d0) { qr[d0] = *reinterpret_cast<const bf16x8*>(Qw + d0 * 16);
#pragma unroll
        for (int e = 0; e < 8; ++e) { const float x = bf2f((unsigned short)qr[d0][e]); ss = fmaf(x, x, ss); } }
      ss += __shfl_xor(ss, 32);
      const float rn = 1.0f / sqrtf(ss * (1.0f / DQK) + 1e-6f);
      float y[DQK / 16][8];
#pragma unroll
      for (int d0 = 0; d0 < DQK / 16; ++d0) { const f32x4 g0 = *(const f32x4*)(gq + d0 * 16 + hi * 8), g1 = *(const f32x4*)(gq + d0 * 16 + hi * 8 + 4);
#pragma unroll
        for (int e = 0; e < 8; ++e) y[d0][e] = bf2f((unsigned short)qr[d0][e]) * rn * (e < 4 ? g0[e] : g1[e - 4]); }
      if (rope != nullptr && DQK == 192) {
#pragma unroll
        for (int half = 0; half < 2; ++half) { const int pos = half ? qcol : qrow; const float* tp = rope + (size_t)(pos * 16 + hi * 8) * 2;
#pragma unroll
          for (int e = 0; e < 8; ++e) { const float cs = tp[2 * e], sn = tp[2 * e + 1]; const float x1 = y[8 + 2 * half][e], x2 = y[9 + 2 * half][e];
            y[8 + 2 * half][e] = x1 * cs - x2 * sn; y[9 + 2 * half][e] = x1 * sn + x2 * cs; } }
      }
#pragma unroll
      for (int d0 = 0; d0 < DQK / 16; ++d0) { u32x4 w = {cvtpk(y[d0][0], y[d0][1]), cvtpk(y[d0][2], y[d0][3]), cvtpk(y[d0][4], y[d0][5]), cvtpk(y[d0][6], y[d0][7])}; qr[d0] = *reinterpret_cast<bf16x8*>(&w); }
    }
  }
#define ATT_QKT(P0, P1, KS) do { if constexpr (SRCC) qkt8<DQK>(P0, P1, KS, qf, r32, hi, PL2 - m_reg); else if constexpr (KF8) qkt8<DQK>(P0, P1, KS, qf, r32, hi); else qkt<DQK>(P0, P1, KS, qr, r32, hi); } while (0)
#define ATT_PSM(FIRST_, P0, P1, MN, AL, ...) do { if constexpr (SRCC) partialSM2<MASKABLE, FIRST_>(P0, P1, m_reg, AL, THR_L2, PL2, __VA_ARGS__); else partialSM<MASKABLE>(P0, P1, m_reg, MN, AL, C, THR_RAW, PL2, __VA_ARGS__); } while (0)
#define ATT_LAND() do { asm volatile("s_waitcnt vmcnt(0)" ::: "memory"); __syncthreads(); } while (0)
#define ATT_RESC(a) do { if (__any((a) < 1.f)) { if (hi == 0) al_l[r32] = (a); asm volatile("s_waitcnt lgkmcnt(0)" ::: "memory"); \
    _Pragma("unroll") for (int d = 0; d < 4; ++d) _Pragma("unroll") for (int r = 0; r < 16; ++r) o[d][r] *= al_l[crow(r, hi)]; } } while (0)
#define ATT_MASKARGS(t) (MASKABLE && (t) >= nA), (jB + 64 * ((t) - nA) - qi + 128 + 4 * hi)
  f32x16 pA0, pA1, pB0, pB1; float mnA, mnB, alA, alB; bf16x8 pa0, pa1, pa2, pa3; v8i pa8;
#define ATT_FIN(P0, P1, AL) do { if constexpr (VF8) finishSM8(P0, P1, AL, l_reg, pa8); else finishSM(P0, P1, AL, l_reg, pa0, pa1, pa2, pa3); } while (0)
#define ATT_PV(VOFF) do { if constexpr (VF8) pv8_d0(o, vp8 + (VOFF), pa8); else pv_d0(o, vbase + (VOFF), pa0, pa1, pa2, pa3); } while (0)
  int vprev = 0, vcur = SHMV, vnext = 2 * SHMV;
  ATT_LAND();
  ATT_QKT(pA0, pA1, K_lds); ATT_PSM(true, pA0, pA1, mnA, alA, ATT_MASKARGS(0));
  __syncthreads();
#ifdef ATT_PRIO_HALF
  if (wid >= 4) __builtin_amdgcn_s_setprio(1);
#endif
  for (int j = 1; j + 1 < NT; j += 2) {
    ATT_DMA(j + 1, 0, vnext);
    ATT_SBAR(); ATT_QKT(pB0, pB1, K_lds + SHM_K);
    ATT_FIN(pA0, pA1, alA); ATT_SBAR();
    ATT_PV(vprev); ATT_PSM(false, pB0, pB1, mnB, alB, ATT_MASKARGS(j));
    ATT_RESC(alB); ATT_LAND();
    { const int t_ = vprev; vprev = vcur; vcur = vnext; vnext = t_; }
    ATT_DMA(j + 2, 1, vnext);
    ATT_SBAR(); ATT_QKT(pA0, pA1, K_lds);
    ATT_FIN(pB0, pB1, alB); ATT_SBAR();
    ATT_PV(vprev); ATT_PSM(false, pA0, pA1, mnA, alA, ATT_MASKARGS(j + 1));
    ATT_RESC(alA); ATT_LAND();
    { const int t_ = vprev; vprev = vcur; vcur = vnext; vnext = t_; }
  }
  ATT_SBAR(); ATT_QKT(pB0, pB1, K_lds + SHM_K);
  ATT_FIN(pA0, pA1, alA); ATT_SBAR();
  ATT_PV(vprev); ATT_PSM(false, pB0, pB1, mnB, alB, ATT_MASKARGS(NT - 1));
  ATT_RESC(alB);
  ATT_FIN(pB0, pB1, alB); ATT_SBAR();
  ATT_PV(vcur);
#ifdef ATT_PRIO_HALF
  __builtin_amdgcn_s_setprio(0);
#endif
  l_reg += __builtin_amdgcn_exp2f(sink_l2 - m_reg * C + PL2);
  if (hi == 0) li_l[r32] = l_reg; asm volatile("s_waitcnt lgkmcnt(0)" ::: "memory");
  float rli[16];
#pragma unroll
  for (int r = 0; r < 16; ++r) rli[r] = __builtin_amdgcn_rcpf(li_l[crow(r, hi)]) * (VF8 ? (1.0f / 32.0f) : 1.0f);
  __syncthreads();
  if constexpr (OFP8) {
    char* ost = lds + wid * (32 * 144);
#pragma unroll
    for (int r = 0; r < 16; ++r) { const int orow = crow(r, hi);
#pragma unroll
      for (int d0 = 0; d0 < 4; ++d0) { const float v = o[d0][r] * rli[r] * 32.0f; const float vc = __builtin_amdgcn_fmed3f(v, -448.f, 448.f); const unsigned w = (unsigned)__builtin_amdgcn_cvt_pk_fp8_f32(vc, vc, 0, false);
        *(unsigned char*)(ost + orow * 144 + d0 * 32 + r32) = (unsigned char)(w & 0xffu); } }
    asm volatile("s_waitcnt lgkmcnt(0)" ::: "memory");
#pragma unroll
    for (int ps = 0; ps < 4; ++ps) { const int row = ps * 8 + (lane >> 3), c16 = lane & 7;
      const u32x4 w = *(const u32x4*)(ost + row * 144 + c16 * 16);
      *(u32x4*)((char*)Owave + (long)row * ldo + c16 * 16) = w; }
  } else {
  char* ost = lds + wid * (32 * OPITCH);
#pragma unroll
  for (int r = 0; r < 16; ++r) { const int orow = crow(r, hi);
#pragma unroll
    for (int d0 = 0; d0 < 4; ++d0) { const float v = o[d0][r] * rli[r]; unsigned u = __float_as_uint(v); u += 0x7fffu + ((u >> 16) & 1u);
      *(unsigned short*)(ost + orow * OPITCH + (d0 * 32 + r32) * 2) = (unsigned short)(u >> 16); } }
  asm volatile("s_waitcnt lgkmcnt(0)" ::: "memory");
#pragma unroll
  for (int ps = 0; ps < 8; ++ps) { const int row = ps * 4 + (lane >> 4), c16 = lane & 15;
    const u32x4 w = *(const u32x4*)(ost + row * OPITCH + c16 * 16);
    *(u32x4*)(Owave + (long)row * ldo + c16 * 8) = w; }
  }
  __syncthreads();
#undef ATT_TROW
#undef ATT_DMA
#undef ATT_QKT
#undef ATT_PSM
#undef ATT_FIN
#undef ATT_PV
#undef ATT_LAND
#undef ATT_RESC
#undef ATT_MASKARGS
}
}

#define LAS __attribute__((address_space(3)))
#define XB_TMO      128
#define XB_XCNT(j)  (256  + 64 * (j))
#define XB_XSUB(j)  (1280 + 64 * (j))
#define XB_XGEN(j)  (2304 + 64 * (j))
#define XB_TOP      3328
#define XB_TOPGEN   3392
#define XCD_BAR_WORDS 3456
#define XB_SPIN_CAP (1u << 18)

__device__ __forceinline__ unsigned xb_ld(unsigned* p)              { return __hip_atomic_load(p, __ATOMIC_RELAXED, __HIP_MEMORY_SCOPE_AGENT); }
__device__ __forceinline__ unsigned xb_add(unsigned* p, unsigned v) { return __hip_atomic_fetch_add(p, v, __ATOMIC_RELAXED, __HIP_MEMORY_SCOPE_AGENT); }
__device__ __forceinline__ unsigned xb_xcc_id() { return (unsigned)__builtin_amdgcn_s_getreg((3 << 11) | 20) & 0xFu; }
#define XB_SPIN(cond, bar) do { unsigned _sp = 0; while (cond) { __builtin_amdgcn_s_sleep(1); \
    if ((++_sp & 255u) == 0u) { if (xb_ld(&(bar)[XB_TMO])) break; if (_sp > XB_SPIN_CAP) { atomicAdd(&(bar)[XB_TMO], 1u); break; } } } } while (0)

struct XcdBarrier {
    unsigned* bar; unsigned x;
    volatile LAS unsigned* st;
};

__device__ __forceinline__ XcdBarrier xcd_barrier_post(unsigned* bar, volatile LAS unsigned* st) {
    XcdBarrier b; b.bar = bar; b.x = xb_xcc_id(); b.st = st;
    if (threadIdx.x == 0) (void)xb_add(&bar[XB_XCNT(b.x)], 1u);
    return b;
}
__device__ __forceinline__ void xcd_barrier_complete(unsigned* bar, unsigned x, unsigned& nloc, unsigned& nx) {
    const unsigned G = gridDim.x * gridDim.y * gridDim.z;
    unsigned sum, cnt, mine, sp = 0u;
    for (;;) {
        sum = 0u; cnt = 0u; mine = 0u;
#pragma unroll
        for (unsigned j = 0; j < 16; ++j) { const unsigned c = xb_ld(&bar[XB_XCNT(j)]); sum += c; cnt += (c > 0u) ? 1u : 0u; mine = (j == x) ? c : mine; }
        if (sum == G) break;
        __builtin_amdgcn_s_sleep(1);
        if ((++sp & 255u) == 0u) { if (xb_ld(&bar[XB_TMO])) break; if (sp > XB_SPIN_CAP) { atomicAdd(&bar[XB_TMO], 1u); break; } }
    }
    nloc = mine > 0u ? mine : 1u; nx = cnt > 0u ? cnt : 1u;
}

__device__ __forceinline__ void xcd_barrier(const XcdBarrier& b) {
    asm volatile("s_waitcnt vmcnt(0)" ::: "memory");
    __syncthreads();
    if (threadIdx.x == 0) {
        unsigned* bar = b.bar;
        __builtin_amdgcn_s_waitcnt(0);
        unsigned nloc = b.st[0], nx = b.st[1];
        if (nloc == 0u) { xcd_barrier_complete(bar, b.x, nloc, nx); b.st[0] = nloc; b.st[1] = nx; }
        const unsigned old = xb_add(&bar[XB_XSUB(b.x)], 1u);
        const unsigned gen = old / nloc;
        if (old + 1u == (gen + 1u) * nloc) {
            __builtin_amdgcn_fence(__ATOMIC_RELEASE, "agent");
            asm volatile("s_waitcnt vmcnt(0)" ::: "memory");
            const unsigned og = xb_add(&bar[XB_TOP], 1u);
            const unsigned tg = og / nx;
            if (og + 1u == (tg + 1u) * nx) xb_add(&bar[XB_TOPGEN], 1u);
            else XB_SPIN(xb_ld(&bar[XB_TOPGEN]) == tg, bar);
            __builtin_amdgcn_fence(__ATOMIC_ACQUIRE, "agent");
            xb_add(&bar[XB_XGEN(b.x)], 1u);
            asm volatile("s_waitcnt vmcnt(0)" ::: "memory");
        } else {
            XB_SPIN(xb_ld(&bar[XB_XGEN(b.x)]) == gen, bar);
            __builtin_amdgcn_fence(__ATOMIC_ACQUIRE, "agent");
            asm volatile("s_waitcnt vmcnt(0)" ::: "memory");
        }
    }
    __syncthreads();
}
#ifndef QUP_I8
#define QUP_I8 0
#endif
#ifndef UP_SUBSTAT
#define UP_SUBSTAT 1
#endif
#ifndef FFN_SORT
#define FFN_SORT 1
#endif
#ifndef UP_I8
#define UP_I8 1
#endif
#ifndef GQ_FP8
#define GQ_FP8 1
#endif
#ifndef W_TAIL3
#define W_TAIL3 1
#endif
#ifndef TAP_FOLD
#define TAP_FOLD 1
#endif
#ifndef UP_TAIL
#define UP_TAIL 0
#endif
#ifndef UPT_A
#define UPT_A 13000
#endif
#ifndef UPT_B
#define UPT_B 15000
#endif
#ifndef DOWN_TAIL
#define DOWN_TAIL 1
#endif
#ifndef KV_FUSE
#define KV_FUSE 1
#endif
#ifndef KVUP_I8
#define KVUP_I8 1
#endif
#ifndef KVUP_FP8
#define KVUP_FP8 1
#endif
#ifndef DOWN_NT8
#define DOWN_NT8 74
#endif
constexpr int DM = 4096, NPROMPT = 16, SEQ = 256, NLAT = 8, LSEQ = 4096, PAST = 256;
constexpr int TP = NPROMPT * SEQ;
constexpr int TL = NLAT * LSEQ;
constexpr int MTOK = TP + TL;
constexpr int KVROWS = TP + NLAT * (PAST + LSEQ);
constexpr int QRANK = 1024, KVRANK = 512, ROPED = 64, MLAH = 16, MLAQK = 192, GQH = 16, GKVH = 4, GHD = 128, DFF = 11008;
constexpr int INC = 4672, INCP = 4864;
constexpr int ZBW = 1792, ZQW = 3072;
constexpr int ZKV = 0, ZPE = 512, ZGK = 576, ZGV = 1088, ZQ = 0, ZGQ = 1024;
constexpr int NMOD = 9;
constexpr int KSPLIT = 32;
constexpr float EPS = 1e-6f;
constexpr int GK8 = DOWN_NT8 * 128;
constexpr int GPB = GK8 + (DFF - GK8) * 2;
constexpr float SG8 = 4.0f, SW8 = 256.0f;
static_assert(DOWN_NT8 % 2 == 0 && GK8 <= DFF && ((DFF - GK8) / 64) % 2 == 0, "mixed-K split");

constexpr size_t MiB = 1u << 20;
constexpr size_t WS_CTL = 0, CTL_ZERO_BYTES = 1 * MiB;
constexpr size_t WS_MOD = 1 * MiB;
constexpr size_t WS_ROPE16 = WS_MOD + 900 * 1024;
constexpr size_t WS_ROPE32 = WS_ROPE16 + 8192;
constexpr size_t WS_COLSC = WS_MOD + 928 * 1024;
constexpr size_t WS_COLMAX = 256 * 1024;
constexpr size_t WS_ROWSC = 2 * MiB;
constexpr size_t WS_MODP = 2 * MiB;
constexpr size_t WS_WIN = 32 * MiB;
constexpr size_t WS_WINQ = 48 * MiB;
constexpr size_t WS_WQUP = 70 * MiB;
constexpr size_t WS_RANK = 73 * MiB;
constexpr size_t WS_SIGMA = WS_RANK + 64 * 1024, WS_CWP = WS_RANK + 128 * 1024, WS_CBP = WS_RANK + 512 * 1024;
constexpr size_t WS_WKVUP = 76 * MiB;
constexpr size_t WS_WOUT = 80 * MiB;
constexpr size_t WS_WUP = 112 * MiB;
constexpr size_t WS_WDOWN = 284 * MiB;
constexpr size_t WS_HB = 370 * MiB;
constexpr size_t WS_Z = 658 * MiB;
constexpr size_t WS_ZB = 874 * MiB;
constexpr size_t WS_K8 = 874 * MiB;
constexpr size_t WS_H8 = 1116 * MiB;
constexpr size_t WS_QRAW = 658 * MiB;
constexpr size_t WS_QN = 1000 * MiB;
constexpr size_t WS_CKV = 1072 * MiB;
constexpr size_t WS_KPE = 1110 * MiB;
constexpr size_t WS_CKVS = WS_KPE + 5 * MiB;
constexpr size_t WS_KPESS = WS_CKVS + 256 * 1024;
constexpr size_t WS_KVCOLMAX = 448 * 1024;
constexpr size_t WS_KVCS = WS_RANK + 640 * 1024;
constexpr size_t WS_KB = 1116 * MiB;
constexpr size_t WS_VB = 1344 * MiB;
constexpr size_t WS_GQ = 1496 * MiB;
constexpr size_t WS_GK = 1640 * MiB;
constexpr size_t WS_GV = 1678 * MiB;
constexpr size_t WS_G = 658 * MiB;
constexpr size_t WS_EDGE = 1432 * MiB;
constexpr size_t WS_VT8 = 1716 * MiB;
constexpr size_t WS_X1 = 1716 * MiB;
constexpr size_t WS_END = 2004 * MiB;
static_assert(WS_G + (size_t)MTOK * DFF * 2 <= WS_EDGE && WS_EDGE + (size_t)576 * 4 * 22016 * 4 <= WS_END, "ws map");
static_assert(WS_KB + (size_t)KVROWS * 3072 * 2 <= WS_VB && WS_VB + (size_t)KVROWS * 2048 * 2 <= WS_GQ && WS_GQ + (size_t)MTOK * 2048 * 2 <= WS_GK && WS_GK + (size_t)KVROWS * 512 * 2 <= WS_GV && WS_GV + (size_t)KVROWS * 512 * 2 <= WS_END, "ws map 2");
static_assert(WS_Z + (size_t)MTOK * ZQW * 2 <= WS_ZB && WS_ZB + (size_t)MTOK * ZBW * 2 <= WS_QN && WS_QN + (size_t)MTOK * 1024 * 2 <= WS_CKV && WS_CKV + (size_t)KVROWS * 512 * 2 <= WS_KPE && WS_KPE + (size_t)KVROWS * 64 * 2 <= WS_KB, "ws map 3");
static_assert(WS_HB + (size_t)MTOK * DM * 2 <= WS_Z && WS_WDOWN + (size_t)DM * DFF * 2 <= WS_HB && WS_WUP + (size_t)22016 * DM * 2 <= WS_WDOWN && WS_WIN + (size_t)ZBW * DM * 2 <= WS_WINQ && WS_WINQ + (size_t)ZQW * DM <= WS_WQUP, "ws map 4");
constexpr int CW_BAR = 4096;

constexpr size_t OUT_Y = 0, OUT_CKV = (size_t)MTOK * DM, OUT_KPE = OUT_CKV + (size_t)TP * KVRANK, OUT_GK = OUT_KPE + (size_t)TP * ROPED, OUT_GV = OUT_GK + (size_t)TP * 512, OUT_END = OUT_GV + (size_t)TP * 512;

constexpr int RING_OFF = 0, RING_BYTES = 131072;
constexpr int MISC_OFF = RING_BYTES + 320;
constexpr int LDS_BYTES = 147456;
constexpr int NWAVES = 8, NTHREADS = 512;
#ifndef MK_ONE_LAUNCH
#define MK_ONE_LAUNCH 1
#endif
constexpr int N_PHASES = 13;
#ifndef ATT_VF8
#define ATT_VF8 1
#endif
#ifndef ATT_KF8
#define ATT_KF8 1
#endif
#ifndef QUP_FP8
#define QUP_FP8 1
#endif
#ifndef MIX_FP8
#define MIX_FP8 1
#endif
#ifndef PROBE_GSCALE
#define PROBE_GSCALE 1.0f
#endif
#ifndef PROBE_GSCALE2
#define PROBE_GSCALE2 1.0f
#endif
#ifndef W_P10
#define W_P3B 4
#define W_P3Q 4
#define W_P5K 4
#define W_P5Q 4
#define W_P8 4
#define W_P10 4
#define W_P12 4
#endif
#ifndef GEMM_ALIGN
#define GEMM_ALIGN true
#endif
#ifndef GEMM_SP2
#define GEMM_SP2 true
#endif

#define LAS __attribute__((address_space(3)))
typedef unsigned short bf16;
typedef unsigned v4u __attribute__((ext_vector_type(4)));
typedef unsigned v2u __attribute__((ext_vector_type(2)));
typedef float f32x4 __attribute__((ext_vector_type(4)));
typedef short bf16x8 __attribute__((ext_vector_type(8)));
#define LDS_WAIT() asm volatile("s_waitcnt lgkmcnt(0)" ::: "memory")
__device__ __forceinline__ unsigned f2bf(float f) { unsigned u = __builtin_bit_cast(unsigned, f); return (u + 0x7fffu + ((u >> 16) & 1u)) >> 16; }
__device__ __forceinline__ unsigned pk2(float lo, float hi) { return f2bf(lo) | (f2bf(hi) << 16); }
__device__ __forceinline__ float bflo(unsigned w) { return __uint_as_float(w << 16); }
__device__ __forceinline__ float bfhi(unsigned w) { return __uint_as_float(w & 0xffff0000u); }
__device__ __forceinline__ void unpack8(const v4u w, float (&x)[8]) { x[0] = bflo(w.x); x[1] = bfhi(w.x); x[2] = bflo(w.y); x[3] = bfhi(w.y); x[4] = bflo(w.z); x[5] = bfhi(w.z); x[6] = bflo(w.w); x[7] = bfhi(w.w); }
__device__ __forceinline__ v4u pack8(const float (&x)[8]) { v4u w; w.x = pk2(x[0], x[1]); w.y = pk2(x[2], x[3]); w.z = pk2(x[4], x[5]); w.w = pk2(x[6], x[7]); return w; }
__device__ __forceinline__ float wave_sum(float v) {
#pragma unroll
    for (int o = 1; o < 64; o <<= 1) v += __shfl_xor(v, o);
    return v;
}
__device__ __forceinline__ float silu_f(float a) { return a / (1.0f + __expf(-a)); }

struct Args { const float* in[27]; float* out; unsigned char* ws; int ph_lo, ph_hi; };

__device__ __forceinline__ int kvrow_of(int t) { if (t < TP) return t; const int u = t - TP, b = u >> 12, s = u & 4095; return TP + b * (PAST + LSEQ) + PAST + s; }

__device__ __forceinline__ void p0_load_block(const float* W, int N, const unsigned* srcrow, int k0, int n0, LAS float* scr, int lane) {
    f32x4 v[8];
#pragma unroll
    for (int i = 0; i < 8; ++i) { const int kk = 8 * i + (lane >> 3); const size_t sr = srcrow ? (size_t)srcrow[k0 + kk] : (size_t)(k0 + kk); v[i] = *(const f32x4*)(W + sr * N + n0 + 4 * (lane & 7)); }
#pragma unroll
    for (int i = 0; i < 8; ++i) { LAS float* d = scr + (8 * i + (lane >> 3)) * 33 + 4 * (lane & 7); d[0] = v[i].x; d[1] = v[i].y; d[2] = v[i].z; d[3] = v[i].w; }
}
template <class DMap>
__device__ __forceinline__ void p0_transpose_item(const float* W, int K, int N, bf16* WT, const DMap& dmap, LAS float* scr, int item, int lane, const unsigned* srcrow = nullptr) {
    const int nblk = N / 32, kb = item / nblk, nb = item % nblk, k0 = 64 * kb, n0 = 32 * nb;
    p0_load_block(W, N, srcrow, k0, n0, scr, lane);
    LDS_WAIT(); asm volatile("" ::: "memory");
    const int c = lane & 7; const int r0 = dmap(n0);
#pragma unroll
    for (int j = 0; j < 4; ++j) { const int n = (lane >> 3) + 8 * j; const LAS float* s = scr + (8 * c) * 33 + n;
        v4u o; o.x = pk2(s[0 * 33], s[1 * 33]); o.y = pk2(s[2 * 33], s[3 * 33]); o.z = pk2(s[4 * 33], s[5 * 33]); o.w = pk2(s[6 * 33], s[7 * 33]);
        *(v4u*)(WT + (size_t)(r0 + n) * K + k0 + 8 * c) = o; }
    LDS_WAIT(); asm volatile("" ::: "memory");
}
__device__ __forceinline__ void p0_transpose_item_fp8(const float* W, int K, int N, unsigned char* WT, LAS float* scr, int item, int lane, int row_shift = 0, const unsigned* srcrow = nullptr) {
    const int nblk = N / 32, kb = item / nblk, nb = item % nblk, k0 = 64 * kb, n0 = 32 * nb;
    p0_load_block(W, N, srcrow, k0, n0, scr, lane);
    LDS_WAIT(); asm volatile("" ::: "memory");
    const int c = lane & 3;
#pragma unroll
    for (int j = 0; j < 2; ++j) { const int n = (lane >> 2) + 16 * j; const LAS float* s = scr + (16 * c) * 33 + n; unsigned w[4];
#pragma unroll
        for (int q = 0; q < 4; ++q) { int t = 0; t = cvt_pk_fp8_sat(s[(4 * q) * 33] * 256.f, s[(4 * q + 1) * 33] * 256.f, t, false); t = cvt_pk_fp8_sat(s[(4 * q + 2) * 33] * 256.f, s[(4 * q + 3) * 33] * 256.f, t, true); w[q] = (unsigned)t; }
        v4u o; o.x = w[0]; o.y = w[1]; o.z = w[2]; o.w = w[3];
        *(v4u*)(WT + (size_t)(n0 + n + row_shift) * K + k0 + 16 * c) = o; }
    LDS_WAIT(); asm volatile("" ::: "memory");
}
__device__ __forceinline__ void p0_colmax_item(const float* W, int N, unsigned* colmax, int item, int lane) {
    const int nblk = N / 32, kb = item / nblk, nb = item % nblk, k0 = 64 * kb, n0 = 32 * nb; f32x4 v[8]; f32x4 mx = (f32x4){0.f, 0.f, 0.f, 0.f};
#pragma unroll
    for (int i = 0; i < 8; ++i) v[i] = *(const f32x4*)(W + (size_t)(k0 + 8 * i + (lane >> 3)) * N + n0 + 4 * (lane & 7));
#pragma unroll
    for (int i = 0; i < 8; ++i) { mx.x = fmaxf(mx.x, fabsf(v[i].x)); mx.y = fmaxf(mx.y, fabsf(v[i].y)); mx.z = fmaxf(mx.z, fabsf(v[i].z)); mx.w = fmaxf(mx.w, fabsf(v[i].w)); }
#pragma unroll
    for (int o = 8; o < 64; o <<= 1) { mx.x = fmaxf(mx.x, __shfl_xor(mx.x, o)); mx.y = fmaxf(mx.y, __shfl_xor(mx.y, o)); mx.z = fmaxf(mx.z, __shfl_xor(mx.z, o)); mx.w = fmaxf(mx.w, __shfl_xor(mx.w, o)); }
    if (lane < 8) { unsigned* c = colmax + n0 + 4 * lane; atomicMax(c, __float_as_uint(mx.x)); atomicMax(c + 1, __float_as_uint(mx.y)); atomicMax(c + 2, __float_as_uint(mx.z)); atomicMax(c + 3, __float_as_uint(mx.w)); }
}
__device__ __forceinline__ void p0_colss_item(const float* W, int N, unsigned long long* colss, int item, int lane) {
    const int nblk = N / 32, kb = item / nblk, nb = item % nblk, k0 = 64 * kb, n0 = 32 * nb; f32x4 v[8]; f32x4 ss = (f32x4){0.f, 0.f, 0.f, 0.f};
#pragma unroll
    for (int i = 0; i < 8; ++i) v[i] = *(const f32x4*)(W + (size_t)(k0 + 8 * i + (lane >> 3)) * N + n0 + 4 * (lane & 7));
#pragma unroll
    for (int i = 0; i < 8; ++i) ss += v[i] * v[i];
#pragma unroll
    for (int o = 8; o < 64; o <<= 1) { ss.x += __shfl_xor(ss.x, o); ss.y += __shfl_xor(ss.y, o); ss.z += __shfl_xor(ss.z, o); ss.w += __shfl_xor(ss.w, o); }
    if (lane < 8) { unsigned long long* c = colss + n0 + 4 * lane; atomicAdd(c, (unsigned long long)(ss.x * 1099511627776.0f)); atomicAdd(c + 1, (unsigned long long)(ss.y * 1099511627776.0f));
        atomicAdd(c + 2, (unsigned long long)(ss.z * 1099511627776.0f)); atomicAdd(c + 3, (unsigned long long)(ss.w * 1099511627776.0f)); }
}
template <class DMap, bool EXACT = false>
__device__ __forceinline__ void p0_transpose_item_i8(const float* W, int K, int N, signed char* WT, const DMap& dmap, const unsigned* colmax, float* colscale, LAS float* scr, int item, int lane, float fixed_cm = 0.15875f) {
    const int nblk = N / 32, kb = item / nblk, nb = item % nblk, k0 = 64 * kb, n0 = 32 * nb;
    p0_load_block(W, N, nullptr, k0, n0, scr, lane);
    LDS_WAIT(); asm volatile("" ::: "memory");
    const int c = lane & 3;
#pragma unroll
    for (int j = 0; j < 2; ++j) { const int n = (lane >> 2) + 16 * j; const LAS float* s = scr + (16 * c) * 33 + n; const int r0 = dmap(n0 + n) - n;
        const float cm = colmax ? ((UP_SUBSTAT && !EXACT) ? 4.2f * sqrtf((float)((const unsigned long long*)colmax)[n0 + n] * (1.0f / 1099511627776.0f) * (1.0f / 512.0f)) : __uint_as_float(colmax[n0 + n])) : fixed_cm; const float inv = cm > 0.f ? 127.0f / cm : 0.f; unsigned w[4];
#pragma unroll
        for (int q = 0; q < 4; ++q) { unsigned t = 0;
#pragma unroll
            for (int e = 0; e < 4; ++e) { int v = (int)__builtin_rintf(s[(4 * q + e) * 33] * inv); v = v > 127 ? 127 : (v < -127 ? -127 : v); t |= ((unsigned)v & 0xffu) << (8 * e); }
            w[q] = t; }
        *(v4u*)(WT + (size_t)(r0 + n) * K + k0 + 16 * c) = (v4u){w[0], w[1], w[2], w[3]};
        if (colscale && kb == 0 && c == 0) colscale[r0 + n] = cm * (1.0f / 127.0f); }
    LDS_WAIT(); asm volatile("" ::: "memory");
}
struct MapId { __device__ __forceinline__ int operator()(int n) const { return n; } };
template <class DMap>
__device__ __forceinline__ void p0_transpose_item_fp8m(const float* W, int K, int N, unsigned char* WT, const DMap& dmap, LAS float* scr, int item, int lane) {
    const int nblk = N / 32, kb = item / nblk, nb = item % nblk, k0 = 64 * kb, n0 = 32 * nb;
    p0_load_block(W, N, nullptr, k0, n0, scr, lane);
    LDS_WAIT(); asm volatile("" ::: "memory");
    const int c = lane & 3; const int r0 = dmap(n0);
#pragma unroll
    for (int j = 0; j < 2; ++j) { const int n = (lane >> 2) + 16 * j; const LAS float* s = scr + (16 * c) * 33 + n; unsigned w[4];
#pragma unroll
        for (int q = 0; q < 4; ++q) { int t = 0; t = cvt_pk_fp8_sat(s[(4 * q) * 33] * 256.f, s[(4 * q + 1) * 33] * 256.f, t, false); t = cvt_pk_fp8_sat(s[(4 * q + 2) * 33] * 256.f, s[(4 * q + 3) * 33] * 256.f, t, true); w[q] = (unsigned)t; }
        *(v4u*)(WT + (size_t)(r0 + n) * K + k0 + 16 * c) = (v4u){w[0], w[1], w[2], w[3]}; }
    LDS_WAIT(); asm volatile("" ::: "memory");
}
struct MapShift { int sh; __device__ __forceinline__ int operator()(int n) const { return n + sh; } };
struct MapUpPerm { const unsigned* rank; __device__ __forceinline__ int operator()(int n) const { const int v = n >= DFF, c = n - v * DFF; const int p = (int)rank[c]; return (p >> 7) * 256 + v * 128 + (p & 127); } };
struct MapUp { __device__ __forceinline__ int operator()(int n) const { const int v = n >= DFF, c = n - v * DFF; return (c >> 7) * 256 + v * 128 + (c & 127); } };

__device__ __forceinline__ void phase0(const Args& a, LAS unsigned char* lds, int vcu, int G) {
    const int tid = threadIdx.x, lane = tid & 63, wave = __builtin_amdgcn_readfirstlane(tid >> 6);
    LAS float* scr = (LAS float*)(lds + RING_OFF + wave * 16384);
    const int gw = vcu * NWAVES + wave, NGW = G * NWAVES;
    unsigned char* ws = a.ws;
    if (FFN_SORT) {
        const float* cw = a.in[24]; LAS float* e = (LAS float*)(lds + RING_OFF);
        for (int k = tid; k < DFF; k += NTHREADS) { const float a0 = cw[k], a1 = cw[22016 + k], a2 = cw[2 * 22016 + k], b0 = cw[DFF + k], b1 = cw[22016 + DFF + k], b2 = cw[2 * 22016 + DFF + k];
            e[k] = (a0 * a0 + a1 * a1 + a2 * a2) * (b0 * b0 + b1 * b1 + b2 * b2); }
        __syncthreads();
        unsigned* rank = (unsigned*)(ws + WS_RANK); unsigned* sigma = (unsigned*)(ws + WS_SIGMA);
        for (int k = gw; k < DFF; k += NGW) { const float ek = e[k]; int cnt = 0;
            for (int j = lane; j < DFF; j += 64) { const float ej = e[j]; cnt += (ej < ek || (ej == ek && j < k)) ? 1 : 0; }
#pragma unroll
            for (int o = 1; o < 64; o <<= 1) cnt += __shfl_xor(cnt, o);
            if (lane == 0) { rank[k] = (unsigned)cnt; sigma[cnt] = (unsigned)k; } }
        __syncthreads();
    }
    {
        const float* cvec = a.in[6]; const float* cctx = a.in[7]; const float* wada = a.in[10];
        float* modp = (float*)(ws + WS_MODP);
        for (int task = gw; task < 96 * KSPLIT; task += NGW) {
            const int cg = task % 96, ks = task / 96, k0 = ks * 128;
            for (int i = lane; i < NMOD * 128; i += 64) { const int r = i >> 7, kk = i & 127; const float v = (r < 8) ? cvec[r * DM + k0 + kk] : cctx[k0 + kk]; scr[i] = silu_f(v); }
            LDS_WAIT(); asm volatile("" ::: "memory");
            f32x4 acc[NMOD];
#pragma unroll
            for (int r = 0; r < NMOD; ++r) acc[r] = (f32x4){0.f, 0.f, 0.f, 0.f};
            const float* wp = wada + (size_t)k0 * 24576 + cg * 256 + lane * 4;
#pragma unroll 4
            for (int kk = 0; kk < 128; ++kk) { const f32x4 w = *(const f32x4*)(wp + (size_t)kk * 24576);
#pragma unroll
                for (int r = 0; r < NMOD; ++r) acc[r] += w * scr[r * 128 + kk]; }
#pragma unroll
            for (int r = 0; r < NMOD; ++r) *(f32x4*)(modp + ((size_t)ks * NMOD + r) * 24576 + cg * 256 + lane * 4) = acc[r];
            LDS_WAIT(); asm volatile("" ::: "memory");
        }
    }
    {
        constexpr int I_IN = (DM / 64) * (INC / 32), I_QUP = (QRANK / 64) * (3072 / 32), I_KVUP = (KVRANK / 64) * (4096 / 32), I_OUT = (DM / 64) * (DM / 32), I_UP = (DM / 64) * (22016 / 32), I_DOWN = (DFF / 64) * (DM / 32);
        constexpr int NITEMS = I_IN + I_QUP + I_KVUP + I_OUT + I_UP + I_DOWN;
        for (int it = gw; it < NITEMS; it += NGW) {
            int r = it;
            if (r < I_IN) { const int n0 = 32 * (r % (INC / 32));
                if (n0 < 1024) p0_transpose_item_fp8(a.in[12], DM, INC, (unsigned char*)(ws + WS_WINQ), scr, r, lane, 0);
                else if (n0 < 1536) p0_transpose_item(a.in[12], DM, INC, (bf16*)(ws + WS_WIN), MapShift{ZKV - 1024}, scr, r, lane);
                else if (n0 < 1600) p0_transpose_item(a.in[12], DM, INC, (bf16*)(ws + WS_WIN), MapShift{ZPE - 1536}, scr, r, lane);
                else if (n0 < 3648) p0_transpose_item_fp8(a.in[12], DM, INC, (unsigned char*)(ws + WS_WINQ), scr, r, lane, ZGQ - 1600);
                else if (n0 < 4160) p0_transpose_item(a.in[12], DM, INC, (bf16*)(ws + WS_WIN), MapShift{ZGK - 3648}, scr, r, lane);
                else p0_transpose_item(a.in[12], DM, INC, (bf16*)(ws + WS_WIN), MapShift{ZGV - 4160}, scr, r, lane);
                continue; } r -= I_IN;
            if (r < I_QUP) { if (W_TAIL3 && QUP_FP8 && !QUP_I8 && MIX_FP8) continue; if (QUP_I8) p0_transpose_item_i8(a.in[14], QRANK, 3072, (signed char*)(ws + WS_WQUP), MapId(), nullptr, nullptr, scr, r, lane); else if (QUP_FP8) p0_transpose_item_fp8(a.in[14], QRANK, 3072, (unsigned char*)(ws + WS_WQUP), scr, r, lane); else p0_transpose_item(a.in[14], QRANK, 3072, (bf16*)(ws + WS_WQUP), MapId(), scr, r, lane); continue; } r -= I_QUP;
            if (r < I_KVUP) { if (KVUP_I8) p0_colmax_item(a.in[16], 4096, (unsigned*)(ws + WS_KVCOLMAX), r, lane); else if (KVUP_FP8) p0_transpose_item_fp8(a.in[16], KVRANK, 4096, (unsigned char*)(ws + WS_WKVUP), scr, r, lane); else p0_transpose_item(a.in[16], KVRANK, 4096, (bf16*)(ws + WS_WKVUP), MapId(), scr, r, lane); continue; } r -= I_KVUP;
            if (r < I_OUT) { if (W_TAIL3 && QUP_FP8 && !QUP_I8 && MIX_FP8) continue; if (MIX_FP8) p0_transpose_item_fp8(a.in[22], DM, DM, (unsigned char*)(ws + WS_WOUT), scr, r, lane); else p0_transpose_item(a.in[22], DM, DM, (bf16*)(ws + WS_WOUT), MapId(), scr, r, lane); continue; } r -= I_OUT;
#if defined(PROBE_UPF8W)
            if (r < I_UP) { p0_transpose_item_fp8m(a.in[23], DM, 22016, (unsigned char*)(ws + WS_WUP), MapUp(), scr, r, lane); continue; }
#endif
#if defined(PROBE_P0CONV)
            if (r < I_UP) { p0_transpose_item_i8(a.in[23], DM, 22016, (signed char*)(ws + WS_WUP), MapUp(), nullptr, (float*)(ws + WS_COLSC), scr, r, lane, 0.085f); continue; }
#endif
            if (r < I_UP) { if (UP_I8 && UP_SUBSTAT) { if (r < 8 * (22016 / 32)) p0_colss_item(a.in[23], 22016, (unsigned long long*)(ws + WS_COLMAX), r, lane); } else if (UP_I8) p0_colmax_item(a.in[23], 22016, (unsigned*)(ws + WS_COLMAX), r, lane); else p0_transpose_item(a.in[23], DM, 22016, (bf16*)(ws + WS_WUP), MapUp(), scr, r, lane); continue; } r -= I_UP;
            if (FFN_SORT) continue;
            { const int k0 = 64 * (r / (DM / 32));
              if (k0 < GK8) p0_transpose_item_fp8(a.in[26], GPB, DM, (unsigned char*)(ws + WS_WDOWN), scr, r, lane, 0);
              else p0_transpose_item(a.in[26], GPB / 2, DM, (bf16*)(ws + WS_WDOWN) - GK8 / 2, MapId(), scr, r, lane); }
        }
        v4u* pz = (v4u*)((bf16*)(ws + WS_WIN) + (size_t)1600 * DM); const size_t nz = (size_t)(ZBW - 1600) * DM * 2 / 16;
        for (size_t i = (size_t)vcu * NTHREADS + tid; i < nz; i += (size_t)G * NTHREADS) pz[i] = (v4u){0u, 0u, 0u, 0u};
    }
}
__device__ __forceinline__ void phase1(const Args& a, LAS unsigned char* lds, int vcu, int G) {
    const int tid = threadIdx.x; unsigned char* ws = a.ws;
#if defined(PROBE_P0CONV)
    if (false) {
#else
    if (UP_I8 && !(UP_TAIL && FFN_SORT)) {
#endif
        const int lane = tid & 63, wave = __builtin_amdgcn_readfirstlane(tid >> 6); LAS float* scr = (LAS float*)(lds + RING_OFF + wave * 16384);
        for (int it = vcu * NWAVES + wave; it < (DM / 64) * (22016 / 32); it += G * NWAVES)
#if defined(PROBE_FIXEDCOL)
            p0_transpose_item_i8(a.in[23], DM, 22016, (signed char*)(ws + WS_WUP), MapUp(), nullptr, (float*)(ws + WS_COLSC), scr, it, lane, 0.085f);
#else
            if (FFN_SORT) p0_transpose_item_i8(a.in[23], DM, 22016, (signed char*)(ws + WS_WUP), MapUpPerm{(const unsigned*)(ws + WS_RANK)}, (const unsigned*)(ws + WS_COLMAX), (float*)(ws + WS_COLSC), scr, it, lane);
            else p0_transpose_item_i8(a.in[23], DM, 22016, (signed char*)(ws + WS_WUP), MapUp(), (const unsigned*)(ws + WS_COLMAX), (float*)(ws + WS_COLSC), scr, it, lane);
#endif
    }
    if (KVUP_I8) {
        const int lane = tid & 63, wave = __builtin_amdgcn_readfirstlane(tid >> 6); LAS float* scr = (LAS float*)(lds + RING_OFF + wave * 16384);
        for (int it = vcu * NWAVES + wave; it < (KVRANK / 64) * (4096 / 32); it += G * NWAVES)
            p0_transpose_item_i8<MapId, true>(a.in[16], KVRANK, 4096, (signed char*)(ws + WS_WKVUP), MapId(), (const unsigned*)(ws + WS_KVCOLMAX), (float*)(ws + WS_KVCS), scr, it, lane);
    }
    if (FFN_SORT) {
        const int lane = tid & 63, wave = __builtin_amdgcn_readfirstlane(tid >> 6); LAS float* scr = (LAS float*)(lds + RING_OFF + wave * 16384); const unsigned* sigma = (const unsigned*)(ws + WS_SIGMA);
        if (!DOWN_TAIL)
        for (int it = vcu * NWAVES + wave; it < (DFF / 64) * (DM / 32); it += G * NWAVES) { const int k0 = 64 * (it / (DM / 32));
            if (k0 < GK8) p0_transpose_item_fp8(a.in[26], GPB, DM, (unsigned char*)(ws + WS_WDOWN), scr, it, lane, 0, sigma);
            else p0_transpose_item(a.in[26], GPB / 2, DM, (bf16*)(ws + WS_WDOWN) - GK8 / 2, MapId(), scr, it, lane, sigma); }
        const float* cw = a.in[24]; const float* cb = a.in[25]; float* cwp = (float*)(ws + WS_CWP); float* cbp = (float*)(ws + WS_CBP);
        for (int i = vcu * NTHREADS + tid; i < 2 * DFF; i += G * NTHREADS) { const int v = i >= DFF, pp = i - v * DFF; const int src = v * DFF + (int)sigma[pp];
            const float f = !TAP_FOLD ? 1.0f : (v ? (-0.6931471805599453f) * (pp < GK8 ? SG8 : 1.0f) : -1.4426950408889634f);
            cwp[i] = cw[src] * f; cwp[22016 + i] = cw[22016 + src] * f; cwp[2 * 22016 + i] = cw[2 * 22016 + src] * f; cbp[i] = cb[src] * f; }
    }
    const float* modp = (const float*)(ws + WS_MODP); float* mod = (float*)(ws + WS_MOD); const float* bada = a.in[11];
    for (int i = vcu * NTHREADS + tid; i < NMOD * 24576; i += G * NTHREADS) { const int n = i % 24576; float s = bada[n];
#pragma unroll 8
        for (int ks = 0; ks < KSPLIT; ++ks) s += modp[(size_t)ks * NMOD * 24576 + i];
        mod[i] = s; }
    const int gi = vcu * NTHREADS + tid;
    if (gi < 64 * 16 + 64 * 32) {
        const bool t32 = gi >= 64 * 16; const int idx = t32 ? gi - 64 * 16 : gi; const int half = t32 ? 32 : 16; const int pos = idx / half, j = idx % half;
        const double step = t32 ? 0.74989420933245582730 : 0.56234132519034908039;
        double inv = 1.0; for (int q = 0; q < j; ++q) inv *= step;
        double ang = (double)pos * (double)(float)inv;
        const double twopi = 6.283185307179586476925286766559;
        const double kq = __builtin_rint(ang * (1.0 / twopi)); double x = ang - kq * twopi; const double x2 = x * x;
        double sn = x, cs = 1.0, ts = x, tc = 1.0;
#pragma unroll
        for (int q = 1; q <= 14; ++q) { tc = -tc * x2 * (1.0 / (double)((2 * q - 1) * (2 * q))); cs += tc; ts = -ts * x2 * (1.0 / (double)((2 * q) * (2 * q + 1))); sn += ts; }
        float* tab = (float*)(ws + (t32 ? WS_ROPE32 : WS_ROPE16));
        tab[(size_t)idx * 2] = (float)cs; tab[(size_t)idx * 2 + 1] = (float)sn;
    }
}
template <bool XB>
__device__ __forceinline__ void phase_norm(const void* xp, const void* xs, const float* g, const float* mod, int off_shift, int off_scale, bf16* out, unsigned char* out8, float* rowscale, LAS unsigned char* lds, int vcu, int G) {
    const int tid = threadIdx.x, lane = tid & 63, wave = tid >> 6;
    LAS float* Av = (LAS float*)(lds + RING_OFF); LAS float* Bv = Av + DM;
    const int ntask = MTOK / 16, per = (ntask + G - 1) / G; int cur_mr = -1;
    for (int k = 0; k < per; ++k) { const int task = vcu * per + k; if (task >= ntask) break;
        const int t0 = task * 16; const int mr = t0 < TP ? 8 : ((t0 - TP) >> 12);
        if (mr != cur_mr) { __syncthreads();
            for (int c = tid; c < DM; c += NTHREADS) { Av[c] = g[c] * (1.0f + mod[(size_t)mr * 24576 + off_scale + c]); Bv[c] = mod[(size_t)mr * 24576 + off_shift + c]; }
            __syncthreads(); cur_mr = mr; }
#pragma unroll 1
        for (int i = 0; i < 2; ++i) { const int t = t0 + wave * 2 + i;
            f32x4 v[16]; float ss = 0.f;
            if constexpr (XB) { const bf16* xr = (const bf16*)xp + (size_t)t * DM;
#pragma unroll
                for (int q = 0; q < 8; ++q) { const v4u w = *(const v4u*)(xr + lane * 8 + 512 * q); v[2 * q] = (f32x4){bflo(w.x), bfhi(w.x), bflo(w.y), bfhi(w.y)}; v[2 * q + 1] = (f32x4){bflo(w.z), bfhi(w.z), bflo(w.w), bfhi(w.w)}; }
            } else { const float* xr = (t < TP) ? (const float*)xp + (size_t)t * DM : (const float*)xs + (size_t)(t - TP) * DM;
#pragma unroll
                for (int j = 0; j < 16; ++j) v[j] = *(const f32x4*)(xr + lane * 8 + 512 * (j >> 1) + 4 * (j & 1));
            }
#pragma unroll
            for (int j = 0; j < 16; ++j) ss += (v[j].x * v[j].x + v[j].y * v[j].y) + (v[j].z * v[j].z + v[j].w * v[j].w);
            const float r = 1.0f / sqrtf(wave_sum(ss) * (1.0f / DM) + EPS);
            if (rowscale) {
                float mx = 0.f;
#pragma unroll
                for (int j = 0; j < 16; ++j) { const int c = lane * 8 + 512 * (j >> 1) + 4 * (j & 1); const f32x4 av = *(const LAS f32x4*)(Av + c), bv = *(const LAS f32x4*)(Bv + c);
                    v[j] = (v[j] * r) * av + bv; mx = fmaxf(fmaxf(mx, fmaxf(fabsf(v[j].x), fabsf(v[j].y))), fmaxf(fabsf(v[j].z), fabsf(v[j].w)));
                    if ((j & 3) == 3) asm volatile("" ::: "memory"); }
#pragma unroll
                for (int o = 1; o < 64; o <<= 1) mx = fmaxf(mx, __shfl_xor(mx, o));
                const float inv = mx > 0.f ? 127.0f / mx : 0.f;
                if (lane == 0) rowscale[t] = mx * (1.0f / 127.0f);
#pragma unroll
                for (int q = 0; q < 8; ++q) { v2u o;
#define PN_Q8(vv) (((unsigned)(int)__builtin_rintf((vv).x * inv) & 0xffu) | (((unsigned)(int)__builtin_rintf((vv).y * inv) & 0xffu) << 8) | (((unsigned)(int)__builtin_rintf((vv).z * inv) & 0xffu) << 16) | (((unsigned)(int)__builtin_rintf((vv).w * inv)) << 24))
                    o.x = PN_Q8(v[2 * q]); o.y = PN_Q8(v[2 * q + 1]);
#undef PN_Q8
                    *(v2u*)(out8 + (size_t)t * DM + lane * 8 + 512 * q) = o; }
            } else {
            bf16* orow = out + (size_t)t * DM;
#pragma unroll
            for (int q = 0; q < 8; ++q) { const int c = lane * 8 + 512 * q;
                const f32x4 a0 = *(const LAS f32x4*)(Av + c), b0 = *(const LAS f32x4*)(Bv + c), a1 = *(const LAS f32x4*)(Av + c + 4), b1 = *(const LAS f32x4*)(Bv + c + 4);
                const f32x4 y0 = (v[2 * q] * r) * a0 + b0, y1 = (v[2 * q + 1] * r) * a1 + b1;
                v4u w; w.x = pk2(y0.x, y0.y); w.y = pk2(y0.z, y0.w); w.z = pk2(y1.x, y1.y); w.w = pk2(y1.z, y1.w); *(v4u*)(orow + c) = w;
                if (out8) { v2u o8; int tt = 0; tt = cvt_pk_fp8_sat(y0.x * 16.f, y0.y * 16.f, tt, false); tt = cvt_pk_fp8_sat(y0.z * 16.f, y0.w * 16.f, tt, true); o8.x = (unsigned)tt;
                    tt = 0; tt = cvt_pk_fp8_sat(y1.x * 16.f, y1.y * 16.f, tt, false); tt = cvt_pk_fp8_sat(y1.z * 16.f, y1.w * 16.f, tt, true); o8.y = (unsigned)tt;
                    *(v2u*)(out8 + (size_t)t * DM + c) = o8; }
                if (q & 1) asm volatile("" ::: "memory"); }
            }
        }
    }
    __syncthreads();
}
template <int CTRL> __device__ __forceinline__ float dppx(float v) { return __builtin_bit_cast(float, __builtin_amdgcn_update_dpp(0, __builtin_bit_cast(int, v), CTRL, 0xf, 0xf, true)); }
__device__ __forceinline__ float row16_sum(float v) { v += dppx<0xB1>(v); v += dppx<0x4E>(v); v += dppx<0x141>(v); v += dppx<0x140>(v); return v; }
__device__ __forceinline__ float wave_sum_rl(float v) { v = row16_sum(v); const int b = __builtin_bit_cast(int, v);
    return (__builtin_bit_cast(float, __builtin_amdgcn_readlane(b, 0)) + __builtin_bit_cast(float, __builtin_amdgcn_readlane(b, 16))) + (__builtin_bit_cast(float, __builtin_amdgcn_readlane(b, 32)) + __builtin_bit_cast(float, __builtin_amdgcn_readlane(b, 48))); }
__device__ __forceinline__ float wave_max_rl(float v) { v = fmaxf(v, dppx<0xB1>(v)); v = fmaxf(v, dppx<0x4E>(v)); v = fmaxf(v, dppx<0x141>(v)); v = fmaxf(v, dppx<0x140>(v)); const int b = __builtin_bit_cast(int, v);
    return fmaxf(fmaxf(__builtin_bit_cast(float, __builtin_amdgcn_readlane(b, 0)), __builtin_bit_cast(float, __builtin_amdgcn_readlane(b, 16))), fmaxf(__builtin_bit_cast(float, __builtin_amdgcn_readlane(b, 32)), __builtin_bit_cast(float, __builtin_amdgcn_readlane(b, 48)))); }
__device__ __forceinline__ void store_row_i8(const float (&x)[8], unsigned char* dst, float* scale, int lane) {
    float mx = 0.f;
#pragma unroll
    for (int e = 0; e < 8; ++e) mx = fmaxf(mx, fabsf(x[e]));
    mx = wave_max_rl(mx); const float inv = mx > 0.f ? 127.0f / mx : 0.f; unsigned q[8];
#pragma unroll
    for (int e = 0; e < 8; ++e) q[e] = (unsigned)(int)__builtin_rintf(__builtin_amdgcn_fmed3f(x[e] * inv, -127.f, 127.f)) & 0xffu;
    v2u w; w.x = q[0] | (q[1] << 8) | (q[2] << 16) | (q[3] << 24); w.y = q[4] | (q[5] << 8) | (q[6] << 16) | (q[7] << 24);
    *(v2u*)(dst + lane * 8) = w; if (lane == 0) *scale = mx * (1.0f / 127.0f);
}
__device__ __forceinline__ v2u pack8_fp8s(const float (&x)[8], const float sc) { v2u w; int tt = 0; tt = cvt_pk_fp8_sat(x[0] * sc, x[1] * sc, tt, false); tt = cvt_pk_fp8_sat(x[2] * sc, x[3] * sc, tt, true); w.x = (unsigned)tt;
    tt = 0; tt = cvt_pk_fp8_sat(x[4] * sc, x[5] * sc, tt, false); tt = cvt_pk_fp8_sat(x[6] * sc, x[7] * sc, tt, true); w.y = (unsigned)tt; return w; }
__device__ __forceinline__ v2u pack8_fp8x16(const float (&x)[8]) { v2u w; int tt = 0; tt = cvt_pk_fp8_sat(x[0] * 16.f, x[1] * 16.f, tt, false); tt = cvt_pk_fp8_sat(x[2] * 16.f, x[3] * 16.f, tt, true); w.x = (unsigned)tt;
    tt = 0; tt = cvt_pk_fp8_sat(x[4] * 16.f, x[5] * 16.f, tt, false); tt = cvt_pk_fp8_sat(x[6] * 16.f, x[7] * 16.f, tt, true); w.y = (unsigned)tt; return w; }
__device__ __forceinline__ void phase4(const Args& a, int vcu, int G) {
    const int tid = threadIdx.x, lane = tid & 63, wave = tid >> 6; unsigned char* ws = a.ws;
    const bf16* Zq = (const bf16*)(ws + WS_Z); const bf16* Zb = (const bf16*)(ws + WS_ZB); bf16* QN = (bf16*)(ws + WS_QN); bf16* CKV = (bf16*)(ws + WS_CKV); bf16* KPE = (bf16*)(ws + WS_KPE);
    bf16* GQ = (bf16*)(ws + WS_GQ); bf16* GK = (bf16*)(ws + WS_GK); bf16* GV = (bf16*)(ws + WS_GV); unsigned char* GK8 = (unsigned char*)(ws + WS_GK);
    const float* T32 = (const float*)(ws + WS_ROPE32);
    const float* g_q_lat = a.in[13]; const float* g_kv_lat = a.in[15]; const float* g_gq = a.in[19]; const float* g_gk = a.in[20];
    float* out = a.out;
    const int gw = vcu * NWAVES + wave, NGW = G * NWAVES;
    const int hq = lane & 15;
    const f32x4 gqa = *(const f32x4*)(g_q_lat + lane * 8), gqb = *(const f32x4*)(g_q_lat + lane * 8 + 4), gqc = *(const f32x4*)(g_q_lat + 512 + lane * 8), gqd = *(const f32x4*)(g_q_lat + 512 + lane * 8 + 4);
    const f32x4 gka = *(const f32x4*)(g_kv_lat + lane * 8), gkb = *(const f32x4*)(g_kv_lat + lane * 8 + 4);
    const float* T16 = (const float*)(ws + WS_ROPE16); const float* g_mk = a.in[18];
    f32x4 gpa = (f32x4){0.f, 0.f, 0.f, 0.f}, gpb = gpa; if (lane < 8) { gpa = *(const f32x4*)(g_mk + 128 + lane * 8); gpb = *(const f32x4*)(g_mk + 128 + lane * 8 + 4); }
    const f32x4 ggqa = *(const f32x4*)(g_gq + hq * 8), ggqb = *(const f32x4*)(g_gq + hq * 8 + 4), ggka = *(const f32x4*)(g_gk + hq * 8), ggkb = *(const f32x4*)(g_gk + hq * 8 + 4);
    for (int t = gw; t < MTOK + NLAT * PAST; t += NGW) {
        if (t >= MTOK) {
            const int u = t - MTOK, b = u >> 8, s = u & 255; const size_t kr = (size_t)TP + (size_t)b * (PAST + LSEQ) + s;
            { const float* src = a.in[2] + (size_t)u * KVRANK + lane * 8; const f32x4 x0 = *(const f32x4*)src, x1 = *(const f32x4*)(src + 4);
              if (KVUP_I8) { const float xx[8] = {x0.x, x0.y, x0.z, x0.w, x1.x, x1.y, x1.z, x1.w}; store_row_i8(xx, (unsigned char*)CKV + kr * KVRANK, (float*)(ws + WS_CKVS) + kr, lane); }
              else if (KVUP_FP8) { const float xx[8] = {x0.x, x0.y, x0.z, x0.w, x1.x, x1.y, x1.z, x1.w}; *(v2u*)((unsigned char*)CKV + kr * KVRANK + lane * 8) = pack8_fp8x16(xx); }
              else { v4u w; w.x = pk2(x0.x, x0.y); w.y = pk2(x0.z, x0.w); w.z = pk2(x1.x, x1.y); w.w = pk2(x1.z, x1.w); *(v4u*)(CKV + kr * KVRANK + lane * 8) = w; } }
            if (KV_FUSE) { f32x4 x0 = (f32x4){0.f, 0.f, 0.f, 0.f}, x1 = x0; if (lane < 8) { const float* src = a.in[3] + (size_t)u * ROPED + lane * 8; x0 = *(const f32x4*)src; x1 = *(const f32x4*)(src + 4); }
              float ss = (x0.x * x0.x + x0.y * x0.y) + (x0.z * x0.z + x0.w * x0.w) + (x1.x * x1.x + x1.y * x1.y) + (x1.z * x1.z + x1.w * x1.w);
              ss = row16_sum(ss); if (lane == 0) ((float*)(ws + WS_KPESS))[kr] = ss;
              x0 *= gpa; x1 *= gpb;
              if (lane < 8) { v4u w; w.x = pk2(x0.x, x0.y); w.y = pk2(x0.z, x0.w); w.z = pk2(x1.x, x1.y); w.w = pk2(x1.z, x1.w); *(v4u*)(KPE + kr * ROPED + lane * 8) = w; } }
            else if (lane < 8) { const float* src = a.in[3] + (size_t)u * ROPED + lane * 8; const f32x4 x0 = *(const f32x4*)src, x1 = *(const f32x4*)(src + 4);
              v4u w; w.x = pk2(x0.x, x0.y); w.y = pk2(x0.z, x0.w); w.z = pk2(x1.x, x1.y); w.w = pk2(x1.z, x1.w); *(v4u*)(KPE + kr * ROPED + lane * 8) = w; }
            { const float* src = a.in[4] + (size_t)u * 512 + lane * 8; const f32x4 x0 = *(const f32x4*)src, x1 = *(const f32x4*)(src + 4);
              if (ATT_KF8) { const float xx[8] = {x0.x, x0.y, x0.z, x0.w, x1.x, x1.y, x1.z, x1.w}; *(v2u*)(GK8 + kr * 512 + lane * 8) = pack8_fp8s(xx, ATT_KS8); }
              else { v4u w; w.x = pk2(x0.x, x0.y); w.y = pk2(x0.z, x0.w); w.z = pk2(x1.x, x1.y); w.w = pk2(x1.z, x1.w); *(v4u*)(GK + kr * 512 + lane * 8) = w; } }
            { const float* src = a.in[5] + (size_t)u * 512 + lane * 8; const f32x4 x0 = *(const f32x4*)src, x1 = *(const f32x4*)(src + 4);
              v4u w; w.x = pk2(x0.x, x0.y); w.y = pk2(x0.z, x0.w); w.z = pk2(x1.x, x1.y); w.w = pk2(x1.z, x1.w); *(v4u*)(GV + kr * 512 + lane * 8) = w; }
            continue;
        }
        const bool prompt = t < TP; const size_t kr = (size_t)kvrow_of(t);
        const int spos = prompt ? 0 : ((t - TP) & 4095); const int prow = spos >> 6, pcol = spos & 63;
        const bf16* zq = Zq + (size_t)t * ZQW; const bf16* z = Zb + (size_t)t * ZBW;
        const v4u wq0 = *(const v4u*)(zq + ZQ + lane * 8), wq1 = *(const v4u*)(zq + ZQ + 512 + lane * 8);
        const v4u wkv = *(const v4u*)(z + ZKV + lane * 8), wgk = *(const v4u*)(z + ZGK + lane * 8), wgv = *(const v4u*)(z + ZGV + lane * 8);
        v4u wpe = (v4u){0u, 0u, 0u, 0u}; if (lane < 8) wpe = *(const v4u*)(z + ZPE + lane * 8);
        v4u wgq[4];
#pragma unroll
        for (int it = 0; it < 4; ++it) wgq[it] = *(const v4u*)(zq + ZGQ + it * 512 + lane * 8);
        float rc[8], rs[8];
        if (!prompt) { const int pos = (hq < 8) ? prow : pcol; const float* tp = T32 + (size_t)(pos * 32 + (hq & 3) * 8) * 2;
#pragma unroll
          for (int q = 0; q < 4; ++q) { const f32x4 cs = *(const f32x4*)(tp + 4 * q); rc[2 * q] = cs[0]; rc[2 * q + 1] = cs[2]; rs[2 * q] = (hq & 4) ? cs[1] : -cs[1]; rs[2 * q + 1] = (hq & 4) ? cs[3] : -cs[3]; } }
        { float x0[8], x1[8]; unpack8(wq0, x0); unpack8(wq1, x1); float ss = 0.f;
#pragma unroll
          for (int e = 0; e < 8; ++e) ss += x0[e] * x0[e] + x1[e] * x1[e];
          const float r = 1.0f / sqrtf(wave_sum_rl(ss) * (1.0f / QRANK) + EPS);
#pragma unroll
          for (int e = 0; e < 8; ++e) { x0[e] = x0[e] * r * (e < 4 ? gqa[e] : gqb[e - 4]); x1[e] = x1[e] * r * (e < 4 ? gqc[e] : gqd[e - 4]); }
          if (QUP_I8) { unsigned char* q8 = (unsigned char*)QN + (size_t)t * QRANK; v2u w0, w1;
#define Q8(x) ((unsigned)(int)__builtin_rintf(__builtin_amdgcn_fmed3f((x) * 16.f, -127.f, 127.f)) & 0xffu)
            w0.x = Q8(x0[0]) | (Q8(x0[1]) << 8) | (Q8(x0[2]) << 16) | (Q8(x0[3]) << 24); w0.y = Q8(x0[4]) | (Q8(x0[5]) << 8) | (Q8(x0[6]) << 16) | (Q8(x0[7]) << 24);
            w1.x = Q8(x1[0]) | (Q8(x1[1]) << 8) | (Q8(x1[2]) << 16) | (Q8(x1[3]) << 24); w1.y = Q8(x1[4]) | (Q8(x1[5]) << 8) | (Q8(x1[6]) << 16) | (Q8(x1[7]) << 24);
#undef Q8
            *(v2u*)(q8 + lane * 8) = w0; *(v2u*)(q8 + 512 + lane * 8) = w1; }
          else if (QUP_FP8) { unsigned char* q8 = (unsigned char*)QN + (size_t)t * QRANK; *(v2u*)(q8 + lane * 8) = pack8_fp8x16(x0); *(v2u*)(q8 + 512 + lane * 8) = pack8_fp8x16(x1); }
          else { *(v4u*)(QN + (size_t)t * QRANK + lane * 8) = pack8(x0); *(v4u*)(QN + (size_t)t * QRANK + 512 + lane * 8) = pack8(x1); } }
        { float x[8]; unpack8(wkv, x); float ss = 0.f;
#pragma unroll
          for (int e = 0; e < 8; ++e) ss += x[e] * x[e];
          const float r = 1.0f / sqrtf(wave_sum_rl(ss) * (1.0f / KVRANK) + EPS);
#pragma unroll
          for (int e = 0; e < 8; ++e) x[e] = x[e] * r * (e < 4 ? gka[e] : gkb[e - 4]);
          if (KVUP_I8) store_row_i8(x, (unsigned char*)CKV + kr * KVRANK, (float*)(ws + WS_CKVS) + kr, lane);
          else if (KVUP_FP8) *(v2u*)((unsigned char*)CKV + kr * KVRANK + lane * 8) = pack8_fp8x16(x); else *(v4u*)(CKV + kr * KVRANK + lane * 8) = pack8(x);
          if (prompt) { float* o = out + OUT_CKV + (size_t)t * KVRANK + lane * 8; *(f32x4*)o = (f32x4){x[0], x[1], x[2], x[3]}; *(f32x4*)(o + 4) = (f32x4){x[4], x[5], x[6], x[7]}; } }
        if (KV_FUSE) { float x[8]; unpack8(wpe, x);
          if (prompt && lane < 8) { float* o = out + OUT_KPE + (size_t)t * ROPED + lane * 8; *(f32x4*)o = (f32x4){x[0], x[1], x[2], x[3]}; *(f32x4*)(o + 4) = (f32x4){x[4], x[5], x[6], x[7]}; }
          float ss = 0.f;
#pragma unroll
          for (int e = 0; e < 8; ++e) ss += x[e] * x[e];
          ss = row16_sum(ss); if (lane == 0) ((float*)(ws + WS_KPESS))[kr] = ss;
#pragma unroll
          for (int e = 0; e < 8; ++e) x[e] *= (e < 4 ? gpa[e] : gpb[e - 4]);
          if (!prompt) { const int pos = (lane & 4) ? pcol : prow; const float* tp = T16 + (size_t)(pos * 16 + 8 * (lane & 1)) * 2;
#pragma unroll
            for (int q = 0; q < 4; ++q) { const f32x4 cs = *(const f32x4*)(tp + 4 * q);
#pragma unroll
              for (int h2 = 0; h2 < 2; ++h2) { const int e = 2 * q + h2; const float pa = dppx<0x112>(x[e]), pb = dppx<0x102>(x[e]); const float pr = (lane & 2) ? pa : pb;
                x[e] = x[e] * cs[2 * h2] + ((lane & 2) ? pr : -pr) * cs[2 * h2 + 1]; } } }
          if (lane < 8) *(v4u*)(KPE + kr * ROPED + lane * 8) = pack8(x); }
        else if (lane < 8) { *(v4u*)(KPE + kr * ROPED + lane * 8) = wpe;
          if (prompt) { float x[8]; unpack8(wpe, x); float* o = out + OUT_KPE + (size_t)t * ROPED + lane * 8; *(f32x4*)o = (f32x4){x[0], x[1], x[2], x[3]}; *(f32x4*)(o + 4) = (f32x4){x[4], x[5], x[6], x[7]}; } }
#pragma unroll
        for (int it = 0; it < 4; ++it) { float x[8]; unpack8(wgq[it], x); float ss = 0.f;
#pragma unroll
            for (int e = 0; e < 8; ++e) ss += x[e] * x[e];
            const float r = 1.0f / sqrtf(row16_sum(ss) * (1.0f / GHD) + EPS);
#pragma unroll
            for (int e = 0; e < 8; ++e) x[e] = x[e] * r * (e < 4 ? ggqa[e] : ggqb[e - 4]);
            if (!prompt) {
#pragma unroll
              for (int e = 0; e < 8; ++e) { const float pa = dppx<0x114>(x[e]), pb = dppx<0x104>(x[e]); const float p = (hq & 4) ? pa : pb;     x[e] = x[e] * rc[e] + p * rs[e]; } }
            if (GQ_FP8 && ATT_KF8) *(v2u*)((unsigned char*)GQ + (size_t)t * 2048 + it * 512 + lane * 8) = pack8_fp8s(x, att::q8_scale<128>());
            else *(v4u*)(GQ + (size_t)t * 2048 + it * 512 + lane * 8) = pack8(x); }
        { float x[8]; unpack8(wgk, x); float ss = 0.f;
#pragma unroll
          for (int e = 0; e < 8; ++e) ss += x[e] * x[e];
          const float r = 1.0f / sqrtf(row16_sum(ss) * (1.0f / GHD) + EPS);
#pragma unroll
          for (int e = 0; e < 8; ++e) x[e] = x[e] * r * (e < 4 ? ggka[e] : ggkb[e - 4]);
          if (prompt) { float* o = out + OUT_GK + (size_t)t * 512 + lane * 8; *(f32x4*)o = (f32x4){x[0], x[1], x[2], x[3]}; *(f32x4*)(o + 4) = (f32x4){x[4], x[5], x[6], x[7]}; }
          else {
#pragma unroll
            for (int e = 0; e < 8; ++e) { const float pa = dppx<0x114>(x[e]), pb = dppx<0x104>(x[e]); const float p = (hq & 4) ? pa : pb;     x[e] = x[e] * rc[e] + p * rs[e]; } }
          if (ATT_KF8) *(v2u*)(GK8 + kr * 512 + lane * 8) = pack8_fp8s(x, ATT_KS8);
          else *(v4u*)(GK + kr * 512 + lane * 8) = pack8(x); }
        { *(v4u*)(GV + kr * 512 + lane * 8) = wgv;
          if (prompt) { float x[8]; unpack8(wgv, x); float* o = out + OUT_GV + (size_t)t * 512 + lane * 8; *(f32x4*)o = (f32x4){x[0], x[1], x[2], x[3]}; *(f32x4*)(o + 4) = (f32x4){x[4], x[5], x[6], x[7]}; } }
    }
}
__device__ __forceinline__ void phase6(const Args& a, LAS unsigned char* lds, int vcu, int G) {
    const int tid = threadIdx.x, lane = tid & 63, wave = tid >> 6; unsigned char* ws = a.ws;
    bf16* KB = (bf16*)(ws + WS_KB); const bf16* KPE = (const bf16*)(ws + WS_KPE); const float* T16 = (const float*)(ws + WS_ROPE16); const float* gk = a.in[18];
    const int gw = vcu * NWAVES + wave, NGW = G * NWAVES; const int h = lane >> 2, q = lane & 3;
    float gn[32], gp[16];
#pragma unroll
    for (int e = 0; e < 32; ++e) gn[e] = gk[32 * q + e];
#pragma unroll
    for (int e = 0; e < 16; ++e) gp[e] = gk[128 + 16 * q + e];
    for (int kr = gw; kr < KVROWS; kr += NGW) {
        bool lat = false; int spos = 0;
        if (kr >= TP) { const int u = (kr - TP) % (PAST + LSEQ); if (u >= PAST) { lat = true; spos = u - PAST; } }
        bf16* kp = KB + ((size_t)kr * 16 + h) * 192; const bf16* pp = KPE + (size_t)kr * ROPED + 16 * q;
        f32x4 tq[8];
        if (lat) { const int pos = (q < 2) ? (spos >> 6) : (spos & 63); const float* tp = T16 + (size_t)pos * 32;
#pragma unroll
            for (int i = 0; i < 8; ++i) tq[i] = *(const f32x4*)(tp + 4 * i); }
        float xn[32], xp[16];
#pragma unroll
        for (int i = 0; i < 4; ++i) { float t8[8]; unpack8(*(const v4u*)(kp + 32 * q + 8 * i), t8);
#pragma unroll
            for (int e = 0; e < 8; ++e) xn[8 * i + e] = t8[e]; }
#pragma unroll
        for (int i = 0; i < 2; ++i) { float t8[8]; unpack8(*(const v4u*)(pp + 8 * i), t8);
#pragma unroll
            for (int e = 0; e < 8; ++e) xp[8 * i + e] = t8[e]; }
        float ss = 0.f;
#pragma unroll
        for (int e = 0; e < 32; ++e) ss += xn[e] * xn[e];
#pragma unroll
        for (int e = 0; e < 16; ++e) ss += xp[e] * xp[e];
        ss += dppx<0xB1>(ss); ss += dppx<0x4E>(ss);
        const float r = 1.0f / sqrtf(ss * (1.0f / MLAQK) + EPS);
#pragma unroll
        for (int e = 0; e < 32; ++e) xn[e] = xn[e] * r * gn[e];
#pragma unroll
        for (int e = 0; e < 16; ++e) xp[e] = xp[e] * r * gp[e];
        if (lat) {
#pragma unroll
            for (int e = 0; e < 16; ++e) { const float p = dppx<0xB1>(xp[e]); const float cs = tq[e >> 1][2 * (e & 1)], sn = tq[e >> 1][2 * (e & 1) + 1]; xp[e] = xp[e] * cs + ((q & 1) ? p : -p) * sn; } }
        if (ATT_KF8) { unsigned char* k8 = (unsigned char*)(ws + WS_K8) + ((size_t)kr * 16 + h) * 192; unsigned wn[8], wp[4];
#pragma unroll
            for (int i = 0; i < 8; ++i) { int tt = 0; tt = cvt_pk_fp8_sat(xn[4 * i] * ATT_KS8, xn[4 * i + 1] * ATT_KS8, tt, false); tt = cvt_pk_fp8_sat(xn[4 * i + 2] * ATT_KS8, xn[4 * i + 3] * ATT_KS8, tt, true); wn[i] = (unsigned)tt; }
#pragma unroll
            for (int i = 0; i < 4; ++i) { int tt = 0; tt = cvt_pk_fp8_sat(xp[4 * i] * ATT_KS8, xp[4 * i + 1] * ATT_KS8, tt, false); tt = cvt_pk_fp8_sat(xp[4 * i + 2] * ATT_KS8, xp[4 * i + 3] * ATT_KS8, tt, true); wp[i] = (unsigned)tt; }
            *(v4u*)(k8 + 32 * q) = (v4u){wn[0], wn[1], wn[2], wn[3]}; *(v4u*)(k8 + 32 * q + 16) = (v4u){wn[4], wn[5], wn[6], wn[7]}; *(v4u*)(k8 + 128 + 16 * q) = (v4u){wp[0], wp[1], wp[2], wp[3]};
        } else {
#pragma unroll
        for (int i = 0; i < 4; ++i) { float t8[8];
#pragma unroll
            for (int e = 0; e < 8; ++e) t8[e] = xn[8 * i + e];
            *(v4u*)(kp + 32 * q + 8 * i) = pack8(t8); }
#pragma unroll
        for (int i = 0; i < 2; ++i) { float t8[8];
#pragma unroll
            for (int e = 0; e < 8; ++e) t8[e] = xp[8 * i + e];
            *(v4u*)(kp + 128 + 16 * q + 8 * i) = pack8(t8); }
        }
    }
}
__device__ __forceinline__ void phase6_vt(const Args& a, LAS unsigned char* lds, int vcu, int G) {
    const int tid = threadIdx.x, lane = tid & 63, wave = __builtin_amdgcn_readfirstlane(tid >> 6); unsigned char* ws = a.ws;
    const bf16* VB = (const bf16*)(ws + WS_VB); const bf16* GV = (const bf16*)(ws + WS_GV); unsigned char* VT8 = ws + WS_VT8;
    LAS unsigned short* scr = (LAS unsigned short*)(lds + RING_OFF + wave * 16384);
    const int gw = vcu * NWAVES + wave, NGW = G * NWAVES;
    for (int it4 = gw; it4 < (KVROWS / 64) * 4; it4 += NGW) {
        const int T = it4 >> 2, hd = 16 + (it4 & 3), it = T * 20 + hd;
        const bf16* src = (hd < 16) ? VB + ((size_t)T * 64 * 16 + hd) * 128 : GV + ((size_t)T * 64 * 4 + (hd - 16)) * 128; const size_t rs = (hd < 16) ? 2048 : 512;
#pragma unroll 4
        for (int i = 0; i < 16; ++i) { const int row = 4 * i + (lane >> 4), c8 = (lane & 15) * 8; const v4u w = *(const v4u*)(src + (size_t)row * rs + c8); *(LAS v4u*)(scr + row * 128 + c8) = w; }
        LDS_WAIT(); asm volatile("" ::: "memory");
        unsigned char* dst = VT8 + (size_t)it * 10240;
#pragma unroll
        for (int cc = 0; cc < 2; ++cc) { const int c = lane + 64 * cc;
#pragma unroll
            for (int k4 = 0; k4 < 4; ++k4) { unsigned wd[4];
#pragma unroll
                for (int q4 = 0; q4 < 4; ++q4) { const int q = 4 * k4 + q4, hi2 = q >> 3, b0 = (4 * q) & 31; float v[4];
#pragma unroll
                    for (int j = 0; j < 4; ++j) { const int b = b0 + j, key = 32 * (b >> 4) + 8 * ((b & 15) >> 2) + 4 * hi2 + (b & 3); v[j] = __uint_as_float(((unsigned)scr[key * 128 + c]) << 16) * 32.f; }
                    int tt = 0; tt = cvt_pk_fp8_sat(v[0], v[1], tt, false); tt = cvt_pk_fp8_sat(v[2], v[3], tt, true); wd[q4] = (unsigned)tt; }
                *(v4u*)(dst + c * 80 + 16 * k4) = (v4u){wd[0], wd[1], wd[2], wd[3]}; } }
        LDS_WAIT(); asm volatile("" ::: "memory");
    }
}
__device__ __forceinline__ void phase7(const Args& a, LAS unsigned char* ldsl, char* lds, int vcu, int G) {
    unsigned char* ws = a.ws;
    constexpr long KES = ATT_KF8 ? 1 : 2;
    const char* VT8 = (const char*)(ws + WS_VT8); constexpr long VTS = 20 * 10240;
    const bf16* QRAW = (const bf16*)(ws + WS_QRAW); const char* KB = (const char*)(ws + (ATT_KF8 ? WS_K8 : WS_KB)); const bf16* VB = (const bf16*)(ws + WS_VB);
    const bf16* GQ = (const bf16*)(ws + WS_GQ); const char* GK = (const char*)(ws + WS_GK); const bf16* GV = (const bf16*)(ws + WS_GV);
    constexpr long MIXS = MIX_FP8 ? 1 : 2; constexpr long LDO = DM;
    bf16* MIX = (bf16*)(ws + WS_HB); const float* T16 = (const float*)(ws + WS_ROPE16); const float* gmq = a.in[17]; const float* sink = a.in[21];
    constexpr float NOSINK = -1e30f, L2E = 1.4426950408889634f;
    constexpr int U_ML = NLAT * MLAH * (LSEQ / 256), U_GL = NLAT * GKVH * (LSEQ / 128) * 2, U_MC = NPROMPT * MLAH, U_GC = NPROMPT * GQH;
#ifndef ATT_ONLY
#define ATT_ONLY 15
#endif
#define ATT_TID() int tid = threadIdx.x; asm volatile("" : "+v"(tid)); const int wave = __builtin_amdgcn_readfirstlane(tid >> 6), r32 = tid & 31
    if (ATT_ONLY & 1) for (int u = vcu; u < U_ML; u += G) {
        ATT_TID();
        const int qt = u & 15, h = (u >> 4) & 15, b = u >> 8; const int qpos = qt * 256 + wave * 32 + r32; const size_t trow = (size_t)TP + (size_t)b * LSEQ + qpos;
        const size_t kr0 = (size_t)TP + (size_t)b * (PAST + LSEQ);
        att::attn_body<192, true, false, MIX_FP8, ATT_KF8, ATT_VF8>(QRAW + trow * 3072 + h * 192, gmq, T16, qpos >> 6, qpos & 63, (const bf16*)(KB + (kr0 * 16 + h) * 192 * KES), 3072, ATT_VF8 ? (const bf16*)(VT8 + ((kr0 >> 6) * 20 + h) * 10240) : VB + (kr0 * 16 + h) * 128, ATT_VF8 ? VTS : 2048,
                                         0, (PAST + LSEQ) / 64, 0, 0, 0, 0, NOSINK, (bf16*)((char*)MIX + (((size_t)TP + (size_t)b * LSEQ + qt * 256 + wave * 32) * DM + h * 128) * MIXS), LDO, lds, ldsl, tid);
    }
    if (ATT_ONLY & 2) for (int v = vcu; v < U_GL; v += G) {
        ATT_TID();
        const int gp = v & 1, c = (v >> 1) & 31, n = (v >> 6) & 3, b = v >> 8; const int h = 4 * n + 2 * gp + (wave >> 2);
        const int q0 = 128 * c + 32 * (wave & 3), qi = q0 + r32; const size_t trow = (size_t)TP + (size_t)b * LSEQ + qi;
        const size_t kr0 = (size_t)TP + (size_t)b * (PAST + LSEQ);
        const int js = c > 0 ? 128 * (c - 1) : 0, je = (c < 31) ? 128 * (c + 2) : LSEQ;
        att::attn_body<128, false, true, MIX_FP8, ATT_KF8, ATT_VF8, (GQ_FP8 && ATT_KF8)>((GQ_FP8 && ATT_KF8) ? (const bf16*)((const unsigned char*)GQ + (trow * 16 + h) * 128) : GQ + (trow * 16 + h) * 128, nullptr, nullptr, 0, 0, (const bf16*)(GK + (kr0 * 4 + n) * 128 * KES), 512, ATT_VF8 ? (const bf16*)(VT8 + ((kr0 >> 6) * 20 + 16 + n) * 10240) : GV + (kr0 * 4 + n) * 128, ATT_VF8 ? VTS : 512,
                                         0, PAST / 64, PAST + js, (je - js) / 64, js, qi, sink[h] * L2E, (bf16*)((char*)MIX + (((size_t)TP + (size_t)b * LSEQ + q0) * DM + 2048 + h * 128) * MIXS), LDO, lds, ldsl, tid);
    }
    if (ATT_ONLY & 4) for (int v = vcu; v < U_MC; v += G) {
        ATT_TID();
        const int h = v & 15, p = v >> 4; const size_t trow = (size_t)p * SEQ + wave * 32 + r32; const size_t kr0 = (size_t)p * SEQ;
        att::attn_body<192, true, false, MIX_FP8, ATT_KF8, ATT_VF8>(QRAW + trow * 3072 + h * 192, gmq, nullptr, 0, 0, (const bf16*)(KB + (kr0 * 16 + h) * 192 * KES), 3072, ATT_VF8 ? (const bf16*)(VT8 + ((kr0 >> 6) * 20 + h) * 10240) : VB + (kr0 * 16 + h) * 128, ATT_VF8 ? VTS : 2048,
                                         0, SEQ / 64, 0, 0, 0, 0, NOSINK, (bf16*)((char*)MIX + (((size_t)p * SEQ + wave * 32) * DM + h * 128) * MIXS), LDO, lds, ldsl, tid);
    }
    if (ATT_ONLY & 8) for (int v = vcu; v < U_GC; v += G) {
        ATT_TID();
        const int h = v & 15, p = v >> 4; const size_t trow = (size_t)p * SEQ + wave * 32 + r32; const size_t kr0 = (size_t)p * SEQ;
        att::attn_body<128, false, false, MIX_FP8, ATT_KF8, ATT_VF8, (GQ_FP8 && ATT_KF8)>((GQ_FP8 && ATT_KF8) ? (const bf16*)((const unsigned char*)GQ + (trow * 16 + h) * 128) : GQ + (trow * 16 + h) * 128, nullptr, nullptr, 0, 0, (const bf16*)(GK + (kr0 * 4 + (h >> 2)) * 128 * KES), 512, ATT_VF8 ? (const bf16*)(VT8 + ((kr0 >> 6) * 20 + 16 + (h >> 2)) * 10240) : GV + (kr0 * 4 + (h >> 2)) * 128, ATT_VF8 ? VTS : 512,
                                          0, SEQ / 64, 0, 0, 0, 0, sink[h] * L2E, (bf16*)((char*)MIX + (((size_t)p * SEQ + wave * 32) * DM + 2048 + h * 128) * MIXS), LDO, lds, ldsl, tid);
    }
}
#undef ATT_TID
__device__ __forceinline__ void wup_convert_dyn(const Args& a, LAS unsigned char* lds, unsigned* ctr, unsigned lo, unsigned hi) {
    const int tid = threadIdx.x, lane = tid & 63, wave = __builtin_amdgcn_readfirstlane(tid >> 6); unsigned char* ws = a.ws;
    LAS float* scr = (LAS float*)(lds + RING_OFF + wave * 16384);
    for (;;) { unsigned it0 = 0; if (lane == 0) it0 = atomicAdd(ctr, 4u); it0 = lo + __builtin_amdgcn_readfirstlane(it0); if (it0 >= hi) break;
        for (unsigned it = it0; it < it0 + 4u && it < hi; ++it)
            p0_transpose_item_i8(a.in[23], DM, 22016, (signed char*)(ws + WS_WUP), MapUpPerm{(const unsigned*)(ws + WS_RANK)}, (const unsigned*)(ws + WS_COLMAX), (float*)(ws + WS_COLSC), scr, (int)it, lane); }
}
__device__ __forceinline__ void wqo_convert_dyn(const Args& a, LAS unsigned char* lds, unsigned* ctr) {
    const int tid = threadIdx.x, lane = tid & 63, wave = __builtin_amdgcn_readfirstlane(tid >> 6); unsigned char* ws = a.ws;
    LAS float* scr = (LAS float*)(lds + RING_OFF + wave * 16384);
    constexpr unsigned NQ = (QRANK / 64) * (3072 / 32), NO = (DM / 64) * (DM / 32);
    for (;;) { unsigned it0 = 0; if (lane == 0) it0 = atomicAdd(ctr, 4u); it0 = __builtin_amdgcn_readfirstlane(it0); if (it0 >= NQ + NO) break;
        for (unsigned it = it0; it < it0 + 4u && it < NQ + NO; ++it) {
            if (it < NQ) p0_transpose_item_fp8(a.in[14], QRANK, 3072, (unsigned char*)(ws + WS_WQUP), scr, (int)it, lane);
            else p0_transpose_item_fp8(a.in[22], DM, DM, (unsigned char*)(ws + WS_WOUT), scr, (int)(it - NQ), lane); } }
}
__device__ __forceinline__ void wdown_convert_dyn(const Args& a, LAS unsigned char* lds, unsigned* ctr) {
    const int tid = threadIdx.x, lane = tid & 63, wave = __builtin_amdgcn_readfirstlane(tid >> 6); unsigned char* ws = a.ws;
    LAS float* scr = (LAS float*)(lds + RING_OFF + wave * 16384); const unsigned* sigma = (const unsigned*)(ws + WS_SIGMA);
    constexpr unsigned NIT = (DFF / 64) * (DM / 32);
    for (;;) { unsigned it0 = 0; if (lane == 0) it0 = atomicAdd(ctr, 4u); it0 = __builtin_amdgcn_readfirstlane(it0); if (it0 >= NIT) break;
        for (unsigned it = it0; it < it0 + 4u && it < NIT; ++it) { const int k0 = 64 * (int)(it / (DM / 32));
            if (k0 < GK8) p0_transpose_item_fp8(a.in[26], GPB, DM, (unsigned char*)(ws + WS_WDOWN), scr, (int)it, lane, 0, sigma);
            else p0_transpose_item(a.in[26], GPB / 2, DM, (bf16*)(ws + WS_WDOWN) - GK8 / 2, MapId(), scr, (int)it, lane, sigma); } }
}
__device__ __forceinline__ void phase11(const Args& a, int vcu, int G) {
    const int tid = threadIdx.x; unsigned char* ws = a.ws;
    const float* edge = (const float*)(ws + WS_EDGE); bf16* Gb = (bf16*)(ws + WS_G); const float* cw = FFN_SORT ? (const float*)(ws + WS_CWP) : a.in[24];
    const int nrun = MTOK / 64; const size_t total = (size_t)nrun * 2 * (DFF / 4);
    for (size_t i = (size_t)vcu * NTHREADS + tid; i < total; i += (size_t)G * NTHREADS) {
        const int c4 = (int)(i % (DFF / 4)); const int rr = (int)(i / (DFF / 4)); const int rho = rr >> 1, last = rr & 1; const int c = c4 * 4;
        const int t = rho * 64 + (last ? 63 : 0); const int L = (t < TP) ? SEQ : LSEQ;
        const float* e = edge + ((size_t)rho * 4 + (last ? 2 : 0)) * 22016;
        f32x4 pg = *(const f32x4*)(e + c), pv = *(const f32x4*)(e + DFF + c);
        const bool has = last ? (((t + 1) % L) != 0) : ((t % L) != 0);
        if (has) { const float* ne = edge + ((size_t)(last ? rho + 1 : rho - 1) * 4 + (last ? 1 : 3)) * 22016; const float* w = cw + (last ? 2 * 22016 : 0);
            pg += *(const f32x4*)(w + c) * *(const f32x4*)(ne + c); pv += *(const f32x4*)(w + DFF + c) * *(const f32x4*)(ne + DFF + c); }
        auto gate = [](float a_, float b_) __attribute__((always_inline)) { return (TAP_FOLD && FFN_SORT) ? (a_ * __builtin_amdgcn_rcpf(1.0f + __builtin_amdgcn_exp2f(a_))) * b_ : silu_f(a_) * b_; };
        const float g0 = gate(pg.x, pv.x), g1 = gate(pg.y, pv.y), g2 = gate(pg.z, pv.z), g3 = gate(pg.w, pv.w);
        unsigned char* grow = (unsigned char*)Gb + (size_t)t * GPB; const float s8 = (TAP_FOLD && FFN_SORT) ? 1.0f : SG8;
        if (c < GK8) { int tt = 0; tt = cvt_pk_fp8_sat(g0 * s8, g1 * s8, tt, false); tt = cvt_pk_fp8_sat(g2 * s8, g3 * s8, tt, true); *(unsigned*)(grow + c) = (unsigned)tt; }
        else { v2u o; o.x = pk2(g0, g1); o.y = pk2(g2, g3); *(v2u*)(grow + GK8 + (size_t)(c - GK8) * 2) = o; }
    }
}

#ifndef LB2
#define LB2 2
#endif
__global__ void __launch_bounds__(NTHREADS, LB2) mk_fwd(Args args) {
    extern __shared__ __attribute__((aligned(16))) unsigned char lds_raw[];
    LAS unsigned char* lds = (LAS unsigned char*)lds_raw;
    volatile LAS unsigned* MISC = (volatile LAS unsigned*)(lds + MISC_OFF);
    const int tid = threadIdx.x;
    const int G = gridDim.x; const int bx = blockIdx.x; const int vcu = (G % 8 == 0) ? (bx % 8) * (G / 8) + bx / 8 : bx;
    unsigned char* ws = args.ws;
    unsigned* ctl = (unsigned*)(ws + WS_CTL);
    { int tz = tid; asm volatile("" : "+v"(tz));
      for (int u = tz; u < (LDS_BYTES - RING_BYTES) / 4; u += NTHREADS) ((LAS unsigned*)(lds + RING_BYTES))[u] = 0u; }
    __syncthreads();
    XcdBarrier bar; bar.bar = ctl + CW_BAR; bar.x = 0; bar.st = nullptr;
    if (MK_ONE_LAUNCH) bar = xcd_barrier_post(ctl + CW_BAR, MISC + 8);
    const int lo = args.ph_lo, hi = args.ph_hi;
#ifndef PH_MASK
#define PH_MASK 0x1fff
#endif
#define IN(k) (((PH_MASK >> (k)) & 1) && lo <= (k) && (k) < hi)
#ifndef DUP_MASK
#define DUP_MASK 0
#endif
#define DUPQ(k) ((DUP_MASK >> (k)) & 1)
#define SEAM(k) do { if (IN(k) && IN((k) + 1)) xcd_barrier(bar); } while (0)
    const float* mod = (const float*)(ws + WS_MOD);
    bf16* HB = (bf16*)(ws + WS_HB);
    float* Y = args.out + OUT_Y; bf16* X1 = (bf16*)(ws + WS_X1);

    auto run3 = [&]() __attribute__((always_inline)) {
        { pg8::Gemm g{HB, (const bf16*)(ws + WS_WIN), MTOK, ZBW, DM}; pg8::StaticOrder S; S.init(MTOK, ZBW, G, bx, W_P3B);
          pg8::EpiBf16 E{(bf16*)(ws + WS_ZB), ZBW, 1.0f};
          pg8::gemm_phase<pg8::EpiBf16, pg8::StaticOrder, GEMM_ALIGN, GEMM_SP2>(lds + RING_OFF, g, S, E); }
        __syncthreads();
        { pg8::Gemm g{(const bf16*)(ws + WS_H8), (const bf16*)(ws + WS_WINQ), MTOK, ZQW, DM / 2}; pg8::StaticOrder S; S.init(MTOK, ZQW, G, bx, W_P3Q);
          pg8::EpiBf16T<true> E{(bf16*)(ws + WS_Z), ZQW, 1.0f / 4096.0f};
          pg8::gemm_phase<pg8::EpiBf16T<true>, pg8::StaticOrder, GEMM_ALIGN, GEMM_SP2>(lds + RING_OFF, g, S, E); } };
    auto run5 = [&]() __attribute__((always_inline)) {
        { pg8::Gemm g{(const bf16*)(ws + WS_CKV), (const bf16*)(ws + WS_WKVUP), KVROWS, 4096, (KVUP_FP8 || KVUP_I8) ? KVRANK / 2 : KVRANK}; pg8::StaticOrder S; S.init(KVROWS, 4096, G, bx, W_P5K);
          if constexpr (KV_FUSE) { static_assert(!KV_FUSE || (KVUP_I8 && ATT_VF8 && ATT_KF8 && GEMM_ALIGN), "KV_FUSE needs the int8 kv-up GEMM, fp8 keys / V images and aligned epilogues");
            typedef pg8::EpiKVFuse<WS_K8, WS_VT8, WS_CKVS, WS_KVCS, WS_KPESS, WS_KPE> EKF;
            EKF E{ws, args.in[18], (LAS float*)(lds + RING_BYTES + 4096), ATT_KS8};
            pg8::gemm_phase<EKF, pg8::StaticOrder, GEMM_ALIGN, GEMM_SP2>(lds + RING_OFF, g, S, E); }
          else {
          typedef pg8::EpiKVT<ATT_VF8, KVUP_FP8 && !KVUP_I8, KVUP_I8> EKV;
          EKV E{(bf16*)(ws + WS_KB), (bf16*)(ws + WS_VB), ws + WS_VT8, (const float*)(ws + WS_CKVS), (const float*)(ws + WS_KVCS)};
          pg8::gemm_phase<EKV, pg8::StaticOrder, GEMM_ALIGN, GEMM_SP2>(lds + RING_OFF, g, S, E); } }
        __syncthreads();
        { pg8::Gemm g{(const bf16*)(ws + WS_QN), (const bf16*)(ws + WS_WQUP), MTOK, 3072, (QUP_FP8 || QUP_I8) ? QRANK / 2 : QRANK}; pg8::StaticOrder S; S.init(MTOK, 3072, G, bx, W_P5Q);
          pg8::EpiBf16T<QUP_FP8 && !QUP_I8, QUP_I8> E{(bf16*)(ws + WS_QRAW), 3072, QUP_I8 ? (1.0f / 16.0f) * (0.15875f / 127.0f) : (QUP_FP8 ? 1.0f / 4096.0f : 1.0f)};
          pg8::gemm_phase<pg8::EpiBf16T<QUP_FP8 && !QUP_I8, QUP_I8>, pg8::StaticOrder, GEMM_ALIGN, GEMM_SP2>(lds + RING_OFF, g, S, E); } };
    auto run8 = [&]() __attribute__((always_inline)) {
        pg8::Gemm g{HB, (const bf16*)(ws + WS_WOUT), MTOK, DM, MIX_FP8 ? DM / 2 : DM}; pg8::StaticOrder S; S.init(MTOK, DM, G, bx, W_P8);
        pg8::EpiResT<MIX_FP8, false, true> E{args.in[0], args.in[1], X1, mod + 2 * 4096, MIX_FP8 ? PROBE_GSCALE * (1.0f / 8192.0f) : PROBE_GSCALE, 1.0f};
        pg8::gemm_phase<pg8::EpiResT<MIX_FP8, false, true>, pg8::StaticOrder, GEMM_ALIGN, GEMM_SP2>(lds + RING_OFF, g, S, E); };
    auto run10 = [&]() __attribute__((always_inline)) {
        pg8::Gemm g{HB, (const bf16*)(ws + WS_WUP), MTOK, 22016, UP_I8 ? DM / 2 : DM}; pg8::StaticOrder S; S.init(MTOK, 22016, G, bx, W_P10);
        pg8::EpiUpT<(UP_I8 && !PROBE_UPF8), (TAP_FOLD && FFN_SORT)> E{(LAS float*)(lds + RING_BYTES + 4096), (unsigned char*)(ws + WS_G), FFN_SORT ? (const float*)(ws + WS_CWP) : args.in[24], FFN_SORT ? (const float*)(ws + WS_CBP) : args.in[25], (float*)(ws + WS_EDGE), GK8, GPB, SG8, (const float*)(ws + WS_ROWSC), (const float*)(ws + WS_COLSC)};
        pg8::gemm_phase<pg8::EpiUpT<(UP_I8 && !PROBE_UPF8), (TAP_FOLD && FFN_SORT)>, pg8::StaticOrder, GEMM_ALIGN, GEMM_SP2>(lds + RING_OFF, g, S, E); };
    auto run12 = [&]() __attribute__((always_inline)) {
        pg8::Gemm g{(const bf16*)(ws + WS_G), (const bf16*)(ws + WS_WDOWN), MTOK, DM, GPB / 2}; pg8::StaticOrder S; S.init(MTOK, DM, G, bx, W_P12);
        pg8::EpiResT<false, true, false, DOWN_NT8> E{X1, X1 + (size_t)TP * DM, Y, mod + 5 * 4096, PROBE_GSCALE2, 1.0f / (SG8 * SW8)};
        pg8::gemm_phase<pg8::EpiResT<false, true, false, DOWN_NT8>, pg8::StaticOrder, GEMM_ALIGN, GEMM_SP2>(lds + RING_OFF, g, S, E); };
    if (IN(0)) { phase0(args, lds, vcu, G); if (DUPQ(0)) { __syncthreads(); phase0(args, lds, vcu, G); } } SEAM(0);
    if (IN(1)) { phase1(args, lds, vcu, G); if (DUPQ(1)) phase1(args, lds, vcu, G); } SEAM(1);
    if (IN(2)) { phase_norm<false>(args.in[0], args.in[1], args.in[8], mod, 0, 4096, HB, (unsigned char*)(ws + WS_H8), nullptr, lds, vcu, G); if (DUPQ(2)) phase_norm<false>(args.in[0], args.in[1], args.in[8], mod, 0, 4096, HB, (unsigned char*)(ws + WS_H8), nullptr, lds, vcu, G); } SEAM(2);
    constexpr unsigned UP_ITEMS = (DM / 64) * (22016 / 32);
    if (IN(3)) { run3(); if (DUPQ(3)) { __syncthreads(); run3(); }
        if (UP_TAIL && UP_I8 && FFN_SORT) { __syncthreads(); wup_convert_dyn(args, lds, ctl + 16448, 0u, UPT_A); }
        if (W_TAIL3 && QUP_FP8 && !QUP_I8 && MIX_FP8) { __syncthreads(); wqo_convert_dyn(args, lds, ctl + 16640); } } SEAM(3);
    if (IN(4)) { phase4(args, vcu, G); if (DUPQ(4)) phase4(args, vcu, G); } SEAM(4);
    if (IN(5)) { run5(); if (DUPQ(5)) { __syncthreads(); run5(); }
        if (KV_FUSE && ATT_VF8 && ((PH_MASK >> 6) & 1)) { __syncthreads(); phase6_vt(args, lds, vcu, G); }
        if (UP_TAIL && UP_I8 && FFN_SORT) { __syncthreads(); wup_convert_dyn(args, lds, ctl + 16512, UPT_A, UPT_B); } }
    if (!KV_FUSE) SEAM(5);
    if (IN(6)) { if (!KV_FUSE) { phase6(args, lds, vcu, G); if (ATT_VF8) phase6_vt(args, lds, vcu, G); if (DUPQ(6)) { phase6(args, lds, vcu, G); if (ATT_VF8) phase6_vt(args, lds, vcu, G); } } } SEAM(6);
    if (IN(7)) { phase7(args, lds, (char*)lds_raw, vcu, G); if (DUPQ(7)) { __syncthreads(); phase7(args, lds, (char*)lds_raw, vcu, G); } } SEAM(7);
    if (IN(8)) { run8(); if (DUPQ(8)) { __syncthreads(); run8(); } } SEAM(8);
    if (IN(9)) { phase_norm<true>(X1, X1, args.in[9], mod, 3 * 4096, 4 * 4096, HB, UP_I8 ? (unsigned char*)HB : nullptr, UP_I8 ? (float*)(ws + WS_ROWSC) : nullptr, lds, vcu, G); if (DUPQ(9)) phase_norm<true>(X1, X1, args.in[9], mod, 3 * 4096, 4 * 4096, HB, UP_I8 ? (unsigned char*)HB : nullptr, UP_I8 ? (float*)(ws + WS_ROWSC) : nullptr, lds, vcu, G);
        if (UP_TAIL && UP_I8 && FFN_SORT) { __syncthreads(); wup_convert_dyn(args, lds, ctl + 16576, UPT_B, UP_ITEMS); } } SEAM(9);
    if (IN(10)) { run10(); if (DUPQ(10)) { __syncthreads(); run10(); }
        if (DOWN_TAIL && FFN_SORT) { __syncthreads(); wdown_convert_dyn(args, lds, ctl + 16384); } } SEAM(10);
    if (IN(11)) { phase11(args, vcu, G); if (DUPQ(11)) phase11(args, vcu, G); } SEAM(11);
    if (IN(12)) { run12(); if (DUPQ(12)) { __syncthreads(); run12(); } }
#undef IN
#undef SEAM
}

extern "C" void kernel_launch(void* const* d_in, const int* in_sizes, int n_in, void* d_out, int out_size, void* d_ws, size_t ws_size, hipStream_t stream) {
    static int grid = 0;
    if (grid == 0) {
        if (n_in != 27 || in_sizes[0] != TP * DM || in_sizes[1] != TL * DM || (size_t)out_size != OUT_END || ws_size < WS_END) {
            fprintf(stderr, "kernel_launch: shape mismatch: n_in %d in0 %d in1 %d out %d ws %zu (need >= %zu); nothing launched\n", n_in, n_in > 0 ? in_sizes[0] : -1, n_in > 1 ? in_sizes[1] : -1, out_size, ws_size, (size_t)WS_END); grid = -1; return; }
        int dev = 0, cus = 0, per_cu = 0;
        if (hipGetDevice(&dev) != hipSuccess || hipDeviceGetAttribute(&cus, hipDeviceAttributeMultiprocessorCount, dev) != hipSuccess) { fprintf(stderr, "kernel_launch: device query failed\n"); grid = -1; return; }
        if (hipFuncSetAttribute((const void*)mk_fwd, hipFuncAttributeMaxDynamicSharedMemorySize, LDS_BYTES) != hipSuccess) { fprintf(stderr, "kernel_launch: hipFuncSetAttribute failed\n"); grid = -1; return; }
        if (hipOccupancyMaxActiveBlocksPerMultiprocessor(&per_cu, (const void*)mk_fwd, NTHREADS, LDS_BYTES) != hipSuccess || per_cu < 1) { fprintf(stderr, "kernel_launch: occupancy query says %d blocks per CU\n", per_cu); }
        (void)hipGetLastError();
        grid = cus;
    }
    if (grid < 0) return;
    if (hipMemsetAsync((char*)d_ws + WS_CTL, 0, CTL_ZERO_BYTES, stream) != hipSuccess) { fprintf(stderr, "kernel_launch: memset failed\n"); return; }
    Args a{};
    for (int i = 0; i < 27; ++i) a.in[i] = (const float*)d_in[i];
    a.out = (float*)d_out; a.ws = (unsigned char*)d_ws;
#if MK_ONE_LAUNCH
    a.ph_lo = 0; a.ph_hi = N_PHASES;
    hipLaunchKernelGGL(mk_fwd, dim3(grid), dim3(NTHREADS), LDS_BYTES, stream, a);
#else
    for (int p = 0; p < N_PHASES; ++p) { a.ph_lo = p; a.ph_hi = p + 1; hipLaunchKernelGGL(mk_fwd, dim3(grid), dim3(NTHREADS), LDS_BYTES, stream, a); }
#endif
    const hipError_t le = hipPeekAtLastError();
    if (le != hipSuccess) fprintf(stderr, "kernel_launch: launch failed: %s\n", hipGetErrorName(le));
}
```

```cpp
#include <hip/hip_runtime.h>
#include <cstdio>
#include <cstdint>
__device__ __forceinline__ int cvt_pk_fp8_sat(float a, float b, int old, bool hi) { a = __builtin_amdgcn_fmed3f(a, -448.f, 448.f); b = __builtin_amdgcn_fmed3f(b, -448.f, 448.f); return hi ? __builtin_amdgcn_cvt_pk_fp8_f32(a, b, old, true) : __builtin_amdgcn_cvt_pk_fp8_f32(a, b, old, false); }
#ifndef PG8_WGM
#define PG8_WGM 8
#endif
namespace pg8 {
#define PG8_LAS __attribute__((address_space(3)))
typedef unsigned short bf16_t;
typedef short bf16x8 __attribute__((ext_vector_type(8)));
typedef float f32x4 __attribute__((ext_vector_type(4)));
typedef unsigned u32x4 __attribute__((ext_vector_type(4)));
constexpr int BM = 256, BK = 64, HALF = 128, HTB = HALF * BK * 2  , STAGE_BYTES = 8 * HTB, NXCD = 8, WGM = PG8_WGM;

__host__ __device__ __forceinline__ int lds_byte(int r, int c) { const int st = (r >> 4) * 2 + (c >> 5), rr = r & 15, cc = c & 31, ob = rr * 64 + cc * 2; return st * 1024 + (ob ^ (((ob >> 9) & 1) << 5)); }
__host__ __device__ __forceinline__ void stage_rc(int b, int& R, int& C) { const int st = b / 1024, sb = b % 1024, swz = sb ^ (((sb >> 9) & 1) << 5); R = (st >> 1) * 16 + swz / 64; C = (st & 1) * 32 + (swz % 64) / 2; }
__host__ __device__ __forceinline__ int perm32(int rho) { const int n = rho >> 4, i = rho & 15; return 8 * (i >> 2) + 4 * n + (i & 3); }

struct Unit { int pm, pn, slot; };
struct Gemm { const bf16_t* A; const bf16_t* Bt; int M, N, K; };

struct StaticOrder {
    int nM, nN, nwg, G, c, wgm;
    __host__ __device__ void init(int M, int N, int G_, int c_, int wgm_ = WGM) { nM = M / BM; nN = N / BM; nwg = nM * nN; G = G_; c = c_; wgm = wgm_; }
    __host__ __device__ bool next(int i, Unit& u) const {
        const long L = (long)i * G + c; if (L >= nwg) return false;
        int wgid = (int)L; { const int q = nwg / NXCD, r = nwg % NXCD, xcd = wgid % NXCD, off = wgid / NXCD; wgid = (xcd < r ? xcd * (q + 1) : r * (q + 1) + (xcd - r) * q) + off; }
        const int nig = wgm * nN, gid = wgid / nig, fm = gid * wgm, gsz = (nM - fm) < wgm ? (nM - fm) : wgm;
        u.pm = fm + ((wgid % nig) % gsz); u.pn = (wgid % nig) / gsz; return true;
    }
    __device__ __forceinline__ void a_ready(const Unit&) const {}
    __device__ __forceinline__ void done(const Unit&) const {}
};

__device__ __forceinline__ unsigned cvt_pk_bf16(float lo, float hi) { unsigned r; asm volatile("v_cvt_pk_bf16_f32 %0, %1, %2" : "=v"(r) : "v"(lo), "v"(hi)); return r; }
#ifndef PROBE_QPERMA
#define PROBE_QPERMA false
#endif
template <bool F8, bool I8_ = false> struct EpiBf16T {
    static constexpr bool PERM = true, AFTER_DRAIN = false, PERMA = I8_ && PROBE_QPERMA, FP8 = F8; static constexpr int NT8 = 0; static constexpr bool I8 = I8_;
    bf16_t* O; int ldc; float scale;
    __device__ __forceinline__ void operator()(const f32x4 (&acc)[2][2][4][2], const Unit& u, int wr, int wc, int fr, int fq) const {
        const int row0 = u.pm * BM + wr * 64, col0 = u.pn * BM + wc * 32 + 8 * fq;
#pragma unroll
        for (int ai = 0; ai < 2; ++ai)
#pragma unroll
            for (int m = 0; m < 4; ++m) { bf16_t* rowp = O + (size_t)(row0 + ai * HALF + (PERMA ? 4 * fr + m : m * 16 + fr)) * ldc + col0;
#pragma unroll
                for (int bj = 0; bj < 2; ++bj) { f32x4 v0, v1;
                    if constexpr (I8) { typedef int i32x4_ __attribute__((ext_vector_type(4))); v0 = __builtin_convertvector(__builtin_bit_cast(i32x4_, acc[ai][bj][m][0]), f32x4) * scale; v1 = __builtin_convertvector(__builtin_bit_cast(i32x4_, acc[ai][bj][m][1]), f32x4) * scale; }
                    else { v0 = acc[ai][bj][m][0] * scale; v1 = acc[ai][bj][m][1] * scale; }
                    u32x4 w; w.x = cvt_pk_bf16(v0[0], v0[1]); w.y = cvt_pk_bf16(v0[2], v0[3]); w.z = cvt_pk_bf16(v1[0], v1[1]); w.w = cvt_pk_bf16(v1[2], v1[3]);
                    *(u32x4*)(rowp + bj * HALF) = w; } }
    }
};
typedef EpiBf16T<false> EpiBf16;
template <bool VIMG, bool F8 = false, bool I8_ = false> struct EpiKVT {
    static constexpr bool PERM = true, AFTER_DRAIN = false, PERMA = VIMG, FP8 = F8; static constexpr int NT8 = 0; static constexpr bool I8 = I8_;
    bf16_t* Kb; bf16_t* Vb; unsigned char* Vt8; const float* rowscale; const float* colscale;
    __device__ __forceinline__ void operator()(const f32x4 (&accr)[2][2][4][2], const Unit& u, int wr, int wc, int fr, int fq) const {
        const int col0 = wc * 32 + 8 * fq;
        f32x4 acc[2][2][4][2];
        if constexpr (I8) { typedef int i32x4_ __attribute__((ext_vector_type(4))); f32x4 cs[2][2];
#pragma unroll
            for (int bj = 0; bj < 2; ++bj)
#pragma unroll
                for (int n = 0; n < 2; ++n) cs[bj][n] = *(const f32x4*)(colscale + u.pn * 256 + bj * 128 + col0 + 4 * n);
#pragma unroll
            for (int ai = 0; ai < 2; ++ai)
#pragma unroll
                for (int m = 0; m < 4; ++m) { const float rs = rowscale[(size_t)(u.pm * BM + ai * HALF + wr * 64 + (VIMG ? 4 * fr + m : 16 * m + fr))];
#pragma unroll
                    for (int bj = 0; bj < 2; ++bj)
#pragma unroll
                        for (int n = 0; n < 2; ++n) acc[ai][bj][m][n] = __builtin_convertvector(__builtin_bit_cast(i32x4_, accr[ai][bj][m][n]), f32x4) * (cs[bj][n] * rs); } }
        else {
#pragma unroll
            for (int ai = 0; ai < 2; ++ai)
#pragma unroll
                for (int bj = 0; bj < 2; ++bj)
#pragma unroll
                    for (int m = 0; m < 4; ++m)
#pragma unroll
                        for (int n = 0; n < 2; ++n) acc[ai][bj][m][n] = accr[ai][bj][m][n]; }
#pragma unroll
        for (int ai = 0; ai < 2; ++ai) {
#pragma unroll
            for (int m = 0; m < 4; ++m) { const size_t row = (size_t)(u.pm * BM + ai * HALF + wr * 64 + (VIMG ? 4 * fr + m : 16 * m + fr));
                { const f32x4 v0 = acc[ai][0][m][0] * (F8 ? 1.0f / 4096.0f : 1.0f), v1 = acc[ai][0][m][1] * (F8 ? 1.0f / 4096.0f : 1.0f); u32x4 w; w.x = cvt_pk_bf16(v0[0], v0[1]); w.y = cvt_pk_bf16(v0[2], v0[3]); w.z = cvt_pk_bf16(v1[0], v1[1]); w.w = cvt_pk_bf16(v1[2], v1[3]);
                  *(u32x4*)(Kb + row * 3072 + u.pn * 192 + col0) = w; }
                if constexpr (!VIMG) { const f32x4 v0 = acc[ai][1][m][0] * (F8 ? 1.0f / 4096.0f : 1.0f), v1 = acc[ai][1][m][1] * (F8 ? 1.0f / 4096.0f : 1.0f); u32x4 w; w.x = cvt_pk_bf16(v0[0], v0[1]); w.y = cvt_pk_bf16(v0[2], v0[3]); w.z = cvt_pk_bf16(v1[0], v1[1]); w.w = cvt_pk_bf16(v1[2], v1[3]);
                  *(u32x4*)(Vb + row * 2048 + u.pn * 128 + col0) = w; } }
            if constexpr (VIMG) { const int T = u.pm * 4 + ai * 2 + wr;
                unsigned char* img = Vt8 + ((size_t)T * 20 + u.pn) * 10240 + (fr & 1) * 32 + (fr >> 3) * 16 + ((fr >> 1) & 3) * 4;
#pragma unroll
                for (int n = 0; n < 2; ++n)
#pragma unroll
                    for (int j = 0; j < 4; ++j) { int t = 0; constexpr float vs = F8 ? 32.f / 4096.f : 32.f; t = cvt_pk_fp8_sat(acc[ai][1][0][n][j] * vs, acc[ai][1][1][n][j] * vs, t, false); t = cvt_pk_fp8_sat(acc[ai][1][2][n][j] * vs, acc[ai][1][3][n][j] * vs, t, true);
                        *(unsigned*)(img + (col0 + 4 * n + j) * 80) = (unsigned)t; } }
        }
    }
};
template <size_t O_K8, size_t O_VT8, size_t O_ROWSC, size_t O_COLSC, size_t O_KPESS, size_t O_KPER>
struct EpiKVFuse {
    static constexpr bool PERM = true, AFTER_DRAIN = false, PERMA = true, FP8 = false; static constexpr int NT8 = 0; static constexpr bool I8 = true;
    unsigned char* wsb; const float* gk; PG8_LAS float* part; float ks8;
    static constexpr bool PREFETCH = true;
    __device__ __forceinline__ void prefetch(const Unit& u, int wid, int lane) const {
        if (wid < 4) { const float* src = wid == 0 ? (const float*)(wsb + O_ROWSC) + u.pm * BM + lane * 4 : (wid == 1 ? (const float*)(wsb + O_COLSC) + u.pn * 256 + lane * 4 : (wid == 2 ? (const float*)(wsb + O_KPESS) + u.pm * BM + lane * 4 : gk + (lane & 31) * 4));
            __builtin_amdgcn_global_load_lds((const unsigned*)src, (PG8_LAS unsigned*)(part + 1024 + u.slot * 1024 + wid * 256), 16, 0, 0); }
    }
    __device__ __forceinline__ void operator()(const f32x4 (&accr)[2][2][4][2], const Unit& u, int wr, int wc, int fr, int fq) const {
        typedef int i32x4_ __attribute__((ext_vector_type(4))); typedef unsigned u32x2k __attribute__((ext_vector_type(2)));
        unsigned char* K8 = wsb + O_K8; unsigned char* Vt8 = wsb + O_VT8; const PG8_LAS float* P = part + 1024 + u.slot * 1024;
        const bf16_t* kper = (const bf16_t*)(wsb + O_KPER);
        const int col0 = wc * 32 + 8 * fq;
        f32x4 cs[2][2]; float rsv[2][4];
#pragma unroll
        for (int bj = 0; bj < 2; ++bj)
#pragma unroll
            for (int n = 0; n < 2; ++n) cs[bj][n] = *(const PG8_LAS f32x4*)(P + 256 + bj * 128 + col0 + 4 * n);
#pragma unroll
        for (int ai = 0; ai < 2; ++ai)
#pragma unroll
            for (int m = 0; m < 4; ++m) rsv[ai][m] = P[ai * HALF + wr * 64 + 4 * fr + m];
#pragma unroll
        for (int ai = 0; ai < 2; ++ai) { const int T = u.pm * 4 + ai * 2 + wr;
            unsigned char* img = Vt8 + ((size_t)T * 20 + u.pn) * 10240 + (fr & 1) * 32 + (fr >> 3) * 16 + ((fr >> 1) & 3) * 4;
#pragma unroll
            for (int n = 0; n < 2; ++n) { f32x4 vv[4];
#pragma unroll
                for (int m = 0; m < 4; ++m) vv[m] = __builtin_convertvector(__builtin_bit_cast(i32x4_, accr[ai][1][m][n]), f32x4) * (cs[1][n] * (rsv[ai][m] * 32.f));
#pragma unroll
                for (int j = 0; j < 4; ++j) { int t = 0; t = cvt_pk_fp8_sat(vv[0][j], vv[1][j], t, false); t = cvt_pk_fp8_sat(vv[2][j], vv[3][j], t, true);
                    *(unsigned*)(img + (col0 + 4 * n + j) * 80) = (unsigned)t; } } }
        f32x4 kf[2][4][2]; float ssq[2][4];
#pragma unroll
        for (int ai = 0; ai < 2; ++ai)
#pragma unroll
            for (int m = 0; m < 4; ++m) { float s_ = 0.f;
#pragma unroll
                for (int n = 0; n < 2; ++n) { const f32x4 k4 = __builtin_convertvector(__builtin_bit_cast(i32x4_, accr[ai][0][m][n]), f32x4) * (cs[0][n] * rsv[ai][m]); kf[ai][m][n] = k4;
                    s_ += (k4[0] * k4[0] + k4[1] * k4[1]) + (k4[2] * k4[2] + k4[3] * k4[3]); }
                s_ += __shfl_xor(s_, 16); s_ += __shfl_xor(s_, 32); ssq[ai][m] = s_; }
        if (fq == 0) {
#pragma unroll
            for (int ai = 0; ai < 2; ++ai)
#pragma unroll
                for (int m = 0; m < 4; ++m) part[((wr * 2 + ai) * 64 + 4 * fr + m) * 4 + wc] = ssq[ai][m]; }
        u32x2k kw[2][4];
#pragma unroll
        for (int ai = 0; ai < 2; ++ai)
#pragma unroll
            for (int m = 0; m < 4; ++m) kw[ai][m] = *(const u32x2k*)(kper + (size_t)(u.pm * BM + ai * HALF + wr * 64 + 4 * fr + m) * 64 + wc * 16 + fq * 4);
        asm volatile("s_waitcnt lgkmcnt(0)" ::: "memory"); __builtin_amdgcn_s_barrier(); asm volatile("" ::: "memory");
        const f32x4 g0 = *(const PG8_LAS f32x4*)(P + 768 + col0), g1 = *(const PG8_LAS f32x4*)(P + 768 + col0 + 4);
#pragma unroll
        for (int ai = 0; ai < 2; ++ai)
#pragma unroll
            for (int m = 0; m < 4; ++m) { const size_t row = (size_t)(u.pm * BM + ai * HALF + wr * 64 + 4 * fr + m);
                const f32x4 pp = *(const PG8_LAS f32x4*)(part + ((wr * 2 + ai) * 64 + 4 * fr + m) * 4);
                const float ss = ((pp[0] + pp[1]) + (pp[2] + pp[3])) + P[512 + ai * HALF + wr * 64 + 4 * fr + m]; const float r = ks8 / sqrtf(ss * (1.0f / 192.0f) + 1e-6f);
                unsigned char* kd = K8 + (row * 16 + u.pn) * 192;
                const f32x4 v0 = kf[ai][m][0] * (g0 * r), v1 = kf[ai][m][1] * (g1 * r); int t0 = 0, t1 = 0;
                t0 = cvt_pk_fp8_sat(v0[0], v0[1], t0, false); t0 = cvt_pk_fp8_sat(v0[2], v0[3], t0, true); t1 = cvt_pk_fp8_sat(v1[0], v1[1], t1, false); t1 = cvt_pk_fp8_sat(v1[2], v1[3], t1, true);
                *(u32x2k*)(kd + col0) = (u32x2k){(unsigned)t0, (unsigned)t1};
                const u32x2k w = kw[ai][m]; int t2 = 0;
                t2 = cvt_pk_fp8_sat(__uint_as_float(w.x << 16) * r, __uint_as_float(w.x & 0xffff0000u) * r, t2, false); t2 = cvt_pk_fp8_sat(__uint_as_float(w.y << 16) * r, __uint_as_float(w.y & 0xffff0000u) * r, t2, true);
                *(unsigned*)(kd + 128 + wc * 16 + fq * 4) = (unsigned)t2; }
    }
};
template <bool F8, bool BB, bool OB, int NT8_ = 0> struct EpiResT {
    static constexpr bool PERM = true, AFTER_DRAIN = false, PERMA = false, FP8 = F8; static constexpr int NT8 = NT8_; static constexpr bool I8 = false;
    __device__ __forceinline__ float mix_rescale() const { return mixrs; }
    const void* base_p; const void* base_s; void* out; const float* gate; float gscale; float mixrs;
    __device__ __forceinline__ void operator()(const f32x4 (&acc)[2][2][4][2], const Unit& u, int wr, int wc, int fr, int fq) const {
        const int mr = u.pm < 16 ? 8 : ((u.pm - 16) >> 4);
        const int col0 = u.pn * BM + wc * 32 + 8 * fq;
        const float* gp = gate + (size_t)mr * 24576 + col0;
        f32x4 gv[2][2];
#pragma unroll
        for (int bj = 0; bj < 2; ++bj)
#pragma unroll
            for (int n = 0; n < 2; ++n) gv[bj][n] = *(const f32x4*)(gp + bj * HALF + n * 4) * gscale;
        const int rt = u.pm * BM + wr * 64 + fr;
        const size_t rb = (u.pm < 16) ? (size_t)rt : (size_t)(rt - 4096);
        const char* bb = (const char*)((u.pm < 16) ? base_p : base_s) + rb * 4096 * (BB ? 2 : 4);
        char* ob = (char*)out + (size_t)rt * 4096 * (OB ? 2 : 4);
#pragma unroll
        for (int ai = 0; ai < 2; ++ai)
#pragma unroll
            for (int m = 0; m < 4; ++m) { const size_t off = (size_t)(ai * HALF + m * 16) * 4096 + col0;
#pragma unroll
                for (int bj = 0; bj < 2; ++bj) { f32x4 b0, b1;
                    if constexpr (BB) { const u32x4 w = *(const u32x4*)(bb + (off + bj * HALF) * 2);
                        b0 = (f32x4){__uint_as_float(w.x << 16), __uint_as_float(w.x & 0xffff0000u), __uint_as_float(w.y << 16), __uint_as_float(w.y & 0xffff0000u)};
                        b1 = (f32x4){__uint_as_float(w.z << 16), __uint_as_float(w.z & 0xffff0000u), __uint_as_float(w.w << 16), __uint_as_float(w.w & 0xffff0000u)}; }
                    else { b0 = *(const f32x4*)(bb + (off + bj * HALF) * 4); b1 = *(const f32x4*)(bb + (off + bj * HALF) * 4 + 16); }
                    const f32x4 o0 = b0 + gv[bj][0] * acc[ai][bj][m][0], o1 = b1 + gv[bj][1] * acc[ai][bj][m][1];
                    if constexpr (OB) { u32x4 w; w.x = cvt_pk_bf16(o0[0], o0[1]); w.y = cvt_pk_bf16(o0[2], o0[3]); w.z = cvt_pk_bf16(o1[0], o1[1]); w.w = cvt_pk_bf16(o1[2], o1[3]); *(u32x4*)(ob + (off + bj * HALF) * 2) = w; }
                    else { *(f32x4*)(ob + (off + bj * HALF) * 4) = o0; *(f32x4*)(ob + (off + bj * HALF) * 4 + 16) = o1; } }
                asm volatile("" ::: "memory"); }
    }
};
__device__ __forceinline__ float dpp_from_prev_lane(float v) { return __builtin_bit_cast(float, __builtin_amdgcn_update_dpp(0, __builtin_bit_cast(int, v), 0x111, 0xf, 0xf, true)); }
__device__ __forceinline__ float dpp_from_next_lane(float v) { return __builtin_bit_cast(float, __builtin_amdgcn_update_dpp(0, __builtin_bit_cast(int, v), 0x101, 0xf, 0xf, true)); }
#ifndef PROBE_UPF8
#define PROBE_UPF8 false
#endif
template <bool I8_, bool FOLD = false> struct EpiUpT {
    static constexpr bool PERM = true, AFTER_DRAIN = false, PERMA = true, FP8 = PROBE_UPF8; static constexpr int NT8 = 0; static constexpr bool I8 = I8_;
    static constexpr bool PREFETCH = true;
    PG8_LAS float* prm;
    __device__ __forceinline__ void prefetch(const Unit& u, int wid, int lane) const {
        if (wid < (I8 ? 6 : 4)) { const int ci = (lane < 32) ? u.pn * 128 + lane * 4 : 11008 + u.pn * 128 + (lane - 32) * 4;
            const float* src = wid < 3 ? cw + wid * 22016 + ci : (wid == 3 ? cb + ci : (wid == 4 ? colscale + u.pn * 256 + lane * 4 : rowscale + u.pm * BM + lane * 4));
            __builtin_amdgcn_global_load_lds((const unsigned*)src, (PG8_LAS unsigned*)(prm + u.slot * 1536 + wid * 256), 16, 0, 0); }
    }
    unsigned char* G; const float* cw; const float* cb; float* edge; int k8; int gpb; float sg; const float* rowscale; const float* colscale;
    __device__ __forceinline__ void operator()(const f32x4 (&acc)[2][2][4][2], const Unit& u, int wr, int wc, int fr, int fq) const {
        const int colg = u.pn * 128 + wc * 32 + 8 * fq;
        const bool g8 = u.pn * 128 < k8;
        unsigned gw[2][4][4]; int gw8[2][4][2];
        f32x4 rs4[2] = {(f32x4){1.f, 1.f, 1.f, 1.f}, (f32x4){1.f, 1.f, 1.f, 1.f}};
        const PG8_LAS float* P = prm + u.slot * 1536;
        if constexpr (I8) { rs4[0] = *(const PG8_LAS f32x4*)(P + 1280 + wr * 64 + 4 * fr); rs4[1] = *(const PG8_LAS f32x4*)(P + 1280 + HALF + wr * 64 + 4 * fr); }
#pragma unroll
        for (int n = 0; n < 2; ++n) {
            f32x4 W0[2], W1[2], W2[2], Bv[2], cs4[2];
#pragma unroll
            for (int bj = 0; bj < 2; ++bj) { const int uc = bj * 11008 + colg + 4 * n;
                const int pe = bj * 128 + wc * 32 + 8 * fq + 4 * n;
                W0[bj] = *(const PG8_LAS f32x4*)(P + pe); W1[bj] = *(const PG8_LAS f32x4*)(P + 256 + pe); W2[bj] = *(const PG8_LAS f32x4*)(P + 512 + pe); Bv[bj] = *(const PG8_LAS f32x4*)(P + 768 + pe);
                cs4[bj] = (f32x4){1.f, 1.f, 1.f, 1.f};
                if constexpr (I8) { cs4[bj] = *(const PG8_LAS f32x4*)(P + 1024 + pe); W0[bj] *= cs4[bj]; W1[bj] *= cs4[bj]; W2[bj] *= cs4[bj]; } }
#pragma unroll
            for (int ai = 0; ai < 2; ++ai) {
                const int rho = u.pm * 4 + ai * 2 + wr;
                float* e0 = edge + ((size_t)rho * 4 + 0) * 22016;
                f32x4 Pf[2], Pl[2], Uf[2], Ul[2];
                f32x4 uv[2][4];
#pragma unroll
                for (int bj = 0; bj < 2; ++bj)
#pragma unroll
                    for (int m = 0; m < 4; ++m) {
                        if constexpr (I8) { typedef int i32x4_ __attribute__((ext_vector_type(4))); uv[bj][m] = __builtin_convertvector(__builtin_bit_cast(i32x4_, acc[ai][bj][m][n]), f32x4) * rs4[ai][m]; }
                        else uv[bj][m] = acc[ai][bj][m][n] * (FP8 ? (1.0f / 4096.0f) : 1.0f); }
                f32x4 Cc[2][4];
#pragma unroll
                for (int bj = 0; bj < 2; ++bj) {
                    const f32x4 U0 = uv[bj][0], U1 = uv[bj][1], U2 = uv[bj][2], U3 = uv[bj][3];
                    f32x4 pv, nx;
#pragma unroll
                    for (int j = 0; j < 4; ++j) { pv[j] = dpp_from_prev_lane(U3[j]); nx[j] = dpp_from_next_lane(U0[j]); }
                    Uf[bj] = U0; Ul[bj] = U3;
                    Cc[bj][0] = W1[bj] * U0 + (W0[bj] * pv + (W2[bj] * U1 + Bv[bj]));
                    Cc[bj][1] = W1[bj] * U1 + (W0[bj] * U0 + (W2[bj] * U2 + Bv[bj]));
                    Cc[bj][2] = W1[bj] * U2 + (W0[bj] * U1 + (W2[bj] * U3 + Bv[bj]));
                    Cc[bj][3] = W1[bj] * U3 + (W0[bj] * U2 + (W2[bj] * nx + Bv[bj]));
                    Pf[bj] = Cc[bj][0]; Pl[bj] = Cc[bj][3];
                }
#pragma unroll
                for (int m = 0; m < 4; ++m) { const f32x4 av = Cc[0][m], bv = Cc[1][m]; const f32x4 ea = FOLD ? av : av * (-1.4426950408889634f); f32x4 sv;
#pragma unroll
                    for (int j = 0; j < 4; ++j) sv[j] = __builtin_amdgcn_rcpf(1.0f + __builtin_amdgcn_exp2f(ea[j]));
                    const f32x4 gv4 = (av * sv) * bv;
                    if (g8) { const f32x4 gs = FOLD ? gv4 : gv4 * sg; int t = 0; t = cvt_pk_fp8_sat(gs[0], gs[1], t, false); t = cvt_pk_fp8_sat(gs[2], gs[3], t, true); gw8[ai][m][n] = t; }
                    else { gw[ai][m][n * 2] = cvt_pk_bf16(gv4[0], gv4[1]); gw[ai][m][n * 2 + 1] = cvt_pk_bf16(gv4[2], gv4[3]); } }
                if (fr == 0) {
#pragma unroll
                    for (int bj = 0; bj < 2; ++bj) { const int uc = bj * 11008 + colg + 4 * n; *(f32x4*)(e0 + uc) = Pf[bj]; *(f32x4*)(e0 + 22016 + uc) = Uf[bj] * cs4[bj]; } }
                if (fr == 15) {
#pragma unroll
                    for (int bj = 0; bj < 2; ++bj) { const int uc = bj * 11008 + colg + 4 * n; *(f32x4*)(e0 + 2 * 22016 + uc) = Pl[bj]; *(f32x4*)(e0 + 3 * 22016 + uc) = Ul[bj] * cs4[bj]; } }
            }
        }
#pragma unroll
        for (int ai = 0; ai < 2; ++ai) {
            const int row0 = u.pm * BM + ai * HALF + wr * 64 + 4 * fr;
#pragma unroll
            for (int m = 0; m < 4; ++m) { unsigned char* grow = G + (size_t)(row0 + m) * gpb;
                if (g8) { typedef unsigned u32x2 __attribute__((ext_vector_type(2))); *(u32x2*)(grow + colg) = (u32x2){(unsigned)gw8[ai][m][0], (unsigned)gw8[ai][m][1]}; }
                else { u32x4 w; w.x = gw[ai][m][0]; w.y = gw[ai][m][1]; w.z = gw[ai][m][2]; w.w = gw[ai][m][3]; *(u32x4*)(grow + k8 + (size_t)(colg - k8) * 2) = w; } }
        }
    }
};

typedef int pg8_v8i __attribute__((ext_vector_type(8)));
__device__ __forceinline__ pg8_v8i pg8_cat(bf16x8 a, bf16x8 b) { typedef short s16 __attribute__((ext_vector_type(16))); const s16 c = __builtin_shufflevector(a, b, 0, 1, 2, 3, 4, 5, 6, 7, 8, 9, 10, 11, 12, 13, 14, 15); return __builtin_bit_cast(pg8_v8i, c); }
__device__ __forceinline__ bf16x8 pg8_lo(pg8_v8i v) { typedef int v4i_ __attribute__((ext_vector_type(4))); return __builtin_bit_cast(bf16x8, (v4i_)__builtin_shufflevector(v, v, 0, 1, 2, 3)); }
__device__ __forceinline__ bf16x8 pg8_hi(pg8_v8i v) { typedef int v4i_ __attribute__((ext_vector_type(4))); return __builtin_bit_cast(bf16x8, (v4i_)__builtin_shufflevector(v, v, 4, 5, 6, 7)); }
template <class T, class = void> struct pg8_has_prefetch { static constexpr bool value = false; };
template <class T> struct pg8_has_prefetch<T, decltype((void)T::PREFETCH)> { static constexpr bool value = true; };
template <class Epi> __device__ __forceinline__ void pg8_prefetch(const Epi& E, const Unit& u, int wid, int lane) { if constexpr (pg8_has_prefetch<Epi>::value) E.prefetch(u, wid, lane); }
template <class Epi, class Sched, bool ALIGN_EPI = false, bool SP2 = false>
__device__ __forceinline__ void gemm_phase(PG8_LAS unsigned char* lds, const Gemm g, const Sched& S, const Epi& E) {
    const int tid = threadIdx.x, wid = __builtin_amdgcn_readfirstlane(tid >> 6), lane = tid & 63, wr = wid >> 2, wc = wid & 3, fr = lane & 15, fq = lane >> 4;
    const int K = g.K, nt = K / BK;
    unsigned voffA[2], voffB[2];
#pragma unroll
    for (int i = 0; i < 2; ++i) { int R, C; stage_rc(tid * 16 + i * 8192, R, C); const int Rb = Epi::PERM ? ((R & ~31) + perm32(R & 31)) : R;
        const int Ra = Epi::PERMA ? ((R & ~63) | ((R & 15) << 2) | ((R >> 4) & 3)) : R;
        voffA[i] = (unsigned)(Ra * K + C) * 2u; voffB[i] = (unsigned)(Rb * K + C) * 2u; }
    const size_t kstep = (size_t)(BK * 2);
    const size_t hstep = (size_t)HALF * K * 2;
    const size_t tstep = 2 * hstep;
    const unsigned ldsw = (unsigned)wid * 1024u;
    const int aoff = lds_byte(wr * 64 + fr, fq * 8), boff = lds_byte(wc * 32 + fr, fq * 8);
#define PG8_SA(b, h) (((b) * 2 + (h)) * HTB)
#define PG8_SB(b, h) ((4 + (b) * 2 + (h)) * HTB)
#define PG8_STAGE(bufoff, gbase, voff) do { _Pragma("unroll") for (int _i = 0; _i < 2; ++_i) \
        __builtin_amdgcn_global_load_lds((const unsigned*)((const char*)(gbase) + (voff)[_i]), (PG8_LAS unsigned*)(lds + (bufoff) + ldsw + _i * 8192), 16, 0, 0); } while (0)
#define PG8_LDA(dst, b, h) do { if constexpr (Epi::FP8 || Epi::NT8 > 0) { _Pragma("unroll") for (int m = 0; m < 4; ++m) dst##8[m] = pg8_cat(*(const PG8_LAS bf16x8*)(lds + PG8_SA(b, h) + aoff + m * 2048), *(const PG8_LAS bf16x8*)(lds + PG8_SA(b, h) + aoff + m * 2048 + 1024)); } \
        else { _Pragma("unroll") for (int m = 0; m < 4; ++m) _Pragma("unroll") for (int k = 0; k < 2; ++k) dst[m][k] = *(const PG8_LAS bf16x8*)(lds + PG8_SA(b, h) + aoff + m * 2048 + k * 1024); } } while (0)
#define PG8_LDB(dst, b, h) do { if constexpr (Epi::FP8 || Epi::NT8 > 0) { _Pragma("unroll") for (int n = 0; n < 2; ++n) dst##8[n] = pg8_cat(*(const PG8_LAS bf16x8*)(lds + PG8_SB(b, h) + boff + n * 2048), *(const PG8_LAS bf16x8*)(lds + PG8_SB(b, h) + boff + n * 2048 + 1024)); } \
        else { _Pragma("unroll") for (int n = 0; n < 2; ++n) _Pragma("unroll") for (int k = 0; k < 2; ++k) dst[n][k] = *(const PG8_LAS bf16x8*)(lds + PG8_SB(b, h) + boff + n * 2048 + k * 1024); } } while (0)
#define PG8_MMA8(ai, bj, At, Bt) do { _Pragma("unroll") for (int m = 0; m < 4; ++m) _Pragma("unroll") for (int n = 0; n < 2; ++n) \
        asm volatile("v_mfma_f32_16x16x128_f8f6f4 %0, %1, %2, %0" : "+v"(acc[ai][bj][m][n]) : "v"(Bt##8[n]), "v"(At##8[m])); } while (0)
#ifndef PG8_PRIO
#define PG8_PRIO 1
#endif
#ifndef PG8_PRIO_MMA
#define PG8_PRIO_MMA 1
#endif
#ifndef PG8_PRIO_AFTER
#define PG8_PRIO_AFTER 3
#endif
#define PG8_MMA(ai, bj, At, Bt) do { if (PG8_PRIO) __builtin_amdgcn_s_setprio(PG8_PRIO_MMA); if constexpr (Epi::FP8) { PG8_MMA8(ai, bj, At, Bt); } \
        else if constexpr (Epi::NT8 > 0) { if constexpr (f8now) { PG8_MMA8(ai, bj, At, Bt); } else { _Pragma("unroll") for (int m = 0; m < 4; ++m) _Pragma("unroll") for (int n = 0; n < 2; ++n) { \
            asm volatile("v_mfma_f32_16x16x32_bf16 %0, %1, %2, %0" : "+v"(acc[ai][bj][m][n]) : "v"(pg8_lo(Bt##8[n])), "v"(pg8_lo(At##8[m]))); \
            asm volatile("v_mfma_f32_16x16x32_bf16 %0, %1, %2, %0" : "+v"(acc[ai][bj][m][n]) : "v"(pg8_hi(Bt##8[n])), "v"(pg8_hi(At##8[m]))); } } } \
        else if constexpr (Epi::I8) { _Pragma("unroll") for (int m = 0; m < 4; ++m) _Pragma("unroll") for (int n = 0; n < 2; ++n) _Pragma("unroll") for (int k = 0; k < 2; ++k) \
        asm volatile("v_mfma_i32_16x16x64_i8 %0, %1, %2, %0" : "+v"(acc[ai][bj][m][n]) : "v"(Bt[n][k]), "v"(At[m][k])); } \
        else { _Pragma("unroll") for (int m = 0; m < 4; ++m) _Pragma("unroll") for (int n = 0; n < 2; ++n) _Pragma("unroll") for (int k = 0; k < 2; ++k) \
        acc[ai][bj][m][n] = __builtin_amdgcn_mfma_f32_16x16x32_bf16(Bt[n][k], At[m][k], acc[ai][bj][m][n], 0, 0, 0); } if (PG8_PRIO) __builtin_amdgcn_s_setprio(PG8_PRIO_AFTER); } while (0)
#define PG8_WAIT_V(n) asm volatile("s_waitcnt vmcnt(" #n ")" ::: "memory")
#define PG8_WAIT_L(n) asm volatile("s_waitcnt lgkmcnt(" #n ")" ::: "memory")
#define PG8_BAR __builtin_amdgcn_s_barrier()
#define PG8_SCHED __builtin_amdgcn_sched_barrier(0)
    Unit cur, nxt; int ui = 0;
    if (!S.next(0, cur)) return;
    cur.slot = 0; pg8_prefetch(E, cur, wid, lane);
    f32x4 acc[2][2][4][2];
#pragma unroll
    for (int a = 0; a < 2; ++a)
#pragma unroll
        for (int b = 0; b < 2; ++b)
#pragma unroll
            for (int m = 0; m < 4; ++m)
#pragma unroll
                for (int n = 0; n < 2; ++n) acc[a][b][m][n] = (f32x4){0.f, 0.f, 0.f, 0.f};
    bf16x8 At[4][2], B0[2][2], B1[2][2]; pg8_v8i At8[4], B08[2], B18[2];
    const char* cA = (const char*)g.A + (size_t)cur.pm * tstep; const char* cB = (const char*)g.Bt + (size_t)cur.pn * tstep;
    S.a_ready(cur);
    if constexpr (SP2) {
        PG8_STAGE(PG8_SB(0, 0), cB, voffB); PG8_STAGE(PG8_SB(0, 1), cB + hstep, voffB); PG8_STAGE(PG8_SA(0, 0), cA, voffA); PG8_STAGE(PG8_SA(0, 1), cA + hstep, voffA);
        if (wr == 1) PG8_BAR;
        PG8_WAIT_V(2); PG8_BAR;
        PG8_STAGE(PG8_SB(1, 0), cB + kstep, voffB); PG8_STAGE(PG8_SA(1, 0), cA + kstep, voffA); PG8_STAGE(PG8_SB(1, 1), cB + hstep + kstep, voffB);
        PG8_WAIT_V(6); PG8_BAR;
    } else {
        PG8_STAGE(PG8_SB(0, 0), cB, voffB); PG8_STAGE(PG8_SA(0, 0), cA, voffA); PG8_STAGE(PG8_SB(0, 1), cB + hstep, voffB); PG8_STAGE(PG8_SA(0, 1), cA + hstep, voffA);
        if (wr == 1) PG8_BAR;
        PG8_WAIT_V(4); PG8_BAR;
        PG8_STAGE(PG8_SB(1, 0), cB + kstep, voffB); PG8_STAGE(PG8_SA(1, 0), cA + kstep, voffA); PG8_STAGE(PG8_SB(1, 1), cB + hstep + kstep, voffB);
        PG8_WAIT_V(6); PG8_BAR;
    }
    for (;;) {
        const bool has_next = S.next(ui + 1, nxt);
        const char* nA = has_next ? (const char*)g.A + (size_t)nxt.pm * tstep : cA; const char* nB = has_next ? (const char*)g.Bt + (size_t)nxt.pn * tstep : cB;
        for (int t = 0; t < (Epi::NT8 > 0 ? Epi::NT8 : 0); t += 2) {
            const bool last = (t == nt - 2);
            constexpr bool f8now = true; (void)f8now;
            const char* a1 = cA + (size_t)(t + 1) * kstep;
            const char* a2 = last ? nA : cA + (size_t)(t + 2) * kstep; const char* b2 = last ? nB : cB + (size_t)(t + 2) * kstep;
            const char* a3 = a2 + kstep; const char* b3 = b2 + kstep;
            if (last && has_next) S.a_ready(nxt);
            if constexpr (SP2) {
            PG8_LDB(B0, 0, 0); PG8_LDB(B1, 0, 1); PG8_SCHED; PG8_LDA(At, 0, 0); PG8_STAGE(PG8_SA(1, 1), a1 + hstep, voffA);
            PG8_WAIT_V(8); PG8_WAIT_L(0); PG8_BAR; PG8_MMA(0, 0, At, B0); PG8_MMA(0, 1, At, B1); PG8_BAR; PG8_SCHED;
            PG8_LDA(At, 0, 1); PG8_STAGE(PG8_SB(0, 0), b2, voffB); PG8_STAGE(PG8_SB(0, 1), b2 + hstep, voffB); PG8_STAGE(PG8_SA(0, 0), a2, voffA);
            PG8_WAIT_V(8); PG8_WAIT_L(0); PG8_BAR; PG8_MMA(1, 0, At, B0); PG8_MMA(1, 1, At, B1); PG8_BAR; PG8_SCHED;
            PG8_LDB(B0, 1, 0); PG8_LDB(B1, 1, 1); PG8_SCHED; PG8_LDA(At, 1, 0); PG8_STAGE(PG8_SA(0, 1), a2 + hstep, voffA);
            PG8_WAIT_V(8); PG8_WAIT_L(0); PG8_BAR; PG8_MMA(0, 0, At, B0); PG8_MMA(0, 1, At, B1); PG8_BAR; PG8_SCHED;
            PG8_LDA(At, 1, 1); PG8_STAGE(PG8_SB(1, 0), b3, voffB); PG8_STAGE(PG8_SB(1, 1), b3 + hstep, voffB); PG8_STAGE(PG8_SA(1, 0), a3, voffA);
            PG8_WAIT_V(8); PG8_WAIT_L(0); PG8_BAR; PG8_MMA(1, 0, At, B0); PG8_MMA(1, 1, At, B1); PG8_BAR; PG8_SCHED;
            } else {
            PG8_LDB(B0, 0, 0); PG8_SCHED; PG8_LDA(At, 0, 0); PG8_STAGE(PG8_SA(1, 1), a1 + hstep, voffA);
            PG8_WAIT_L(8); PG8_BAR; PG8_WAIT_L(0); PG8_MMA(0, 0, At, B0); PG8_BAR; PG8_SCHED;
            PG8_LDB(B1, 0, 1); PG8_STAGE(PG8_SB(0, 0), b2, voffB);
            PG8_BAR; PG8_WAIT_L(0); PG8_MMA(0, 1, At, B1); PG8_BAR;
            PG8_LDA(At, 0, 1); PG8_STAGE(PG8_SA(0, 0), a2, voffA);
            PG8_BAR; PG8_WAIT_L(0); PG8_MMA(1, 0, At, B0); PG8_BAR; PG8_SCHED;
            PG8_STAGE(PG8_SB(0, 1), b2 + hstep, voffB);
            PG8_WAIT_V(6); PG8_BAR; PG8_MMA(1, 1, At, B1); PG8_BAR;
            PG8_LDB(B0, 1, 0); PG8_SCHED; PG8_LDA(At, 1, 0); PG8_STAGE(PG8_SA(0, 1), a2 + hstep, voffA);
            PG8_WAIT_L(8); PG8_BAR; PG8_WAIT_L(0); PG8_MMA(0, 0, At, B0); PG8_BAR; PG8_SCHED;
            PG8_LDB(B1, 1, 1); PG8_STAGE(PG8_SB(1, 0), b3, voffB);
            PG8_BAR; PG8_WAIT_L(0); PG8_MMA(0, 1, At, B1); PG8_BAR;
            PG8_LDA(At, 1, 1); PG8_STAGE(PG8_SA(1, 0), a3, voffA);
            PG8_BAR; PG8_WAIT_L(0); PG8_MMA(1, 0, At, B0); PG8_BAR; PG8_SCHED;
            PG8_STAGE(PG8_SB(1, 1), b3 + hstep, voffB);
            PG8_WAIT_V(6); PG8_BAR; PG8_MMA(1, 1, At, B1); PG8_BAR;
            }
        }
        if constexpr (Epi::NT8 > 0) { const float rs_ = E.mix_rescale();
#pragma unroll
            for (int a_ = 0; a_ < 2; ++a_)
#pragma unroll
                for (int b_ = 0; b_ < 2; ++b_)
#pragma unroll
                    for (int m_ = 0; m_ < 4; ++m_)
#pragma unroll
                        for (int n_ = 0; n_ < 2; ++n_) acc[a_][b_][m_][n_] *= rs_; }
        for (int t = (Epi::NT8 > 0 ? Epi::NT8 : 0); t < nt; t += 2) {
            const bool last = (t == nt - 2);
            constexpr bool f8now = false; (void)f8now;
            const char* a1 = cA + (size_t)(t + 1) * kstep;
            const char* a2 = last ? nA : cA + (size_t)(t + 2) * kstep; const char* b2 = last ? nB : cB + (size_t)(t + 2) * kstep;
            const char* a3 = a2 + kstep; const char* b3 = b2 + kstep;
            if (last && has_next) S.a_ready(nxt);
            if constexpr (SP2) {
            PG8_LDB(B0, 0, 0); PG8_LDB(B1, 0, 1); PG8_SCHED; PG8_LDA(At, 0, 0); PG8_STAGE(PG8_SA(1, 1), a1 + hstep, voffA);
            PG8_WAIT_V(8); PG8_WAIT_L(0); PG8_BAR; PG8_MMA(0, 0, At, B0); PG8_MMA(0, 1, At, B1); PG8_BAR; PG8_SCHED;
            PG8_LDA(At, 0, 1); PG8_STAGE(PG8_SB(0, 0), b2, voffB); PG8_STAGE(PG8_SB(0, 1), b2 + hstep, voffB); PG8_STAGE(PG8_SA(0, 0), a2, voffA);
            PG8_WAIT_V(8); PG8_WAIT_L(0); PG8_BAR; PG8_MMA(1, 0, At, B0); PG8_MMA(1, 1, At, B1); PG8_BAR; PG8_SCHED;
            PG8_LDB(B0, 1, 0); PG8_LDB(B1, 1, 1); PG8_SCHED; PG8_LDA(At, 1, 0); PG8_STAGE(PG8_SA(0, 1), a2 + hstep, voffA);
            PG8_WAIT_V(8); PG8_WAIT_L(0); PG8_BAR; PG8_MMA(0, 0, At, B0); PG8_MMA(0, 1, At, B1); PG8_BAR; PG8_SCHED;
            PG8_LDA(At, 1, 1); PG8_STAGE(PG8_SB(1, 0), b3, voffB); PG8_STAGE(PG8_SB(1, 1), b3 + hstep, voffB); PG8_STAGE(PG8_SA(1, 0), a3, voffA);
            PG8_WAIT_V(8); PG8_WAIT_L(0); PG8_BAR; PG8_MMA(1, 0, At, B0); PG8_MMA(1, 1, At, B1); PG8_BAR; PG8_SCHED;
            } else {
            PG8_LDB(B0, 0, 0); PG8_SCHED; PG8_LDA(At, 0, 0); PG8_STAGE(PG8_SA(1, 1), a1 + hstep, voffA);
            PG8_WAIT_L(8); PG8_BAR; PG8_WAIT_L(0); PG8_MMA(0, 0, At, B0); PG8_BAR; PG8_SCHED;
            PG8_LDB(B1, 0, 1); PG8_STAGE(PG8_SB(0, 0), b2, voffB);
            PG8_BAR; PG8_WAIT_L(0); PG8_MMA(0, 1, At, B1); PG8_BAR;
            PG8_LDA(At, 0, 1); PG8_STAGE(PG8_SA(0, 0), a2, voffA);
            PG8_BAR; PG8_WAIT_L(0); PG8_MMA(1, 0, At, B0); PG8_BAR; PG8_SCHED;
            PG8_STAGE(PG8_SB(0, 1), b2 + hstep, voffB);
            PG8_WAIT_V(6); PG8_BAR; PG8_MMA(1, 1, At, B1); PG8_BAR;
            PG8_LDB(B0, 1, 0); PG8_SCHED; PG8_LDA(At, 1, 0); PG8_STAGE(PG8_SA(0, 1), a2 + hstep, voffA);
            PG8_WAIT_L(8); PG8_BAR; PG8_WAIT_L(0); PG8_MMA(0, 0, At, B0); PG8_BAR; PG8_SCHED;
            PG8_LDB(B1, 1, 1); PG8_STAGE(PG8_SB(1, 0), b3, voffB);
            PG8_BAR; PG8_WAIT_L(0); PG8_MMA(0, 1, At, B1); PG8_BAR;
            PG8_LDA(At, 1, 1); PG8_STAGE(PG8_SA(1, 0), a3, voffA);
            PG8_BAR; PG8_WAIT_L(0); PG8_MMA(1, 0, At, B0); PG8_BAR; PG8_SCHED;
            PG8_STAGE(PG8_SB(1, 1), b3 + hstep, voffB);
            PG8_WAIT_V(6); PG8_BAR; PG8_MMA(1, 1, At, B1); PG8_BAR;
            }
        }
        if constexpr (ALIGN_EPI) { if (wr == 0) PG8_BAR; }
#ifdef PROBE_EPI2
        if constexpr (!Epi::AFTER_DRAIN) { if constexpr (Epi::I8) {
                int reps_ = 2; asm volatile("" : "+s"(reps_));
#pragma unroll 1
                for (int rep_ = 0; rep_ < reps_; ++rep_) { asm volatile("" ::: "memory"); E(acc, cur, wr, wc, fr, fq); } }
            else E(acc, cur, wr, wc, fr, fq);
            S.done(cur); }
#else
        if constexpr (!Epi::AFTER_DRAIN) { E(acc, cur, wr, wc, fr, fq); S.done(cur); }
#endif
        if (!has_next) break;
#pragma unroll
        for (int a = 0; a < 2; ++a)
#pragma unroll
            for (int b = 0; b < 2; ++b)
#pragma unroll
                for (int m = 0; m < 4; ++m)
#pragma unroll
                    for (int n = 0; n < 2; ++n) acc[a][b][m][n] = (f32x4){0.f, 0.f, 0.f, 0.f};
        cur = nxt; cA = nA; cB = nB; ++ui; cur.slot = ui & 1; pg8_prefetch(E, cur, wid, lane);
        if constexpr (ALIGN_EPI) { if (wr == 1) PG8_BAR; }
    }
    PG8_WAIT_V(0);
    if constexpr (!ALIGN_EPI) { if (wr == 0) PG8_BAR; }
    PG8_BAR;
    if (PG8_PRIO) __builtin_amdgcn_s_setprio(0);
    if constexpr (Epi::AFTER_DRAIN) { E.fused(acc, cur, wr, wc, fr, fq, lds, wid, lane); S.done(cur); }
#undef PG8_SA
#undef PG8_SB
#undef PG8_STAGE
#undef PG8_LDA
#undef PG8_LDB
#undef PG8_MMA
#undef PG8_WAIT_V
#undef PG8_WAIT_L
#undef PG8_BAR
#undef PG8_SCHED
}
}
#define ATT_LAS __attribute__((address_space(3)))
namespace att {
typedef unsigned short bf16;
using bf16x8 = __attribute__((ext_vector_type(8))) short;
using s16x4  = __attribute__((ext_vector_type(4))) short;
using f32x16 = __attribute__((ext_vector_type(16))) float;
using f32x4  = __attribute__((ext_vector_type(4))) float;
using u32x4  = __attribute__((ext_vector_type(4))) unsigned;
constexpr int NW = 8, QBLK = 32, KVBLK = 64;
constexpr float THR = 8.f;
#ifndef ATT_SRCC
#define ATT_SRCC 1
#endif
#define ATT_KS8 (ATT_SRCC ? 0.5f : 16.0f)
constexpr int SHM_V = KVBLK * 128 * 2;
constexpr int SHM_KMAX = KVBLK * (192 * 2 + 16);
constexpr int OFF_K = 3 * SHM_V, OFF_WS = OFF_K + 2 * SHM_KMAX, ATT_LDS = OFF_WS + NW * 64 * 4;
constexpr int OPITCH = 272;
static_assert(NW * 32 * OPITCH <= OFF_WS, "output staging fits under the K/V buffers");
#define ATT_SBAR() __builtin_amdgcn_sched_barrier(0)
template <int DQK, bool KF8 = false> __device__ __forceinline__ constexpr int kpitch() { return DQK * (KF8 ? 1 : 2) + 16; }
template <int DQK> __device__ __forceinline__ int kswz(int row, int cb) { return row * kpitch<DQK>() + cb; }
__device__ __forceinline__ int crow(int r, int hi) { return (r & 3) + 8 * (r >> 2) + 4 * hi; }
__device__ __forceinline__ unsigned cvtpk(float lo, float hi) { unsigned r; asm volatile("v_cvt_pk_bf16_f32 %0, %1, %2" : "=v"(r) : "v"(lo), "v"(hi)); return r; }
__device__ __forceinline__ float bf2f(unsigned short b) { return __uint_as_float(((unsigned)b) << 16); }

template <bool MASKABLE>
__device__ __forceinline__ void partialSM(f32x16& p0, f32x16& p1, float& m_reg, float& mn, float& alpha, const float C, const float thr_raw, const float pl2, const bool domask, const int mbase) {
  if (MASKABLE) { if (domask) {
#pragma unroll
    for (int r = 0; r < 16; ++r) { const int off = (r & 3) + 8 * (r >> 2);
      p0[r] = ((unsigned)(mbase + off) > 256u) ? -1e30f : p0[r]; p1[r] = ((unsigned)(mbase + 32 + off) > 256u) ? -1e30f : p1[r]; } } }
  float pmax = p0[0];
#pragma unroll
  for (int r = 1; r < 16; ++r) pmax = fmaxf(pmax, p0[r]);
#pragma unroll
  for (int r = 0; r < 16; ++r) pmax = fmaxf(pmax, p1[r]);
  { auto rr = __builtin_amdgcn_permlane32_swap(__float_as_uint(pmax), __float_as_uint(pmax), false, false);
    pmax = fmaxf(__uint_as_float(rr[0]), __uint_as_float(rr[1])); }
  if (__builtin_expect(__all(pmax - m_reg <= thr_raw), 1)) { mn = m_reg; alpha = 1.f; }
  else { mn = fmaxf(m_reg, pmax); alpha = __builtin_amdgcn_exp2f((m_reg - mn) * C); m_reg = mn; }
  const float mnC = pl2 - mn * C;
#pragma unroll
  for (int r = 0; r < 16; ++r) p0[r] = fmaf(p0[r], C, mnC);
#pragma unroll
  for (int r = 0; r < 16; ++r) p1[r] = fmaf(p1[r], C, mnC);
#pragma unroll
  for (int r = 0; r < 16; ++r) p0[r] = __builtin_amdgcn_exp2f(p0[r]);
}
template <bool MASKABLE, bool FIRST>
__device__ __forceinline__ void partialSM2(f32x16& p0, f32x16& p1, float& m_reg, float& alpha, const float thr_l2, const float pl2, const bool domask, const int mbase) {
  if (MASKABLE) { if (domask) {
#pragma unroll
    for (int r = 0; r < 16; ++r) { const int off = (r & 3) + 8 * (r >> 2);
      p0[r] = ((unsigned)(mbase + off) > 256u) ? -1e30f : p0[r]; p1[r] = ((unsigned)(mbase + 32 + off) > 256u) ? -1e30f : p1[r]; } } }
  float pmax = p0[0];
#pragma unroll
  for (int r = 1; r < 16; ++r) pmax = fmaxf(pmax, p0[r]);
#pragma unroll
  for (int r = 0; r < 16; ++r) pmax = fmaxf(pmax, p1[r]);
  { auto rr = __builtin_amdgcn_permlane32_swap(__float_as_uint(pmax), __float_as_uint(pmax), false, false);
    pmax = fmaxf(__uint_as_float(rr[0]), __uint_as_float(rr[1])); }
  const float rel = pmax - pl2;
  if (!FIRST && __builtin_expect(__all(rel <= thr_l2), 1)) { alpha = 1.f; }
  else { const float d = FIRST ? rel : fmaxf(rel, 0.f); alpha = FIRST ? 1.f : __builtin_amdgcn_exp2f(-d); m_reg += d;
#pragma unroll
    for (int r = 0; r < 16; ++r) { p0[r] -= d; p1[r] -= d; } }
#pragma unroll
  for (int r = 0; r < 16; ++r) p0[r] = __builtin_amdgcn_exp2f(p0[r]);
}
__device__ __forceinline__ void finishSM(f32x16& p0, f32x16& p1, float alpha, float& l_reg, bf16x8& pa0, bf16x8& pa1, bf16x8& pa2, bf16x8& pa3) {
#pragma unroll
  for (int r = 0; r < 16; ++r) p1[r] = __builtin_amdgcn_exp2f(p1[r]);
  float ps = 0;
#pragma unroll
  for (int r = 0; r < 16; ++r) ps += p0[r];
#pragma unroll
  for (int r = 0; r < 16; ++r) ps += p1[r];
  { auto rr = __builtin_amdgcn_permlane32_swap(__float_as_uint(ps), __float_as_uint(ps), false, false);
    ps = __uint_as_float(rr[0]) + __uint_as_float(rr[1]); }
  l_reg = l_reg * alpha + ps;
#define ATT_PK4(P, BASE, OUT) do { unsigned a0 = cvtpk(P[BASE + 0], P[BASE + 1]), a1 = cvtpk(P[BASE + 2], P[BASE + 3]);   \
    unsigned b0 = cvtpk(P[BASE + 4], P[BASE + 5]), b1 = cvtpk(P[BASE + 6], P[BASE + 7]);                              \
    auto r0 = __builtin_amdgcn_permlane32_swap(a0, b0, false, false); auto r1 = __builtin_amdgcn_permlane32_swap(a1, b1, false, false); \
    u32x4 w = {r0[0], r1[0], r0[1], r1[1]}; OUT = *reinterpret_cast<bf16x8*>(&w); } while (0)
  ATT_PK4(p0, 0, pa0); ATT_PK4(p0, 8, pa1); ATT_PK4(p1, 0, pa2); ATT_PK4(p1, 8, pa3);
#undef ATT_PK4
}
template <int DQK>
__device__ __forceinline__ void qkt(f32x16& p0, f32x16& p1, const char* Ks, const bf16x8* qr, int r32, int hi) {
  p0 = f32x16{}; p1 = f32x16{};
  const char* kb = Ks + r32 * kpitch<DQK>() + hi * 16;
#pragma unroll
  for (int d0 = 0; d0 < DQK / 16; ++d0) {
    const bf16x8 b0 = *reinterpret_cast<const bf16x8*>(kb + d0 * 32);
    const bf16x8 b1 = *reinterpret_cast<const bf16x8*>(kb + d0 * 32 + 32 * kpitch<DQK>());
    p0 = __builtin_amdgcn_mfma_f32_32x32x16_bf16(b0, qr[d0], p0, 0, 0, 0);
    p1 = __builtin_amdgcn_mfma_f32_32x32x16_bf16(b1, qr[d0], p1, 0, 0, 0);
    if ((d0 & 3) == 3) ATT_SBAR(); }
}
typedef int v8i __attribute__((ext_vector_type(8)));
template <int DQK>
__device__ __forceinline__ void qkt8(f32x16& p0, f32x16& p1, const char* Ks, const v8i* qf, int r32, int hi, const float cinit = 0.f) {
#pragma unroll
  for (int r = 0; r < 16; ++r) { p0[r] = cinit; p1[r] = cinit; }
  constexpr int KP = kpitch<DQK, true>();
  const char* kb = Ks + r32 * KP + hi * 32;
#pragma unroll
  for (int s = 0; s < DQK / 64; ++s) {
    typedef int v4i __attribute__((ext_vector_type(4)));
    const v4i a00 = *reinterpret_cast<const v4i*>(kb + s * 64), a01 = *reinterpret_cast<const v4i*>(kb + s * 64 + 16);
    const v4i a10 = *reinterpret_cast<const v4i*>(kb + s * 64 + 32 * KP), a11 = *reinterpret_cast<const v4i*>(kb + s * 64 + 32 * KP + 16);
    const v8i a0 = __builtin_shufflevector(a00, a01, 0, 1, 2, 3, 4, 5, 6, 7), a1 = __builtin_shufflevector(a10, a11, 0, 1, 2, 3, 4, 5, 6, 7);
    p0 = __builtin_amdgcn_mfma_scale_f32_32x32x64_f8f6f4(a0, qf[s], p0, 0, 0, 0, 0, 0, 0);
    p1 = __builtin_amdgcn_mfma_scale_f32_32x32x64_f8f6f4(a1, qf[s], p1, 0, 0, 0, 0, 0, 0); }
}
__device__ __forceinline__ int v_st(int k, int c) { const int kk = (k & ~0xC) | ((k & 4) << 1) | ((k & 8) >> 1); return ((kk >> 3) * 4 + (c >> 5)) * 512 + ((kk & 7) * 32 + (c & 31)) * 2; }
__device__ __forceinline__ int v_rd_base(int lane) { return ((lane & 3) << 3) | (((lane >> 2) & 3) << 6) | (((lane >> 4) & 1) << 5) | (((lane >> 5) & 1) << 8); }
constexpr int v_rd_off(int d0, int ks, int half) { return d0 * 512 + ks * 4096 + half * 2048; }
template <int OFF> __device__ __forceinline__ s16x4 tr_read(int vb) {
  s16x4 r; asm volatile("ds_read_b64_tr_b16 %0, %1 offset:%2" : "=&v"(r) : "v"(vb), "i"(OFF) : "memory"); return r;
}
template <int D0> __device__ __forceinline__ void pv_one(f32x16& od, int vb, bf16x8 pa0, bf16x8 pa1, bf16x8 pa2, bf16x8 pa3) {
  const s16x4 l0 = tr_read<v_rd_off(D0, 0, 0)>(vb), h0 = tr_read<v_rd_off(D0, 0, 1)>(vb), l1 = tr_read<v_rd_off(D0, 1, 0)>(vb), h1 = tr_read<v_rd_off(D0, 1, 1)>(vb);
  const s16x4 l2 = tr_read<v_rd_off(D0, 2, 0)>(vb), h2 = tr_read<v_rd_off(D0, 2, 1)>(vb), l3 = tr_read<v_rd_off(D0, 3, 0)>(vb), h3 = tr_read<v_rd_off(D0, 3, 1)>(vb);
  asm volatile("s_waitcnt lgkmcnt(0)" ::: "memory"); ATT_SBAR();
#define ATT_PK(L, H) (bf16x8){L[0], L[1], L[2], L[3], H[0], H[1], H[2], H[3]}
  od = __builtin_amdgcn_mfma_f32_32x32x16_bf16(pa0, ATT_PK(l0, h0), od, 0, 0, 0);
  od = __builtin_amdgcn_mfma_f32_32x32x16_bf16(pa1, ATT_PK(l1, h1), od, 0, 0, 0);
  od = __builtin_amdgcn_mfma_f32_32x32x16_bf16(pa2, ATT_PK(l2, h2), od, 0, 0, 0);
  od = __builtin_amdgcn_mfma_f32_32x32x16_bf16(pa3, ATT_PK(l3, h3), od, 0, 0, 0);
#undef ATT_PK
}
__device__ __forceinline__ void pv_d0(f32x16* o, int vb, bf16x8 pa0, bf16x8 pa1, bf16x8 pa2, bf16x8 pa3) {
  pv_one<0>(o[0], vb, pa0, pa1, pa2, pa3); pv_one<1>(o[1], vb, pa0, pa1, pa2, pa3); pv_one<2>(o[2], vb, pa0, pa1, pa2, pa3); pv_one<3>(o[3], vb, pa0, pa1, pa2, pa3);
}

constexpr int VT8_PITCH = 80, VT8_BYTES = 128 * VT8_PITCH;
__device__ __forceinline__ int pk4_fp8(float a, float b, float c, float d) { int t = 0; t = __builtin_amdgcn_cvt_pk_fp8_f32(a, b, t, false); t = __builtin_amdgcn_cvt_pk_fp8_f32(c, d, t, true); return t; }
__device__ __forceinline__ void finishSM8(f32x16& p0, f32x16& p1, float alpha, float& l_reg, v8i& pa) {
#pragma unroll
  for (int r = 0; r < 16; ++r) p1[r] = __builtin_amdgcn_exp2f(p1[r]);
  float ps = 0;
#pragma unroll
  for (int r = 0; r < 16; ++r) ps += p0[r];
#pragma unroll
  for (int r = 0; r < 16; ++r) ps += p1[r];
  { auto rr = __builtin_amdgcn_permlane32_swap(__float_as_uint(ps), __float_as_uint(ps), false, false);
    ps = __uint_as_float(rr[0]) + __uint_as_float(rr[1]); }
  l_reg = l_reg * alpha + ps;
#pragma unroll
  for (int i = 0; i < 4; ++i) { pa[i] = pk4_fp8(p0[4 * i], p0[4 * i + 1], p0[4 * i + 2], p0[4 * i + 3]); pa[4 + i] = pk4_fp8(p1[4 * i], p1[4 * i + 1], p1[4 * i + 2], p1[4 * i + 3]); }
}
__device__ __forceinline__ void pv8_d0(f32x16* o, const char* vp, v8i pa) {
  typedef int v4i __attribute__((ext_vector_type(4)));
#pragma unroll
  for (int d0 = 0; d0 < 4; ++d0) { const v4i x0 = *reinterpret_cast<const v4i*>(vp + d0 * 32 * VT8_PITCH), x1 = *reinterpret_cast<const v4i*>(vp + d0 * 32 * VT8_PITCH + 16);
    const v8i bf = __builtin_shufflevector(x0, x1, 0, 1, 2, 3, 4, 5, 6, 7);
    o[d0] = __builtin_amdgcn_mfma_scale_f32_32x32x64_f8f6f4(pa, bf, o[d0], 0, 0, 0, 0, 0, 0); }
}

template <int DQK> __device__ __forceinline__ constexpr float q8_scale() { return (ATT_SRCC != 0) ? (DQK == 192 ? 0.07216878364870323f : 0.08838834764831845f) * 1.4426950408889634f / ATT_KS8 : 16.0f; }
template <int DQK, bool QNORM, bool MASKABLE, bool OFP8, bool KF8, bool VF8, bool Q8IN = false>
__device__ __forceinline__ void attn_body(const bf16* __restrict__ Qlane, const float* __restrict__ gq, const float* __restrict__ rope, int qrow, int qcol,
                                          const bf16* __restrict__ K0, long ldk, const bf16* __restrict__ V0, long ldv, int a0, int nA, int b0, int nB, int jB, int qi,
                                          float sink_l2, bf16* __restrict__ Owave, long ldo, char* lds, ATT_LAS unsigned char* ldsl, const int tid) {
  constexpr float SCALE = DQK == 192 ? 0.07216878364870323f : 0.08838834764831845f;
  constexpr bool SRCC = KF8 && (ATT_SRCC != 0);
  constexpr float QKS = KF8 ? 256.0f : 1.0f;
  constexpr float C = SRCC ? 1.0f : SCALE * 1.4426950408889634f / QKS;
  constexpr float THR_RAW = (VF8 ? 2.f : THR) / SCALE * QKS;
  constexpr float THR_L2 = (VF8 ? 2.f : THR) * 1.4426950408889634f;
  constexpr float SQ8 = SRCC ? SCALE * 1.4426950408889634f / ATT_KS8 : 16.0f;
  constexpr int SHMV = VF8 ? VT8_BYTES : SHM_V;
  constexpr float PL2 = VF8 ? 5.0f : 0.0f;
  constexpr int SHM_K = KVBLK * kpitch<DQK, KF8>();
  constexpr int KP = DQK / 64;
  const int wid = __builtin_amdgcn_readfirstlane(tid >> 6), lane = tid & 63, r32 = lane & 31, hi = lane >> 5;
  char* V_lds = lds; char* K_lds = lds + OFF_K;
  float* ws = (float*)(lds + OFF_WS) + wid * 64; float* li_l = ws; float* al_l = ws + 32;
  float m_reg = (KF8 && (ATT_SRCC != 0)) ? 0.f : -1e30f, l_reg = 0; f32x16 o[4] = {}; bf16x8 qr[KF8 ? 1 : DQK / 16]; v8i qf[KF8 ? DQK / 64 : 1];
  bf16x8 qw[(KF8 && !(Q8IN && !QNORM)) ? DQK / 64 : 1][4];
  if constexpr (KF8 && !(Q8IN && !QNORM)) { const bf16* Qw0 = Qlane + hi * 32;
#pragma unroll
    for (int s_ = 0; s_ < DQK / 64; ++s_)
#pragma unroll
      for (int i = 0; i < 4; ++i) qw[s_][i] = *reinterpret_cast<const bf16x8*>(Qw0 + s_ * 64 + i * 8); }
  asm volatile("" ::: "memory");
  constexpr int KPITCH = kpitch<DQK, KF8>(), KSLOTW = SHM_K / 1024, KI = (KSLOTW + 7) / 8, KROWB = DQK * (KF8 ? 1 : 2), KES = KF8 ? 1 : 2;
  int koff[KI], voff[2];
#pragma unroll
  for (int i = 0; i < KI; ++i) { const int p = ((i * 8 + wid) * 64 + lane) * 16; const int row = p / KPITCH; int cb = p - row * KPITCH; if (cb >= KROWB) cb = 0; koff[i] = row * (int)ldk * KES + cb; }
  if constexpr (!VF8) {
#pragma unroll
  for (int i = 0; i < 2; ++i) { const int p = (i * 8 + wid) * 64 + lane; const int sub = p >> 5; const int kk = ((sub >> 2) << 3) | ((p >> 2) & 7); const int k = (kk & ~0xC) | ((kk & 4) << 1) | ((kk & 8) >> 1);
    const int c = (sub & 3) * 32 + (p & 3) * 8; voff[i] = k * (int)ldv * 2 + c * 2; }
  } else { voff[0] = (wid * 64 + lane) * 16; voff[1] = ((8 + wid) * 64 + lane) * 16; }
  const int vbase = (int)(uintptr_t)V_lds + v_rd_base(lane);
  const char* vp8 = V_lds + r32 * VT8_PITCH + hi * 32;
  const int NT = nA + nB;
#define ATT_TROW(t) ((t) < nA ? a0 + 64 * (t) : b0 + 64 * ((t) - nA))
#define ATT_DMA(t, kbsel, vbyte) do { const long r0_ = ATT_TROW(t); const char* kt_ = (const char*)K0 + r0_ * ldk * KES; const char* vt_ = VF8 ? (const char*)V0 + (r0_ >> 6) * ldv : (const char*)V0 + r0_ * ldv * 2; \
    _Pragma("unroll") for (int i_ = 0; i_ < KI; ++i_) { const int s_ = i_ * 8 + wid; if (s_ < KSLOTW) __builtin_amdgcn_global_load_lds((const unsigned*)(kt_ + koff[i_]), (ATT_LAS unsigned*)(ldsl + OFF_K + (kbsel) * SHM_K + s_ * 1024), 16, 0, 0); } \
    _Pragma("unroll") for (int i_ = 0; i_ < 2; ++i_) { if (!VF8 || i_ * 8 + wid < VT8_BYTES / 1024) __builtin_amdgcn_global_load_lds((const unsigned*)(vt_ + voff[i_]), (ATT_LAS unsigned*)(ldsl + (vbyte) + (i_ * 8 + wid) * 1024), 16, 0, 0); } } while (0)
  ATT_DMA(0, 0, 0); ATT_DMA(1, 1, SHMV);
  if constexpr (KF8 && Q8IN && !QNORM) {
    typedef int v4i_q __attribute__((ext_vector_type(4))); const char* Q8 = (const char*)Qlane + hi * 32;
#pragma unroll
    for (int s_ = 0; s_ < DQK / 64; ++s_) { const v4i_q a_ = *reinterpret_cast<const v4i_q*>(Q8 + s_ * 64), b_ = *reinterpret_cast<const v4i_q*>(Q8 + s_ * 64 + 16); qf[s_] = __builtin_shufflevector(a_, b_, 0, 1, 2, 3, 4, 5, 6, 7); }
  } else if constexpr (KF8) {
    constexpr int NS = DQK / 64; float y[NS][32];
    const bf16* Qw = Qlane + hi * 32;
#pragma unroll
    for (int s_ = 0; s_ < NS; ++s_)
#pragma unroll
      for (int i = 0; i < 4; ++i) { const bf16x8 w = qw[s_][i];
#pragma unroll
        for (int e = 0; e < 8; ++e) y[s_][i * 8 + e] = bf2f((unsigned short)w[e]); }
    if constexpr (QNORM) {
      float ss = 0.f;
#pragma unroll
      for (int s_ = 0; s_ < NS; ++s_)
#pragma unroll
        for (int e = 0; e < 32; ++e) ss = fmaf(y[s_][e], y[s_][e], ss);
      ss += __shfl_xor(ss, 32);
      const float rn = 1.0f / sqrtf(ss * (1.0f / DQK) + 1e-6f);
#pragma unroll
      for (int s_ = 0; s_ < NS; ++s_)
#pragma unroll
        for (int i = 0; i < 8; ++i) { const f32x4 g4 = *(const f32x4*)(gq + s_ * 64 + hi * 32 + i * 4);
#pragma unroll
          for (int e = 0; e < 4; ++e) y[s_][i * 4 + e] *= rn * g4[e]; }
      if (rope != nullptr && DQK == 192) {
        const int pos = hi ? qcol : qrow; const float* tp = rope + (size_t)pos * 32;
#pragma unroll
        for (int j = 0; j < 16; ++j) { const float cs = tp[2 * j], sn = tp[2 * j + 1]; const float x1 = y[NS - 1][j], x2 = y[NS - 1][16 + j];
          y[NS - 1][j] = x1 * cs - x2 * sn; y[NS - 1][16 + j] = x1 * sn + x2 * cs; }
      }
    }
#pragma unroll
    for (int s_ = 0; s_ < NS; ++s_)
#pragma unroll
      for (int i = 0; i < 8; ++i) { int t = 0; t = __builtin_amdgcn_cvt_pk_fp8_f32(y[s_][4 * i] * SQ8, y[s_][4 * i + 1] * SQ8, t, false); t = __builtin_amdgcn_cvt_pk_fp8_f32(y[s_][4 * i + 2] * SQ8, y[s_][4 * i + 3] * SQ8, t, true); qf[s_][i] = t; }
  } else
  {
    const bf16* Qw = Qlane + hi * 8;
    if constexpr (!QNORM) {
#pragma unroll
      for (int d0 = 0; d0 < DQK / 16; ++d0) qr[d0] = *reinterpret_cast<const bf16x8*>(Qw + d0 * 16);
    } else {
      float ss = 0.f;
#pragma unroll
      for (int d0 = 0; d0 < DQK / 16; ++d0) { qr[d0] = *reinterpret_cast<const bf16x8*>(Qw + d0 * 16);
#pragma unroll
        for (int e = 0; e < 8; ++e) { const float x = bf2f((unsigned short)qr[d0][e]); ss = fmaf(x, x, ss); } }
      ss += __shfl_xor(ss, 32);
      const float rn = 1.0f / sqrtf(ss * (1.0f / DQK) + 1e-6f);
      float y[DQK / 16][8];
#pragma unroll
      for (int d0 = 0; d0 < DQK / 16; ++d0) { const f32x4 g0 = *(const f32x4*)(gq + d0 * 16 + hi * 8), g1 = *(const f32x4*)(gq + d0 * 16 + hi * 8 + 4);
#pragma unroll
        for (int e = 0; e < 8; ++e) y[d0][e] = bf2f((unsigned short)qr[d0][e]) * rn * (e < 4 ? g0[e] : g1[e - 4]); }
      if (rope != nullptr && DQK == 192) {
#pragma unroll
        for (int half = 0; half < 2; ++half) { const int pos = half ? qcol : qrow; const float* tp = rope + (size_t)(pos * 16 + hi * 8) * 2;
#pragma unroll
          for (int e = 0; e < 8; ++e) { const float cs = tp[2 * e], sn = tp[2 * e + 1]; const float x1 = y[8 + 2 * half][e], x2 = y[9 + 2 * half][e];
            y[8 + 2 * half][e] = x1 * cs - x2 * sn; y[9 + 2 * half][e] = x1 * sn + x2 * cs; } }
      }
#pragma unroll
      for (int d0 = 0; d0 < DQK / 16; ++d0) { u32x4 w = {cvtpk(y[d0][0], y[d0][1]), cvtpk(y[d0][2], y[d0][3]), cvtpk(y[d0][4], y[d0][5]), cvtpk(y[d0][6], y[d0][7])}; qr[d0] = *reinterpret_cast<bf16x8*>(&w); }
    }
  }
#define ATT_QKT(P0, P1, KS) do { if constexpr (SRCC) qkt8<DQK>(P0, P1, KS, qf, r32, hi, PL2 - m_reg); else if constexpr (KF8) qkt8<DQK>(P0, P1, KS, qf, r32, hi); else qkt<DQK>(P0, P1, KS, qr, r32, hi); } while (0)
#define ATT_PSM(FIRST_, P0, P1, MN, AL, ...) do { if constexpr (SRCC) partialSM2<MASKABLE, FIRST_>(P0, P1, m_reg, AL, THR_L2, PL2, __VA_ARGS__); else partialSM<MASKABLE>(P0, P1, m_reg, MN, AL, C, THR_RAW, PL2, __VA_ARGS__); } while (0)
#define ATT_LAND() do { asm volatile("s_waitcnt vmcnt(0)" ::: "memory"); __syncthreads(); } while (0)
#define ATT_RESC(a) do { if (__any((a) < 1.f)) { if (hi == 0) al_l[r32] = (a); asm volatile("s_waitcnt lgkmcnt(0)" ::: "memory"); \
    _Pragma("unroll") for (int d = 0; d < 4; ++d) _Pragma("unroll") for (int r = 0; r < 16; ++r) o[d][r] *= al_l[crow(r, hi)]; } } while (0)
#define ATT_MASKARGS(t) (MASKABLE && (t) >= nA), (jB + 64 * ((t) - nA) - qi + 128 + 4 * hi)
  f32x16 pA0, pA1, pB0, pB1; float mnA, mnB, alA, alB; bf16x8 pa0, pa1, pa2, pa3; v8i pa8;
#define ATT_FIN(P0, P1, AL) do { if constexpr (VF8) finishSM8(P0, P1, AL, l_reg, pa8); else finishSM(P0, P1, AL, l_reg, pa0, pa1, pa2, pa3); } while (0)
#define ATT_PV(VOFF) do { if constexpr (VF8) pv8_d0(o, vp8 + (VOFF), pa8); else pv_d0(o, vbase + (VOFF), pa0, pa1, pa2, pa3); } while (0)
  int vprev = 0, vcur = SHMV, vnext = 2 * SHMV;
  ATT_LAND();
  ATT_QKT(pA0, pA1, K_lds); ATT_PSM(true, pA0, pA1, mnA, alA, ATT_MASKARGS(0));
  __syncthreads();
#ifdef ATT_PRIO_HALF
  if (wid >= 4) __builtin_amdgcn_s_setprio(1);
#endif
  for (int j = 1; j + 1 < NT; j += 2) {
    ATT_DMA(j + 1, 0, vnext);
    ATT_SBAR(); ATT_QKT(pB0, pB1, K_lds + SHM_K);
    ATT_FIN(pA0, pA1, alA); ATT_SBAR();
    ATT_PV(vprev); ATT_PSM(false, pB0, pB1, mnB, alB, ATT_MASKARGS(j));
    ATT_RESC(alB); ATT_LAND();
    { const int t_ = vprev; vprev = vcur; vcur = vnext; vnext = t_; }
    ATT_DMA(j + 2, 1, vnext);
    ATT_SBAR(); ATT_QKT(pA0, pA1, K_lds);
    ATT_FIN(pB0, pB1, alB); ATT_SBAR();
    ATT_PV(vprev); ATT_PSM(false, pA0, pA1, mnA, alA, ATT_MASKARGS(j + 1));
    ATT_RESC(alA); ATT_LAND();
    { const int t_ = vprev; vprev = vcur; vcur = vnext; vnext = t_; }
  }
  ATT_SBAR(); ATT_QKT(pB0, pB1, K_lds + SHM_K);
  ATT_FIN(pA0, pA1, alA); ATT_SBAR();
  ATT_PV(vprev); ATT_PSM(false, pB0, pB1, mnB, alB, ATT_MASKARGS(NT - 1));
  ATT_RESC(alB);
  ATT_FIN(pB0, pB1, alB); ATT_SBAR();
  ATT_PV(vcur);
#ifdef ATT_PRIO_HALF
  __builtin_amdgcn_s_setprio(0);
#endif
  l_reg += __builtin_amdgcn_exp2f(sink_l2 - m_reg * C + PL2);
  if (hi == 0) li_l[r32] = l_reg; asm volatile("s_waitcnt lgkmcnt(0)" ::: "memory");
  float rli[16];
#pragma unroll
  for (int r = 0; r < 16; ++r) rli[r] = __builtin_amdgcn_rcpf(li_l[crow(r, hi)]) * (VF8 ? (1.0f / 32.0f) : 1.0f);
  __syncthreads();
  if constexpr (OFP8) {
    char* ost = lds + wid * (32 * 144);
#pragma unroll
    for (int r = 0; r < 16; ++r) { const int orow = crow(r, hi);
#pragma unroll
      for (int d0 = 0; d0 < 4; ++d0) { const float v = o[d0][r] * rli[r] * 32.0f; const float vc = __builtin_amdgcn_fmed3f(v, -448.f, 448.f); const unsigned w = (unsigned)__builtin_amdgcn_cvt_pk_fp8_f32(vc, vc, 0, false);
        *(unsigned char*)(ost + orow * 144 + d0 * 32 + r32) = (unsigned char)(w & 0xffu); } }
    asm volatile("s_waitcnt lgkmcnt(0)" ::: "memory");
#pragma unroll
    for (int ps = 0; ps < 4; ++ps) { const int row = ps * 8 + (lane >> 3), c16 = lane & 7;
      const u32x4 w = *(const u32x4*)(ost + row * 144 + c16 * 16);
      *(u32x4*)((char*)Owave + (long)row * ldo + c16 * 16) = w; }
  } else {
  char* ost = lds + wid * (32 * OPITCH);
#pragma unroll
  for (int r = 0; r < 16; ++r) { const int orow = crow(r, hi);
#pragma unroll
    for (int d0 = 0; d0 < 4; ++d0) { const float v = o[d0][r] * rli[r]; unsigned u = __float_as_uint(v); u += 0x7fffu + ((u >> 16) & 1u);
      *(unsigned short*)(ost + orow * OPITCH + (d0 * 32 + r32) * 2) = (unsigned short)(u >> 16); } }
  asm volatile("s_waitcnt lgkmcnt(0)" ::: "memory");
#pragma unroll
  for (int ps = 0; ps < 8; ++ps) { const int row = ps * 4 + (lane >> 4), c16 = lane & 15;
    const u32x4 w = *(const u32x4*)(ost + row * OPITCH + c16 * 16);
    *(u32x4*)(Owave + (long)row * ldo + c16 * 8) = w; }
  }
  __syncthreads();
#undef ATT_TROW
#undef ATT_DMA
#undef ATT_QKT
#undef ATT_PSM
#undef ATT_FIN
#undef ATT_PV
#undef ATT_LAND
#undef ATT_RESC
#undef ATT_MASKARGS
}
}

#define LAS __attribute__((address_space(3)))
#define XB_TMO      128
#define XB_XCNT(j)  (256  + 64 * (j))
#define XB_XSUB(j)  (1280 + 64 * (j))
#define XB_XGEN(j)  (2304 + 64 * (j))
#define XB_TOP      3328
#define XB_TOPGEN   3392
#define XCD_BAR_WORDS 3456
#define XB_SPIN_CAP (1u << 18)

__device__ __forceinline__ unsigned xb_ld(unsigned* p)              { return __hip_atomic_load(p, __ATOMIC_RELAXED, __HIP_MEMORY_SCOPE_AGENT); }
__device__ __forceinline__ unsigned xb_add(unsigned* p, unsigned v) { return __hip_atomic_fetch_add(p, v, __ATOMIC_RELAXED, __HIP_MEMORY_SCOPE_AGENT); }
__device__ __forceinline__ unsigned xb_xcc_id() { return (unsigned)__builtin_amdgcn_s_getreg((3 << 11) | 20) & 0xFu; }
#define XB_SPIN(cond, bar) do { unsigned _sp = 0; while (cond) { __builtin_amdgcn_s_sleep(1); \
    if ((++_sp & 255u) == 0u) { if (xb_ld(&(bar)[XB_TMO])) break; if (_sp > XB_SPIN_CAP) { atomicAdd(&(bar)[XB_TMO], 1u); break; } } } } while (0)

struct XcdBarrier {
    unsigned* bar; unsigned x;
    volatile LAS unsigned* st;
};

__device__ __forceinline__ XcdBarrier xcd_barrier_post(unsigned* bar, volatile LAS unsigned* st) {
    XcdBarrier b; b.bar = bar; b.x = xb_xcc_id(); b.st = st;
    if (threadIdx.x == 0) (void)xb_add(&bar[XB_XCNT(b.x)], 1u);
    return b;
}
__device__ __forceinline__ void xcd_barrier_complete(unsigned* bar, unsigned x, unsigned& nloc, unsigned& nx) {
    const unsigned G = gridDim.x * gridDim.y * gridDim.z;
    unsigned sum, cnt, mine, sp = 0u;
    for (;;) {
        sum = 0u; cnt = 0u; mine = 0u;
#pragma unroll
        for (unsigned j = 0; j < 16; ++j) { const unsigned c = xb_ld(&bar[XB_XCNT(j)]); sum += c; cnt += (c > 0u) ? 1u : 0u; mine = (j == x) ? c : mine; }
        if (sum == G) break;
        __builtin_amdgcn_s_sleep(1);
        if ((++sp & 255u) == 0u) { if (xb_ld(&bar[XB_TMO])) break; if (sp > XB_SPIN_CAP) { atomicAdd(&bar[XB_TMO], 1u); break; } }
    }
    nloc = mine > 0u ? mine : 1u; nx = cnt > 0u ? cnt : 1u;
}

__device__ __forceinline__ void xcd_barrier(const XcdBarrier& b) {
    asm volatile("s_waitcnt vmcnt(0)" ::: "memory");
    __syncthreads();
    if (threadIdx.x == 0) {
        unsigned* bar = b.bar;
        __builtin_amdgcn_s_waitcnt(0);
        unsigned nloc = b.st[0], nx = b.st[1];
        if (nloc == 0u) { xcd_barrier_complete(bar, b.x, nloc, nx); b.st[0] = nloc; b.st[1] = nx; }
        const unsigned old = xb_add(&bar[XB_XSUB(b.x)], 1u);
        const unsigned gen = old / nloc;
        if (old + 1u == (gen + 1u) * nloc) {
            __builtin_amdgcn_fence(__ATOMIC_RELEASE, "agent");
            asm volatile("s_waitcnt vmcnt(0)" ::: "memory");
            const unsigned og = xb_add(&bar[XB_TOP], 1u);
            const unsigned tg = og / nx;
            if (og + 1u == (tg + 1u) * nx) xb_add(&bar[XB_TOPGEN], 1u);
            else XB_SPIN(xb_ld(&bar[XB_TOPGEN]) == tg, bar);
            __builtin_amdgcn_fence(__ATOMIC_ACQUIRE, "agent");
            xb_add(&bar[XB_XGEN(b.x)], 1u);
            asm volatile("s_waitcnt vmcnt(0)" ::: "memory");
        } else {
            XB_SPIN(xb_ld(&bar[XB_XGEN(b.x)]) == gen, bar);
            __builtin_amdgcn_fence(__ATOMIC_ACQUIRE, "agent");
            asm volatile("s_waitcnt vmcnt(0)" ::: "memory");
        }
    }
    __syncthreads();
}
#ifndef QUP_I8
#define QUP_I8 0
#endif
#ifndef UP_SUBSTAT
#define UP_SUBSTAT 1
#endif
#ifndef FFN_SORT
#define FFN_SORT 1
#endif
#ifndef UP_I8
#define UP_I8 1
#endif
#ifndef GQ_FP8
#define GQ_FP8 1
#endif
#ifndef W_TAIL3
#define W_TAIL3 1
#endif
#ifndef TAP_FOLD
#define TAP_FOLD 1
#endif
#ifndef UP_TAIL
#define UP_TAIL 0
#endif
#ifndef UPT_A
#define UPT_A 13000
#endif
#ifndef UPT_B
#define UPT_B 15000
#endif
#ifndef DOWN_TAIL
#define DOWN_TAIL 1
#endif
#ifndef KV_FUSE
#define KV_FUSE 1
#endif
#ifndef KVUP_I8
#define KVUP_I8 1
#endif
#ifndef KVUP_FP8
#define KVUP_FP8 1
#endif
#ifndef DOWN_NT8
#define DOWN_NT8 74
#endif
constexpr int DM = 4096, NPROMPT = 16, SEQ = 256, NLAT = 8, LSEQ = 4096, PAST = 256;
constexpr int TP = NPROMPT * SEQ;
constexpr int TL = NLAT * LSEQ;
constexpr int MTOK = TP + TL;
constexpr int KVROWS = TP + NLAT * (PAST + LSEQ);
constexpr int QRANK = 1024, KVRANK = 512, ROPED = 64, MLAH = 16, MLAQK = 192, GQH = 16, GKVH = 4, GHD = 128, DFF = 11008;
constexpr int INC = 4672, INCP = 4864;
constexpr int ZBW = 1792, ZQW = 3072;
constexpr int ZKV = 0, ZPE = 512, ZGK = 576, ZGV = 1088, ZQ = 0, ZGQ = 1024;
constexpr int NMOD = 9;
constexpr int KSPLIT = 32;
constexpr float EPS = 1e-6f;
constexpr int GK8 = DOWN_NT8 * 128;
constexpr int GPB = GK8 + (DFF - GK8) * 2;
constexpr float SG8 = 4.0f, SW8 = 256.0f;
static_assert(DOWN_NT8 % 2 == 0 && GK8 <= DFF && ((DFF - GK8) / 64) % 2 == 0, "mixed-K split");

constexpr size_t MiB = 1u << 20;
constexpr size_t WS_CTL = 0, CTL_ZERO_BYTES = 1 * MiB;
constexpr size_t WS_MOD = 1 * MiB;
constexpr size_t WS_ROPE16 = WS_MOD + 900 * 1024;
constexpr size_t WS_ROPE32 = WS_ROPE16 + 8192;
constexpr size_t WS_COLSC = WS_MOD + 928 * 1024;
constexpr size_t WS_COLMAX = 256 * 1024;
constexpr size_t WS_ROWSC = 2 * MiB;
constexpr size_t WS_MODP = 2 * MiB;
constexpr size_t WS_WIN = 32 * MiB;
constexpr size_t WS_WINQ = 48 * MiB;
constexpr size_t WS_WQUP = 70 * MiB;
constexpr size_t WS_RANK = 73 * MiB;
constexpr size_t WS_SIGMA = WS_RANK + 64 * 1024, WS_CWP = WS_RANK + 128 * 1024, WS_CBP = WS_RANK + 512 * 1024;
constexpr size_t WS_WKVUP = 76 * MiB;
constexpr size_t WS_WOUT = 80 * MiB;
constexpr size_t WS_WUP = 112 * MiB;
constexpr size_t WS_WDOWN = 284 * MiB;
constexpr size_t WS_HB = 370 * MiB;
constexpr size_t WS_Z = 658 * MiB;
constexpr size_t WS_ZB = 874 * MiB;
constexpr size_t WS_K8 = 874 * MiB;
constexpr size_t WS_H8 = 1116 * MiB;
constexpr size_t WS_QRAW = 658 * MiB;
constexpr size_t WS_QN = 1000 * MiB;
constexpr size_t WS_CKV = 1072 * MiB;
constexpr size_t WS_KPE = 1110 * MiB;
constexpr size_t WS_CKVS = WS_KPE + 5 * MiB;
constexpr size_t WS_KPESS = WS_CKVS + 256 * 1024;
constexpr size_t WS_KVCOLMAX = 448 * 1024;
constexpr size_t WS_KVCS = WS_RANK + 640 * 1024;
constexpr size_t WS_KB = 1116 * MiB;
constexpr size_t WS_VB = 1344 * MiB;
constexpr size_t WS_GQ = 1496 * MiB;
constexpr size_t WS_GK = 1640 * MiB;
constexpr size_t WS_GV = 1678 * MiB;
constexpr size_t WS_G = 658 * MiB;
constexpr size_t WS_EDGE = 1432 * MiB;
constexpr size_t WS_VT8 = 1716 * MiB;
constexpr size_t WS_X1 = 1716 * MiB;
constexpr size_t WS_END = 2004 * MiB;
static_assert(WS_G + (size_t)MTOK * DFF * 2 <= WS_EDGE && WS_EDGE + (size_t)576 * 4 * 22016 * 4 <= WS_END, "ws map");
static_assert(WS_KB + (size_t)KVROWS * 3072 * 2 <= WS_VB && WS_VB + (size_t)KVROWS * 2048 * 2 <= WS_GQ && WS_GQ + (size_t)MTOK * 2048 * 2 <= WS_GK && WS_GK + (size_t)KVROWS * 512 * 2 <= WS_GV && WS_GV + (size_t)KVROWS * 512 * 2 <= WS_END, "ws map 2");
static_assert(WS_Z + (size_t)MTOK * ZQW * 2 <= WS_ZB && WS_ZB + (size_t)MTOK * ZBW * 2 <= WS_QN && WS_QN + (size_t)MTOK * 1024 * 2 <= WS_CKV && WS_CKV + (size_t)KVROWS * 512 * 2 <= WS_KPE && WS_KPE + (size_t)KVROWS * 64 * 2 <= WS_KB, "ws map 3");
static_assert(WS_HB + (size_t)MTOK * DM * 2 <= WS_Z && WS_WDOWN + (size_t)DM * DFF * 2 <= WS_HB && WS_WUP + (size_t)22016 * DM * 2 <= WS_WDOWN && WS_WIN + (size_t)ZBW * DM * 2 <= WS_WINQ && WS_WINQ + (size_t)ZQW * DM <= WS_WQUP, "ws map 4");
constexpr int CW_BAR = 4096;

constexpr size_t OUT_Y = 0, OUT_CKV = (size_t)MTOK * DM, OUT_KPE = OUT_CKV + (size_t)TP * KVRANK, OUT_GK = OUT_KPE + (size_t)TP * ROPED, OUT_GV = OUT_GK + (size_t)TP * 512, OUT_END = OUT_GV + (size_t)TP * 512;

constexpr int RING_OFF = 0, RING_BYTES = 131072;
constexpr int MISC_OFF = RING_BYTES + 320;
constexpr int LDS_BYTES = 147456;
constexpr int NWAVES = 8, NTHREADS = 512;
#ifndef MK_ONE_LAUNCH
#define MK_ONE_LAUNCH 1
#endif
constexpr int N_PHASES = 13;
#ifndef ATT_VF8
#define ATT_VF8 1
#endif
#ifndef ATT_KF8
#define ATT_KF8 1
#endif
#ifndef QUP_FP8
#define QUP_FP8 1
#endif
#ifndef MIX_FP8
#define MIX_FP8 1
#endif
#ifndef PROBE_GSCALE
#define PROBE_GSCALE 1.0f
#endif
#ifndef PROBE_GSCALE2
#define PROBE_GSCALE2 1.0f
#endif
#ifndef W_P10
#define W_P3B 4
#define W_P3Q 4
#define W_P5K 4
#define W_P5Q 4
#define W_P8 4
#define W_P10 4
#define W_P12 4
#endif
#ifndef GEMM_ALIGN
#define GEMM_ALIGN true
#endif
#ifndef GEMM_SP2
#define GEMM_SP2 true
#endif

#define LAS __attribute__((address_space(3)))
typedef unsigned short bf16;
typedef unsigned v4u __attribute__((ext_vector_type(4)));
typedef unsigned v2u __attribute__((ext_vector_type(2)));
typedef float f32x4 __attribute__((ext_vector_type(4)));
typedef short bf16x8 __attribute__((ext_vector_type(8)));
#define LDS_WAIT() asm volatile("s_waitcnt lgkmcnt(0)" ::: "memory")
__device__ __forceinline__ unsigned f2bf(float f) { unsigned u = __builtin_bit_cast(unsigned, f); return (u + 0x7fffu + ((u >> 16) & 1u)) >> 16; }
__device__ __forceinline__ unsigned pk2(float lo, float hi) { return f2bf(lo) | (f2bf(hi) << 16); }
__device__ __forceinline__ float bflo(unsigned w) { return __uint_as_float(w << 16); }
__device__ __forceinline__ float bfhi(unsigned w) { return __uint_as_float(w & 0xffff0000u); }
__device__ __forceinline__ void unpack8(const v4u w, float (&x)[8]) { x[0] = bflo(w.x); x[1] = bfhi(w.x); x[2] = bflo(w.y); x[3] = bfhi(w.y); x[4] = bflo(w.z); x[5] = bfhi(w.z); x[6] = bflo(w.w); x[7] = bfhi(w.w); }
__device__ __forceinline__ v4u pack8(const float (&x)[8]) { v4u w; w.x = pk2(x[0], x[1]); w.y = pk2(x[2], x[3]); w.z = pk2(x[4], x[5]); w.w = pk2(x[6], x[7]); return w; }
__device__ __forceinline__ float wave_sum(float v) {
#pragma unroll
    for (int o = 1; o < 64; o <<= 1) v += __shfl_xor(v, o);
    return v;
}
__device__ __forceinline__ float silu_f(float a) { return a / (1.0f + __expf(-a)); }

struct Args { const float* in[27]; float* out; unsigned char* ws; int ph_lo, ph_hi; };

__device__ __forceinline__ int kvrow_of(int t) { if (t < TP) return t; const int u = t - TP, b = u >> 12, s = u & 4095; return TP + b * (PAST + LSEQ) + PAST + s; }

__device__ __forceinline__ void p0_load_block(const float* W, int N, const unsigned* srcrow, int k0, int n0, LAS float* scr, int lane) {
    f32x4 v[8];
#pragma unroll
    for (int i = 0; i < 8; ++i) { const int kk = 8 * i + (lane >> 3); const size_t sr = srcrow ? (size_t)srcrow[k0 + kk] : (size_t)(k0 + kk); v[i] = *(const f32x4*)(W + sr * N + n0 + 4 * (lane & 7)); }
#pragma unroll
    for (int i = 0; i < 8; ++i) { LAS float* d = scr + (8 * i + (lane >> 3)) * 33 + 4 * (lane & 7); d[0] = v[i].x; d[1] = v[i].y; d[2] = v[i].z; d[3] = v[i].w; }
}
template <class DMap>
__device__ __forceinline__ void p0_transpose_item(const float* W, int K, int N, bf16* WT, const DMap& dmap, LAS float* scr, int item, int lane, const unsigned* srcrow = nullptr) {
    const int nblk = N / 32, kb = item / nblk, nb = item % nblk, k0 = 64 * kb, n0 = 32 * nb;
    p0_load_block(W, N, srcrow, k0, n0, scr, lane);
    LDS_WAIT(); asm volatile("" ::: "memory");
    const int c = lane & 7; const int r0 = dmap(n0);
#pragma unroll
    for (int j = 0; j < 4; ++j) { const int n = (lane >> 3) + 8 * j; const LAS float* s = scr + (8 * c) * 33 + n;
        v4u o; o.x = pk2(s[0 * 33], s[1 * 33]); o.y = pk2(s[2 * 33], s[3 * 33]); o.z = pk2(s[4 * 33], s[5 * 33]); o.w = pk2(s[6 * 33], s[7 * 33]);
        *(v4u*)(WT + (size_t)(r0 + n) * K + k0 + 8 * c) = o; }
    LDS_WAIT(); asm volatile("" ::: "memory");
}
__device__ __forceinline__ void p0_transpose_item_fp8(const float* W, int K, int N, unsigned char* WT, LAS float* scr, int item, int lane, int row_shift = 0, const unsigned* srcrow = nullptr) {
    const int nblk = N / 32, kb = item / nblk, nb = item % nblk, k0 = 64 * kb, n0 = 32 * nb;
    p0_load_block(W, N, srcrow, k0, n0, scr, lane);
    LDS_WAIT(); asm volatile("" ::: "memory");
    const int c = lane & 3;
#pragma unroll
    for (int j = 0; j < 2; ++j) { const int n = (lane >> 2) + 16 * j; const LAS float* s = scr + (16 * c) * 33 + n; unsigned w[4];
#pragma unroll
        for (int q = 0; q < 4; ++q) { int t = 0; t = cvt_pk_fp8_sat(s[(4 * q) * 33] * 256.f, s[(4 * q + 1) * 33] * 256.f, t, false); t = cvt_pk_fp8_sat(s[(4 * q + 2) * 33] * 256.f, s[(4 * q + 3) * 33] * 256.f, t, true); w[q] = (unsigned)t; }
        v4u o; o.x = w[0]; o.y = w[1]; o.z = w[2]; o.w = w[3];
        *(v4u*)(WT + (size_t)(n0 + n + row_shift) * K + k0 + 16 * c) = o; }
    LDS_WAIT(); asm volatile("" ::: "memory");
}
__device__ __forceinline__ void p0_colmax_item(const float* W, int N, unsigned* colmax, int item, int lane) {
    const int nblk = N / 32, kb = item / nblk, nb = item % nblk, k0 = 64 * kb, n0 = 32 * nb; f32x4 v[8]; f32x4 mx = (f32x4){0.f, 0.f, 0.f, 0.f};
#pragma unroll
    for (int i = 0; i < 8; ++i) v[i] = *(const f32x4*)(W + (size_t)(k0 + 8 * i + (lane >> 3)) * N + n0 + 4 * (lane & 7));
#pragma unroll
    for (int i = 0; i < 8; ++i) { mx.x = fmaxf(mx.x, fabsf(v[i].x)); mx.y = fmaxf(mx.y, fabsf(v[i].y)); mx.z = fmaxf(mx.z, fabsf(v[i].z)); mx.w = fmaxf(mx.w, fabsf(v[i].w)); }
#pragma unroll
    for (int o = 8; o < 64; o <<= 1) { mx.x = fmaxf(mx.x, __shfl_xor(mx.x, o)); mx.y = fmaxf(mx.y, __shfl_xor(mx.y, o)); mx.z = fmaxf(mx.z, __shfl_xor(mx.z, o)); mx.w = fmaxf(mx.w, __shfl_xor(mx.w, o)); }
    if (lane < 8) { unsigned* c = colmax + n0 + 4 * lane; atomicMax(c, __float_as_uint(mx.x)); atomicMax(c + 1, __float_as_uint(mx.y)); atomicMax(c + 2, __float_as_uint(mx.z)); atomicMax(c + 3, __float_as_uint(mx.w)); }
}
__device__ __forceinline__ void p0_colss_item(const float* W, int N, unsigned long long* colss, int item, int lane) {
    const int nblk = N / 32, kb = item / nblk, nb = item % nblk, k0 = 64 * kb, n0 = 32 * nb; f32x4 v[8]; f32x4 ss = (f32x4){0.f, 0.f, 0.f, 0.f};
#pragma unroll
    for (int i = 0; i < 8; ++i) v[i] = *(const f32x4*)(W + (size_t)(k0 + 8 * i + (lane >> 3)) * N + n0 + 4 * (lane & 7));
#pragma unroll
    for (int i = 0; i < 8; ++i) ss += v[i] * v[i];
#pragma unroll
    for (int o = 8; o < 64; o <<= 1) { ss.x += __shfl_xor(ss.x, o); ss.y += __shfl_xor(ss.y, o); ss.z += __shfl_xor(ss.z, o); ss.w += __shfl_xor(ss.w, o); }
    if (lane < 8) { unsigned long long* c = colss + n0 + 4 * lane; atomicAdd(c, (unsigned long long)(ss.x * 1099511627776.0f)); atomicAdd(c + 1, (unsigned long long)(ss.y * 1099511627776.0f));
        atomicAdd(c + 2, (unsigned long long)(ss.z * 1099511627776.0f)); atomicAdd(c + 3, (unsigned long long)(ss.w * 1099511627776.0f)); }
}
template <class DMap, bool EXACT = false>
__device__ __forceinline__ void p0_transpose_item_i8(const float* W, int K, int N, signed char* WT, const DMap& dmap, const unsigned* colmax, float* colscale, LAS float* scr, int item, int lane, float fixed_cm = 0.15875f) {
    const int nblk = N / 32, kb = item / nblk, nb = item % nblk, k0 = 64 * kb, n0 = 32 * nb;
    p0_load_block(W, N, nullptr, k0, n0, scr, lane);
    LDS_WAIT(); asm volatile("" ::: "memory");
    const int c = lane & 3;
#pragma unroll
    for (int j = 0; j < 2; ++j) { const int n = (lane >> 2) + 16 * j; const LAS float* s = scr + (16 * c) * 33 + n; const int r0 = dmap(n0 + n) - n;
        const float cm = colmax ? ((UP_SUBSTAT && !EXACT) ? 4.2f * sqrtf((float)((const unsigned long long*)colmax)[n0 + n] * (1.0f / 1099511627776.0f) * (1.0f / 512.0f)) : __uint_as_float(colmax[n0 + n])) : fixed_cm; const float inv = cm > 0.f ? 127.0f / cm : 0.f; unsigned w[4];
#pragma unroll
        for (int q = 0; q < 4; ++q) { unsigned t = 0;
#pragma unroll
            for (int e = 0; e < 4; ++e) { int v = (int)__builtin_rintf(s[(4 * q + e) * 33] * inv); v = v > 127 ? 127 : (v < -127 ? -127 : v); t |= ((unsigned)v & 0xffu) << (8 * e); }
            w[q] = t; }
        *(v4u*)(WT + (size_t)(r0 + n) * K + k0 + 16 * c) = (v4u){w[0], w[1], w[2], w[3]};
        if (colscale && kb == 0 && c == 0) colscale[r0 + n] = cm * (1.0f / 127.0f); }
    LDS_WAIT(); asm volatile("" ::: "memory");
}
struct MapId { __device__ __forceinline__ int operator()(int n) const { return n; } };
template <class DMap>
__device__ __forceinline__ void p0_transpose_item_fp8m(const float* W, int K, int N, unsigned char* WT, const DMap& dmap, LAS float* scr, int item, int lane) {
    const int nblk = N / 32, kb = item / nblk, nb = item % nblk, k0 = 64 * kb, n0 = 32 * nb;
    p0_load_block(W, N, nullptr, k0, n0, scr, lane);
    LDS_WAIT(); asm volatile("" ::: "memory");
    const int c = lane & 3; const int r0 = dmap(n0);
#pragma unroll
    for (int j = 0; j < 2; ++j) { const int n = (lane >> 2) + 16 * j; const LAS float* s = scr + (16 * c) * 33 + n; unsigned w[4];
#pragma unroll
        for (int q = 0; q < 4; ++q) { int t = 0; t = cvt_pk_fp8_sat(s[(4 * q) * 33] * 256.f, s[(4 * q + 1) * 33] * 256.f, t, false); t = cvt_pk_fp8_sat(s[(4 * q + 2) * 33] * 256.f, s[(4 * q + 3) * 33] * 256.f, t, true); w[q] = (unsigned)t; }
        *(v4u*)(WT + (size_t)(r0 + n) * K + k0 + 16 * c) = (v4u){w[0], w[1], w[2], w[3]}; }
    LDS_WAIT(); asm volatile("" ::: "memory");
}
struct MapShift { int sh; __device__ __forceinline__ int operator()(int n) const { return n + sh; } };
struct MapUpPerm { const unsigned* rank; __device__ __forceinline__ int operator()(int n) const { const int v = n >= DFF, c = n - v * DFF; const int p = (int)rank[c]; return (p >> 7) * 256 + v * 128 + (p & 127); } };
struct MapUp { __device__ __forceinline__ int operator()(int n) const { const int v = n >= DFF, c = n - v * DFF; return (c >> 7) * 256 + v * 128 + (c & 127); } };

__device__ __forceinline__ void phase0(const Args& a, LAS unsigned char* lds, int vcu, int G) {
    const int tid = threadIdx.x, lane = tid & 63, wave = __builtin_amdgcn_readfirstlane(tid >> 6);
    LAS float* scr = (LAS float*)(lds + RING_OFF + wave * 16384);
    const int gw = vcu * NWAVES + wave, NGW = G * NWAVES;
    unsigned char* ws = a.ws;
    if (FFN_SORT) {
        const float* cw = a.in[24]; LAS float* e = (LAS float*)(lds + RING_OFF);
        for (int k = tid; k < DFF; k += NTHREADS) { const float a0 = cw[k], a1 = cw[22016 + k], a2 = cw[2 * 22016 + k], b0 = cw[DFF + k], b1 = cw[22016 + DFF + k], b2 = cw[2 * 22016 + DFF + k];
            e[k] = (a0 * a0 + a1 * a1 + a2 * a2) * (b0 * b0 + b1 * b1 + b2 * b2); }
        __syncthreads();
        unsigned* rank = (unsigned*)(ws + WS_RANK); unsigned* sigma = (unsigned*)(ws + WS_SIGMA);
        for (int k = gw; k < DFF; k += NGW) { const float ek = e[k]; int cnt = 0;
            for (int j = lane; j < DFF; j += 64) { const float ej = e[j]; cnt += (ej < ek || (ej == ek && j < k)) ? 1 : 0; }
#pragma unroll
            for (int o = 1; o < 64; o <<= 1) cnt += __shfl_xor(cnt, o);
            if (lane == 0) { rank[k] = (unsigned)cnt; sigma[cnt] = (unsigned)k; } }
        __syncthreads();
    }
    {
        const float* cvec = a.in[6]; const float* cctx = a.in[7]; const float* wada = a.in[10];
        float* modp = (float*)(ws + WS_MODP);
        for (int task = gw; task < 96 * KSPLIT; task += NGW) {
            const int cg = task % 96, ks = task / 96, k0 = ks * 128;
            for (int i = lane; i < NMOD * 128; i += 64) { const int r = i >> 7, kk = i & 127; const float v = (r < 8) ? cvec[r * DM + k0 + kk] : cctx[k0 + kk]; scr[i] = silu_f(v); }
            LDS_WAIT(); asm volatile("" ::: "memory");
            f32x4 acc[NMOD];
#pragma unroll
            for (int r = 0; r < NMOD; ++r) acc[r] = (f32x4){0.f, 0.f, 0.f, 0.f};
            const float* wp = wada + (size_t)k0 * 24576 + cg * 256 + lane * 4;
#pragma unroll 4
            for (int kk = 0; kk < 128; ++kk) { const f32x4 w = *(const f32x4*)(wp + (size_t)kk * 24576);
#pragma unroll
                for (int r = 0; r < NMOD; ++r) acc[r] += w * scr[r * 128 + kk]; }
#pragma unroll
            for (int r = 0; r < NMOD; ++r) *(f32x4*)(modp + ((size_t)ks * NMOD + r) * 24576 + cg * 256 + lane * 4) = acc[r];
            LDS_WAIT(); asm volatile("" ::: "memory");
        }
    }
    {
        constexpr int I_IN = (DM / 64) * (INC / 32), I_QUP = (QRANK / 64) * (3072 / 32), I_KVUP = (KVRANK / 64) * (4096 / 32), I_OUT = (DM / 64) * (DM / 32), I_UP = (DM / 64) * (22016 / 32), I_DOWN = (DFF / 64) * (DM / 32);
        constexpr int NITEMS = I_IN + I_QUP + I_KVUP + I_OUT + I_UP + I_DOWN;
        for (int it = gw; it < NITEMS; it += NGW) {
            int r = it;
            if (r < I_IN) { const int n0 = 32 * (r % (INC / 32));
                if (n0 < 1024) p0_transpose_item_fp8(a.in[12], DM, INC, (unsigned char*)(ws + WS_WINQ), scr, r, lane, 0);
                else if (n0 < 1536) p0_transpose_item(a.in[12], DM, INC, (bf16*)(ws + WS_WIN), MapShift{ZKV - 1024}, scr, r, lane);
                else if (n0 < 1600) p0_transpose_item(a.in[12], DM, INC, (bf16*)(ws + WS_WIN), MapShift{ZPE - 1536}, scr, r, lane);
                else if (n0 < 3648) p0_transpose_item_fp8(a.in[12], DM, INC, (unsigned char*)(ws + WS_WINQ), scr, r, lane, ZGQ - 1600);
                else if (n0 < 4160) p0_transpose_item(a.in[12], DM, INC, (bf16*)(ws + WS_WIN), MapShift{ZGK - 3648}, scr, r, lane);
                else p0_transpose_item(a.in[12], DM, INC, (bf16*)(ws + WS_WIN), MapShift{ZGV - 4160}, scr, r, lane);
                continue; } r -= I_IN;
            if (r < I_QUP) { if (W_TAIL3 && QUP_FP8 && !QUP_I8 && MIX_FP8) continue; if (QUP_I8) p0_transpose_item_i8(a.in[14], QRANK, 3072, (signed char*)(ws + WS_WQUP), MapId(), nullptr, nullptr, scr, r, lane); else if (QUP_FP8) p0_transpose_item_fp8(a.in[14], QRANK, 3072, (unsigned char*)(ws + WS_WQUP), scr, r, lane); else p0_transpose_item(a.in[14], QRANK, 3072, (bf16*)(ws + WS_WQUP), MapId(), scr, r, lane); continue; } r -= I_QUP;
            if (r < I_KVUP) { if (KVUP_I8) p0_colmax_item(a.in[16], 4096, (unsigned*)(ws + WS_KVCOLMAX), r, lane); else if (KVUP_FP8) p0_transpose_item_fp8(a.in[16], KVRANK, 4096, (unsigned char*)(ws + WS_WKVUP), scr, r, lane); else p0_transpose_item(a.in[16], KVRANK, 4096, (bf16*)(ws + WS_WKVUP), MapId(), scr, r, lane); continue; } r -= I_KVUP;
            if (r < I_OUT) { if (W_TAIL3 && QUP_FP8 && !QUP_I8 && MIX_FP8) continue; if (MIX_FP8) p0_transpose_item_fp8(a.in[22], DM, DM, (unsigned char*)(ws + WS_WOUT), scr, r, lane); else p0_transpose_item(a.in[22], DM, DM, (bf16*)(ws + WS_WOUT), MapId(), scr, r, lane); continue; } r -= I_OUT;
#if defined(PROBE_UPF8W)
            if (r < I_UP) { p0_transpose_item_fp8m(a.in[23], DM, 22016, (unsigned char*)(ws + WS_WUP), MapUp(), scr, r, lane); continue; }
#endif
#if defined(PROBE_P0CONV)
            if (r < I_UP) { p0_transpose_item_i8(a.in[23], DM, 22016, (signed char*)(ws + WS_WUP), MapUp(), nullptr, (float*)(ws + WS_COLSC), scr, r, lane, 0.085f); continue; }
#endif
            if (r < I_UP) { if (UP_I8 && UP_SUBSTAT) { if (r < 8 * (22016 / 32)) p0_colss_item(a.in[23], 22016, (unsigned long long*)(ws + WS_COLMAX), r, lane); } else if (UP_I8) p0_colmax_item(a.in[23], 22016, (unsigned*)(ws + WS_COLMAX), r, lane); else p0_transpose_item(a.in[23], DM, 22016, (bf16*)(ws + WS_WUP), MapUp(), scr, r, lane); continue; } r -= I_UP;
            if (FFN_SORT) continue;
            { const int k0 = 64 * (r / (DM / 32));
              if (k0 < GK8) p0_transpose_item_fp8(a.in[26], GPB, DM, (unsigned char*)(ws + WS_WDOWN), scr, r, lane, 0);
              else p0_transpose_item(a.in[26], GPB / 2, DM, (bf16*)(ws + WS_WDOWN) - GK8 / 2, MapId(), scr, r, lane); }
        }
        v4u* pz = (v4u*)((bf16*)(ws + WS_WIN) + (size_t)1600 * DM); const size_t nz = (size_t)(ZBW - 1600) * DM * 2 / 16;
        for (size_t i = (size_t)vcu * NTHREADS + tid; i < nz; i += (size_t)G * NTHREADS) pz[i] = (v4u){0u, 0u, 0u, 0u};
    }
}
__device__ __forceinline__ void phase1(const Args& a, LAS unsigned char* lds, int vcu, int G) {
    const int tid = threadIdx.x; unsigned char* ws = a.ws;
#if defined(PROBE_P0CONV)
    if (false) {
#else
    if (UP_I8 && !(UP_TAIL && FFN_SORT)) {
#endif
        const int lane = tid & 63, wave = __builtin_amdgcn_readfirstlane(tid >> 6); LAS float* scr = (LAS float*)(lds + RING_OFF + wave * 16384);
        for (int it = vcu * NWAVES + wave; it < (DM / 64) * (22016 / 32); it += G * NWAVES)
#if defined(PROBE_FIXEDCOL)
            p0_transpose_item_i8(a.in[23], DM, 22016, (signed char*)(ws + WS_WUP), MapUp(), nullptr, (float*)(ws + WS_COLSC), scr, it, lane, 0.085f);
#else
            if (FFN_SORT) p0_transpose_item_i8(a.in[23], DM, 22016, (signed char*)(ws + WS_WUP), MapUpPerm{(const unsigned*)(ws + WS_RANK)}, (const unsigned*)(ws + WS_COLMAX), (float*)(ws + WS_COLSC), scr, it, lane);
            else p0_transpose_item_i8(a.in[23], DM, 22016, (signed char*)(ws + WS_WUP), MapUp(), (const unsigned*)(ws + WS_COLMAX), (float*)(ws + WS_COLSC), scr, it, lane);
#endif
    }
    if (KVUP_I8) {
        const int lane = tid & 63, wave = __builtin_amdgcn_readfirstlane(tid >> 6); LAS float* scr = (LAS float*)(lds + RING_OFF + wave * 16384);
        for (int it = vcu * NWAVES + wave; it < (KVRANK / 64) * (4096 / 32); it += G * NWAVES)
            p0_transpose_item_i8<MapId, true>(a.in[16], KVRANK, 4096, (signed char*)(ws + WS_WKVUP), MapId(), (const unsigned*)(ws + WS_KVCOLMAX), (float*)(ws + WS_KVCS), scr, it, lane);
    }
    if (FFN_SORT) {
        const int lane = tid & 63, wave = __builtin_amdgcn_readfirstlane(tid >> 6); LAS float* scr = (LAS float*)(lds + RING_OFF + wave * 16384); const unsigned* sigma = (const unsigned*)(ws + WS_SIGMA);
        if (!DOWN_TAIL)
        for (int it = vcu * NWAVES + wave; it < (DFF / 64) * (DM / 32); it += G * NWAVES) { const int k0 = 64 * (it / (DM / 32));
            if (k0 < GK8) p0_transpose_item_fp8(a.in[26], GPB, DM, (unsigned char*)(ws + WS_WDOWN), scr, it, lane, 0, sigma);
            else p0_transpose_item(a.in[26], GPB / 2, DM, (bf16*)(ws + WS_WDOWN) - GK8 / 2, MapId(), scr, it, lane, sigma); }
        const float* cw = a.in[24]; const float* cb = a.in[25]; float* cwp = (float*)(ws + WS_CWP); float* cbp = (float*)(ws + WS_CBP);
        for (int i = vcu * NTHREADS + tid; i < 2 * DFF; i += G * NTHREADS) { const int v = i >= DFF, pp = i - v * DFF; const int src = v * DFF + (int)sigma[pp];
            const float f = !TAP_FOLD ? 1.0f : (v ? (-0.6931471805599453f) * (pp < GK8 ? SG8 : 1.0f) : -1.4426950408889634f);
            cwp[i] = cw[src] * f; cwp[22016 + i] = cw[22016 + src] * f; cwp[2 * 22016 + i] = cw[2 * 22016 + src] * f; cbp[i] = cb[src] * f; }
    }
    const float* modp = (const float*)(ws + WS_MODP); float* mod = (float*)(ws + WS_MOD); const float* bada = a.in[11];
    for (int i = vcu * NTHREADS + tid; i < NMOD * 24576; i += G * NTHREADS) { const int n = i % 24576; float s = bada[n];
#pragma unroll 8
        for (int ks = 0; ks < KSPLIT; ++ks) s += modp[(size_t)ks * NMOD * 24576 + i];
        mod[i] = s; }
    const int gi = (G == 256) ? (tid < 12 ? vcu * 12 + tid : 1 << 30) : vcu * NTHREADS + tid;
    if (gi < 64 * 16 + 64 * 32) {
        const bool t32 = gi >= 64 * 16; const int idx = t32 ? gi - 64 * 16 : gi; const int half = t32 ? 32 : 16; const int pos = idx / half, j = idx % half;
        const double step = t32 ? 0.74989420933245582730 : 0.56234132519034908039;
        double inv = 1.0; for (int q = 0; q < j; ++q) inv *= step;
        double ang = (double)pos * (double)(float)inv;
        const double twopi = 6.283185307179586476925286766559;
        const double kq = __builtin_rint(ang * (1.0 / twopi)); double x = ang - kq * twopi; const double x2 = x * x;
        double sn = x, cs = 1.0, ts = x, tc = 1.0;
#pragma unroll
        for (int q = 1; q <= 14; ++q) { tc = -tc * x2 * (1.0 / (double)((2 * q - 1) * (2 * q))); cs += tc; ts = -ts * x2 * (1.0 / (double)((2 * q) * (2 * q + 1))); sn += ts; }
        float* tab = (float*)(ws + (t32 ? WS_ROPE32 : WS_ROPE16));
        tab[(size_t)idx * 2] = (float)cs; tab[(size_t)idx * 2 + 1] = (float)sn;
    }
}
template <bool XB>
__device__ __forceinline__ void phase_norm(const void* xp, const void* xs, const float* g, const float* mod, int off_shift, int off_scale, bf16* out, unsigned char* out8, float* rowscale, LAS unsigned char* lds, int vcu, int G) {
    const int tid = threadIdx.x, lane = tid & 63, wave = tid >> 6;
    LAS float* Av = (LAS float*)(lds + RING_OFF); LAS float* Bv = Av + DM;
    const int ntask = MTOK / 16, per = (ntask + G - 1) / G; int cur_mr = -1;
    for (int k = 0; k < per; ++k) { const int task = vcu * per + k; if (task >= ntask) break;
        const int t0 = task * 16; const int mr = t0 < TP ? 8 : ((t0 - TP) >> 12);
        if (mr != cur_mr) { __syncthreads();
            for (int c = tid; c < DM; c += NTHREADS) { Av[c] = g[c] * (1.0f + mod[(size_t)mr * 24576 + off_scale + c]); Bv[c] = mod[(size_t)mr * 24576 + off_shift + c]; }
            __syncthreads(); cur_mr = mr; }
#pragma unroll 1
        for (int i = 0; i < 2; ++i) { const int t = t0 + wave * 2 + i;
            f32x4 v[16]; float ss = 0.f;
            if constexpr (XB) { const bf16* xr = (const bf16*)xp + (size_t)t * DM;
#pragma unroll
                for (int q = 0; q < 8; ++q) { const v4u w = *(const v4u*)(xr + lane * 8 + 512 * q); v[2 * q] = (f32x4){bflo(w.x), bfhi(w.x), bflo(w.y), bfhi(w.y)}; v[2 * q + 1] = (f32x4){bflo(w.z), bfhi(w.z), bflo(w.w), bfhi(w.w)}; }
            } else { const float* xr = (t < TP) ? (const float*)xp + (size_t)t * DM : (const float*)xs + (size_t)(t - TP) * DM;
#pragma unroll
                for (int j = 0; j < 16; ++j) v[j] = *(const f32x4*)(xr + lane * 8 + 512 * (j >> 1) + 4 * (j & 1));
            }
#pragma unroll
            for (int j = 0; j < 16; ++j) ss += (v[j].x * v[j].x + v[j].y * v[j].y) + (v[j].z * v[j].z + v[j].w * v[j].w);
            const float r = 1.0f / sqrtf(wave_sum(ss) * (1.0f / DM) + EPS);
            if (rowscale) {
                float mx = 0.f;
#pragma unroll
                for (int j = 0; j < 16; ++j) { const int c = lane * 8 + 512 * (j >> 1) + 4 * (j & 1); const f32x4 av = *(const LAS f32x4*)(Av + c), bv = *(const LAS f32x4*)(Bv + c);
                    v[j] = (v[j] * r) * av + bv; mx = fmaxf(fmaxf(mx, fmaxf(fabsf(v[j].x), fabsf(v[j].y))), fmaxf(fabsf(v[j].z), fabsf(v[j].w)));
                    if ((j & 3) == 3) asm volatile("" ::: "memory"); }
#pragma unroll
                for (int o = 1; o < 64; o <<= 1) mx = fmaxf(mx, __shfl_xor(mx, o));
                const float inv = mx > 0.f ? 127.0f / mx : 0.f;
                if (lane == 0) rowscale[t] = mx * (1.0f / 127.0f);
#pragma unroll
                for (int q = 0; q < 8; ++q) { v2u o;
#define PN_Q8(vv) (((unsigned)(int)__builtin_rintf((vv).x * inv) & 0xffu) | (((unsigned)(int)__builtin_rintf((vv).y * inv) & 0xffu) << 8) | (((unsigned)(int)__builtin_rintf((vv).z * inv) & 0xffu) << 16) | (((unsigned)(int)__builtin_rintf((vv).w * inv)) << 24))
                    o.x = PN_Q8(v[2 * q]); o.y = PN_Q8(v[2 * q + 1]);
#undef PN_Q8
                    *(v2u*)(out8 + (size_t)t * DM + lane * 8 + 512 * q) = o; }
            } else {
            bf16* orow = out + (size_t)t * DM;
#pragma unroll
            for (int q = 0; q < 8; ++q) { const int c = lane * 8 + 512 * q;
                const f32x4 a0 = *(const LAS f32x4*)(Av + c), b0 = *(const LAS f32x4*)(Bv + c), a1 = *(const LAS f32x4*)(Av + c + 4), b1 = *(const LAS f32x4*)(Bv + c + 4);
                const f32x4 y0 = (v[2 * q] * r) * a0 + b0, y1 = (v[2 * q + 1] * r) * a1 + b1;
                v4u w; w.x = pk2(y0.x, y0.y); w.y = pk2(y0.z, y0.w); w.z = pk2(y1.x, y1.y); w.w = pk2(y1.z, y1.w); *(v4u*)(orow + c) = w;
                if (out8) { v2u o8; int tt = 0; tt = cvt_pk_fp8_sat(y0.x * 16.f, y0.y * 16.f, tt, false); tt = cvt_pk_fp8_sat(y0.z * 16.f, y0.w * 16.f, tt, true); o8.x = (unsigned)tt;
                    tt = 0; tt = cvt_pk_fp8_sat(y1.x * 16.f, y1.y * 16.f, tt, false); tt = cvt_pk_fp8_sat(y1.z * 16.f, y1.w * 16.f, tt, true); o8.y = (unsigned)tt;
                    *(v2u*)(out8 + (size_t)t * DM + c) = o8; }
                if (q & 1) asm volatile("" ::: "memory"); }
            }
        }
    }
    __syncthreads();
}
template <int CTRL> __device__ __forceinline__ float dppx(float v) { return __builtin_bit_cast(float, __builtin_amdgcn_update_dpp(0, __builtin_bit_cast(int, v), CTRL, 0xf, 0xf, true)); }
__device__ __forceinline__ float row16_sum(float v) { v += dppx<0xB1>(v); v += dppx<0x4E>(v); v += dppx<0x141>(v); v += dppx<0x140>(v); return v; }
__device__ __forceinline__ float wave_sum_rl(float v) { v = row16_sum(v); const int b = __builtin_bit_cast(int, v);
    return (__builtin_bit_cast(float, __builtin_amdgcn_readlane(b, 0)) + __builtin_bit_cast(float, __builtin_amdgcn_readlane(b, 16))) + (__builtin_bit_cast(float, __builtin_amdgcn_readlane(b, 32)) + __builtin_bit_cast(float, __builtin_amdgcn_readlane(b, 48))); }
__device__ __forceinline__ float wave_max_rl(float v) { v = fmaxf(v, dppx<0xB1>(v)); v = fmaxf(v, dppx<0x4E>(v)); v = fmaxf(v, dppx<0x141>(v)); v = fmaxf(v, dppx<0x140>(v)); const int b = __builtin_bit_cast(int, v);
    return fmaxf(fmaxf(__builtin_bit_cast(float, __builtin_amdgcn_readlane(b, 0)), __builtin_bit_cast(float, __builtin_amdgcn_readlane(b, 16))), fmaxf(__builtin_bit_cast(float, __builtin_amdgcn_readlane(b, 32)), __builtin_bit_cast(float, __builtin_amdgcn_readlane(b, 48)))); }
__device__ __forceinline__ void store_row_i8(const float (&x)[8], unsigned char* dst, float* scale, int lane) {
    float mx = 0.f;
#pragma unroll
    for (int e = 0; e < 8; ++e) mx = fmaxf(mx, fabsf(x[e]));
    mx = wave_max_rl(mx); const float inv = mx > 0.f ? 127.0f / mx : 0.f; unsigned q[8];
#pragma unroll
    for (int e = 0; e < 8; ++e) q[e] = (unsigned)(int)__builtin_rintf(__builtin_amdgcn_fmed3f(x[e] * inv, -127.f, 127.f)) & 0xffu;
    v2u w; w.x = q[0] | (q[1] << 8) | (q[2] << 16) | (q[3] << 24); w.y = q[4] | (q[5] << 8) | (q[6] << 16) | (q[7] << 24);
    *(v2u*)(dst + lane * 8) = w; if (lane == 0) *scale = mx * (1.0f / 127.0f);
}
__device__ __forceinline__ v2u pack8_fp8s(const float (&x)[8], const float sc) { v2u w; int tt = 0; tt = cvt_pk_fp8_sat(x[0] * sc, x[1] * sc, tt, false); tt = cvt_pk_fp8_sat(x[2] * sc, x[3] * sc, tt, true); w.x = (unsigned)tt;
    tt = 0; tt = cvt_pk_fp8_sat(x[4] * sc, x[5] * sc, tt, false); tt = cvt_pk_fp8_sat(x[6] * sc, x[7] * sc, tt, true); w.y = (unsigned)tt; return w; }
__device__ __forceinline__ v2u pack8_fp8x16(const float (&x)[8]) { v2u w; int tt = 0; tt = cvt_pk_fp8_sat(x[0] * 16.f, x[1] * 16.f, tt, false); tt = cvt_pk_fp8_sat(x[2] * 16.f, x[3] * 16.f, tt, true); w.x = (unsigned)tt;
    tt = 0; tt = cvt_pk_fp8_sat(x[4] * 16.f, x[5] * 16.f, tt, false); tt = cvt_pk_fp8_sat(x[6] * 16.f, x[7] * 16.f, tt, true); w.y = (unsigned)tt; return w; }
__device__ __forceinline__ void phase4(const Args& a, int vcu, int G) {
    const int tid = threadIdx.x, lane = tid & 63, wave = tid >> 6; unsigned char* ws = a.ws;
    const bf16* Zq = (const bf16*)(ws + WS_Z); const bf16* Zb = (const bf16*)(ws + WS_ZB); bf16* QN = (bf16*)(ws + WS_QN); bf16* CKV = (bf16*)(ws + WS_CKV); bf16* KPE = (bf16*)(ws + WS_KPE);
    bf16* GQ = (bf16*)(ws + WS_GQ); bf16* GK = (bf16*)(ws + WS_GK); bf16* GV = (bf16*)(ws + WS_GV); unsigned char* GK8 = (unsigned char*)(ws + WS_GK);
    const float* T32 = (const float*)(ws + WS_ROPE32);
    const float* g_q_lat = a.in[13]; const float* g_kv_lat = a.in[15]; const float* g_gq = a.in[19]; const float* g_gk = a.in[20];
    float* out = a.out;
    const int gw = vcu * NWAVES + wave, NGW = G * NWAVES;
    const int hq = lane & 15;
    const f32x4 gqa = *(const f32x4*)(g_q_lat + lane * 8), gqb = *(const f32x4*)(g_q_lat + lane * 8 + 4), gqc = *(const f32x4*)(g_q_lat + 512 + lane * 8), gqd = *(const f32x4*)(g_q_lat + 512 + lane * 8 + 4);
    const f32x4 gka = *(const f32x4*)(g_kv_lat + lane * 8), gkb = *(const f32x4*)(g_kv_lat + lane * 8 + 4);
    const float* T16 = (const float*)(ws + WS_ROPE16); const float* g_mk = a.in[18];
    f32x4 gpa = (f32x4){0.f, 0.f, 0.f, 0.f}, gpb = gpa; if (lane < 8) { gpa = *(const f32x4*)(g_mk + 128 + lane * 8); gpb = *(const f32x4*)(g_mk + 128 + lane * 8 + 4); }
    const f32x4 ggqa = *(const f32x4*)(g_gq + hq * 8), ggqb = *(const f32x4*)(g_gq + hq * 8 + 4), ggka = *(const f32x4*)(g_gk + hq * 8), ggkb = *(const f32x4*)(g_gk + hq * 8 + 4);
    for (int t = gw; t < MTOK + NLAT * PAST; t += NGW) {
        if (t >= MTOK) {
            const int u = t - MTOK, b = u >> 8, s = u & 255; const size_t kr = (size_t)TP + (size_t)b * (PAST + LSEQ) + s;
            { const float* src = a.in[2] + (size_t)u * KVRANK + lane * 8; const f32x4 x0 = *(const f32x4*)src, x1 = *(const f32x4*)(src + 4);
              if (KVUP_I8) { const float xx[8] = {x0.x, x0.y, x0.z, x0.w, x1.x, x1.y, x1.z, x1.w}; store_row_i8(xx, (unsigned char*)CKV + kr * KVRANK, (float*)(ws + WS_CKVS) + kr, lane); }
              else if (KVUP_FP8) { const float xx[8] = {x0.x, x0.y, x0.z, x0.w, x1.x, x1.y, x1.z, x1.w}; *(v2u*)((unsigned char*)CKV + kr * KVRANK + lane * 8) = pack8_fp8x16(xx); }
              else { v4u w; w.x = pk2(x0.x, x0.y); w.y = pk2(x0.z, x0.w); w.z = pk2(x1.x, x1.y); w.w = pk2(x1.z, x1.w); *(v4u*)(CKV + kr * KVRANK + lane * 8) = w; } }
            if (KV_FUSE) { f32x4 x0 = (f32x4){0.f, 0.f, 0.f, 0.f}, x1 = x0; if (lane < 8) { const float* src = a.in[3] + (size_t)u * ROPED + lane * 8; x0 = *(const f32x4*)src; x1 = *(const f32x4*)(src + 4); }
              float ss = (x0.x * x0.x + x0.y * x0.y) + (x0.z * x0.z + x0.w * x0.w) + (x1.x * x1.x + x1.y * x1.y) + (x1.z * x1.z + x1.w * x1.w);
              ss = row16_sum(ss); if (lane == 0) ((float*)(ws + WS_KPESS))[kr] = ss;
              x0 *= gpa; x1 *= gpb;
              if (lane < 8) { v4u w; w.x = pk2(x0.x, x0.y); w.y = pk2(x0.z, x0.w); w.z = pk2(x1.x, x1.y); w.w = pk2(x1.z, x1.w); *(v4u*)(KPE + kr * ROPED + lane * 8) = w; } }
            else if (lane < 8) { const float* src = a.in[3] + (size_t)u * ROPED + lane * 8; const f32x4 x0 = *(const f32x4*)src, x1 = *(const f32x4*)(src + 4);
              v4u w; w.x = pk2(x0.x, x0.y); w.y = pk2(x0.z, x0.w); w.z = pk2(x1.x, x1.y); w.w = pk2(x1.z, x1.w); *(v4u*)(KPE + kr * ROPED + lane * 8) = w; }
            { const float* src = a.in[4] + (size_t)u * 512 + lane * 8; const f32x4 x0 = *(const f32x4*)src, x1 = *(const f32x4*)(src + 4);
              if (ATT_KF8) { const float xx[8] = {x0.x, x0.y, x0.z, x0.w, x1.x, x1.y, x1.z, x1.w}; *(v2u*)(GK8 + kr * 512 + lane * 8) = pack8_fp8s(xx, ATT_KS8); }
              else { v4u w; w.x = pk2(x0.x, x0.y); w.y = pk2(x0.z, x0.w); w.z = pk2(x1.x, x1.y); w.w = pk2(x1.z, x1.w); *(v4u*)(GK + kr * 512 + lane * 8) = w; } }
            { const float* src = a.in[5] + (size_t)u * 512 + lane * 8; const f32x4 x0 = *(const f32x4*)src, x1 = *(const f32x4*)(src + 4);
              v4u w; w.x = pk2(x0.x, x0.y); w.y = pk2(x0.z, x0.w); w.z = pk2(x1.x, x1.y); w.w = pk2(x1.z, x1.w); *(v4u*)(GV + kr * 512 + lane * 8) = w; }
            continue;
        }
        const bool prompt = t < TP; const size_t kr = (size_t)kvrow_of(t);
        const int spos = prompt ? 0 : ((t - TP) & 4095); const int prow = spos >> 6, pcol = spos & 63;
        const bf16* zq = Zq + (size_t)t * ZQW; const bf16* z = Zb + (size_t)t * ZBW;
        const v4u wq0 = *(const v4u*)(zq + ZQ + lane * 8), wq1 = *(const v4u*)(zq + ZQ + 512 + lane * 8);
        const v4u wkv = *(const v4u*)(z + ZKV + lane * 8), wgk = *(const v4u*)(z + ZGK + lane * 8), wgv = *(const v4u*)(z + ZGV + lane * 8);
        v4u wpe = (v4u){0u, 0u, 0u, 0u}; if (lane < 8) wpe = *(const v4u*)(z + ZPE + lane * 8);
        v4u wgq[4];
#pragma unroll
        for (int it = 0; it < 4; ++it) wgq[it] = *(const v4u*)(zq + ZGQ + it * 512 + lane * 8);
        float rc[8], rs[8];
        if (!prompt) { const int pos = (hq < 8) ? prow : pcol; const float* tp = T32 + (size_t)(pos * 32 + (hq & 3) * 8) * 2;
#pragma unroll
          for (int q = 0; q < 4; ++q) { const f32x4 cs = *(const f32x4*)(tp + 4 * q); rc[2 * q] = cs[0]; rc[2 * q + 1] = cs[2]; rs[2 * q] = (hq & 4) ? cs[1] : -cs[1]; rs[2 * q + 1] = (hq & 4) ? cs[3] : -cs[3]; } }
        { float x0[8], x1[8]; unpack8(wq0, x0); unpack8(wq1, x1); float ss = 0.f;
#pragma unroll
          for (int e = 0; e < 8; ++e) ss += x0[e] * x0[e] + x1[e] * x1[e];
          const float r = 1.0f / sqrtf(wave_sum_rl(ss) * (1.0f / QRANK) + EPS);
#pragma unroll
          for (int e = 0; e < 8; ++e) { x0[e] = x0[e] * r * (e < 4 ? gqa[e] : gqb[e - 4]); x1[e] = x1[e] * r * (e < 4 ? gqc[e] : gqd[e - 4]); }
          if (QUP_I8) { unsigned char* q8 = (unsigned char*)QN + (size_t)t * QRANK; v2u w0, w1;
#define Q8(x) ((unsigned)(int)__builtin_rintf(__builtin_amdgcn_fmed3f((x) * 16.f, -127.f, 127.f)) & 0xffu)
            w0.x = Q8(x0[0]) | (Q8(x0[1]) << 8) | (Q8(x0[2]) << 16) | (Q8(x0[3]) << 24); w0.y = Q8(x0[4]) | (Q8(x0[5]) << 8) | (Q8(x0[6]) << 16) | (Q8(x0[7]) << 24);
            w1.x = Q8(x1[0]) | (Q8(x1[1]) << 8) | (Q8(x1[2]) << 16) | (Q8(x1[3]) << 24); w1.y = Q8(x1[4]) | (Q8(x1[5]) << 8) | (Q8(x1[6]) << 16) | (Q8(x1[7]) << 24);
#undef Q8
            *(v2u*)(q8 + lane * 8) = w0; *(v2u*)(q8 + 512 + lane * 8) = w1; }
          else if (QUP_FP8) { unsigned char* q8 = (unsigned char*)QN + (size_t)t * QRANK; *(v2u*)(q8 + lane * 8) = pack8_fp8x16(x0); *(v2u*)(q8 + 512 + lane * 8) = pack8_fp8x16(x1); }
          else { *(v4u*)(QN + (size_t)t * QRANK + lane * 8) = pack8(x0); *(v4u*)(QN + (size_t)t * QRANK + 512 + lane * 8) = pack8(x1); } }
        { float x[8]; unpack8(wkv, x); float ss = 0.f;
#pragma unroll
          for (int e = 0; e < 8; ++e) ss += x[e] * x[e];
          const float r = 1.0f / sqrtf(wave_sum_rl(ss) * (1.0f / KVRANK) + EPS);
#pragma unroll
          for (int e = 0; e < 8; ++e) x[e] = x[e] * r * (e < 4 ? gka[e] : gkb[e - 4]);
          if (KVUP_I8) store_row_i8(x, (unsigned char*)CKV + kr * KVRANK, (float*)(ws + WS_CKVS) + kr, lane);
          else if (KVUP_FP8) *(v2u*)((unsigned char*)CKV + kr * KVRANK + lane * 8) = pack8_fp8x16(x); else *(v4u*)(CKV + kr * KVRANK + lane * 8) = pack8(x);
          if (prompt) { float* o = out + OUT_CKV + (size_t)t * KVRANK + lane * 8; *(f32x4*)o = (f32x4){x[0], x[1], x[2], x[3]}; *(f32x4*)(o + 4) = (f32x4){x[4], x[5], x[6], x[7]}; } }
        if (KV_FUSE) { float x[8]; unpack8(wpe, x);
          if (prompt && lane < 8) { float* o = out + OUT_KPE + (size_t)t * ROPED + lane * 8; *(f32x4*)o = (f32x4){x[0], x[1], x[2], x[3]}; *(f32x4*)(o + 4) = (f32x4){x[4], x[5], x[6], x[7]}; }
          float ss = 0.f;
#pragma unroll
          for (int e = 0; e < 8; ++e) ss += x[e] * x[e];
          ss = row16_sum(ss); if (lane == 0) ((float*)(ws + WS_KPESS))[kr] = ss;
#pragma unroll
          for (int e = 0; e < 8; ++e) x[e] *= (e < 4 ? gpa[e] : gpb[e - 4]);
          if (!prompt) { const int pos = (lane & 4) ? pcol : prow; const float* tp = T16 + (size_t)(pos * 16 + 8 * (lane & 1)) * 2;
#pragma unroll
            for (int q = 0; q < 4; ++q) { const f32x4 cs = *(const f32x4*)(tp + 4 * q);
#pragma unroll
              for (int h2 = 0; h2 < 2; ++h2) { const int e = 2 * q + h2; const float pa = dppx<0x112>(x[e]), pb = dppx<0x102>(x[e]); const float pr = (lane & 2) ? pa : pb;
                x[e] = x[e] * cs[2 * h2] + ((lane & 2) ? pr : -pr) * cs[2 * h2 + 1]; } } }
          if (lane < 8) *(v4u*)(KPE + kr * ROPED + lane * 8) = pack8(x); }
        else if (lane < 8) { *(v4u*)(KPE + kr * ROPED + lane * 8) = wpe;
          if (prompt) { float x[8]; unpack8(wpe, x); float* o = out + OUT_KPE + (size_t)t * ROPED + lane * 8; *(f32x4*)o = (f32x4){x[0], x[1], x[2], x[3]}; *(f32x4*)(o + 4) = (f32x4){x[4], x[5], x[6], x[7]}; } }
#pragma unroll
        for (int it = 0; it < 4; ++it) { float x[8]; unpack8(wgq[it], x); float ss = 0.f;
#pragma unroll
            for (int e = 0; e < 8; ++e) ss += x[e] * x[e];
            const float r = 1.0f / sqrtf(row16_sum(ss) * (1.0f / GHD) + EPS);
#pragma unroll
            for (int e = 0; e < 8; ++e) x[e] = x[e] * r * (e < 4 ? ggqa[e] : ggqb[e - 4]);
            if (!prompt) {
#pragma unroll
              for (int e = 0; e < 8; ++e) { const float pa = dppx<0x114>(x[e]), pb = dppx<0x104>(x[e]); const float p = (hq & 4) ? pa : pb;     x[e] = x[e] * rc[e] + p * rs[e]; } }
            if (GQ_FP8 && ATT_KF8) *(v2u*)((unsigned char*)GQ + (size_t)t * 2048 + it * 512 + lane * 8) = pack8_fp8s(x, att::q8_scale<128>());
            else *(v4u*)(GQ + (size_t)t * 2048 + it * 512 + lane * 8) = pack8(x); }
        { float x[8]; unpack8(wgk, x); float ss = 0.f;
#pragma unroll
          for (int e = 0; e < 8; ++e) ss += x[e] * x[e];
          const float r = 1.0f / sqrtf(row16_sum(ss) * (1.0f / GHD) + EPS);
#pragma unroll
          for (int e = 0; e < 8; ++e) x[e] = x[e] * r * (e < 4 ? ggka[e] : ggkb[e - 4]);
          if (prompt) { float* o = out + OUT_GK + (size_t)t * 512 + lane * 8; *(f32x4*)o = (f32x4){x[0], x[1], x[2], x[3]}; *(f32x4*)(o + 4) = (f32x4){x[4], x[5], x[6], x[7]}; }
          else {
#pragma unroll
            for (int e = 0; e < 8; ++e) { const float pa = dppx<0x114>(x[e]), pb = dppx<0x104>(x[e]); const float p = (hq & 4) ? pa : pb;     x[e] = x[e] * rc[e] + p * rs[e]; } }
          if (ATT_KF8) *(v2u*)(GK8 + kr * 512 + lane * 8) = pack8_fp8s(x, ATT_KS8);
          else *(v4u*)(GK + kr * 512 + lane * 8) = pack8(x); }
        { *(v4u*)(GV + kr * 512 + lane * 8) = wgv;
          if (prompt) { float x[8]; unpack8(wgv, x); float* o = out + OUT_GV + (size_t)t * 512 + lane * 8; *(f32x4*)o = (f32x4){x[0], x[1], x[2], x[3]}; *(f32x4*)(o + 4) = (f32x4){x[4], x[5], x[6], x[7]}; } }
    }
}
__device__ __forceinline__ void phase6(const Args& a, LAS unsigned char* lds, int vcu, int G) {
    const int tid = threadIdx.x, lane = tid & 63, wave = tid >> 6; unsigned char* ws = a.ws;
    bf16* KB = (bf16*)(ws + WS_KB); const bf16* KPE = (const bf16*)(ws + WS_KPE); const float* T16 = (const float*)(ws + WS_ROPE16); const float* gk = a.in[18];
    const int gw = vcu * NWAVES + wave, NGW = G * NWAVES; const int h = lane >> 2, q = lane & 3;
    float gn[32], gp[16];
#pragma unroll
    for (int e = 0; e < 32; ++e) gn[e] = gk[32 * q + e];
#pragma unroll
    for (int e = 0; e < 16; ++e) gp[e] = gk[128 + 16 * q + e];
    for (int kr = gw; kr < KVROWS; kr += NGW) {
        bool lat = false; int spos = 0;
        if (kr >= TP) { const int u = (kr - TP) % (PAST + LSEQ); if (u >= PAST) { lat = true; spos = u - PAST; } }
        bf16* kp = KB + ((size_t)kr * 16 + h) * 192; const bf16* pp = KPE + (size_t)kr * ROPED + 16 * q;
        f32x4 tq[8];
        if (lat) { const int pos = (q < 2) ? (spos >> 6) : (spos & 63); const float* tp = T16 + (size_t)pos * 32;
#pragma unroll
            for (int i = 0; i < 8; ++i) tq[i] = *(const f32x4*)(tp + 4 * i); }
        float xn[32], xp[16];
#pragma unroll
        for (int i = 0; i < 4; ++i) { float t8[8]; unpack8(*(const v4u*)(kp + 32 * q + 8 * i), t8);
#pragma unroll
            for (int e = 0; e < 8; ++e) xn[8 * i + e] = t8[e]; }
#pragma unroll
        for (int i = 0; i < 2; ++i) { float t8[8]; unpack8(*(const v4u*)(pp + 8 * i), t8);
#pragma unroll
            for (int e = 0; e < 8; ++e) xp[8 * i + e] = t8[e]; }
        float ss = 0.f;
#pragma unroll
        for (int e = 0; e < 32; ++e) ss += xn[e] * xn[e];
#pragma unroll
        for (int e = 0; e < 16; ++e) ss += xp[e] * xp[e];
        ss += dppx<0xB1>(ss); ss += dppx<0x4E>(ss);
        const float r = 1.0f / sqrtf(ss * (1.0f / MLAQK) + EPS);
#pragma unroll
        for (int e = 0; e < 32; ++e) xn[e] = xn[e] * r * gn[e];
#pragma unroll
        for (int e = 0; e < 16; ++e) xp[e] = xp[e] * r * gp[e];
        if (lat) {
#pragma unroll
            for (int e = 0; e < 16; ++e) { const float p = dppx<0xB1>(xp[e]); const float cs = tq[e >> 1][2 * (e & 1)], sn = tq[e >> 1][2 * (e & 1) + 1]; xp[e] = xp[e] * cs + ((q & 1) ? p : -p) * sn; } }
        if (ATT_KF8) { unsigned char* k8 = (unsigned char*)(ws + WS_K8) + ((size_t)kr * 16 + h) * 192; unsigned wn[8], wp[4];
#pragma unroll
            for (int i = 0; i < 8; ++i) { int tt = 0; tt = cvt_pk_fp8_sat(xn[4 * i] * ATT_KS8, xn[4 * i + 1] * ATT_KS8, tt, false); tt = cvt_pk_fp8_sat(xn[4 * i + 2] * ATT_KS8, xn[4 * i + 3] * ATT_KS8, tt, true); wn[i] = (unsigned)tt; }
#pragma unroll
            for (int i = 0; i < 4; ++i) { int tt = 0; tt = cvt_pk_fp8_sat(xp[4 * i] * ATT_KS8, xp[4 * i + 1] * ATT_KS8, tt, false); tt = cvt_pk_fp8_sat(xp[4 * i + 2] * ATT_KS8, xp[4 * i + 3] * ATT_KS8, tt, true); wp[i] = (unsigned)tt; }
            *(v4u*)(k8 + 32 * q) = (v4u){wn[0], wn[1], wn[2], wn[3]}; *(v4u*)(k8 + 32 * q + 16) = (v4u){wn[4], wn[5], wn[6], wn[7]}; *(v4u*)(k8 + 128 + 16 * q) = (v4u){wp[0], wp[1], wp[2], wp[3]};
        } else {
#pragma unroll
        for (int i = 0; i < 4; ++i) { float t8[8];
#pragma unroll
            for (int e = 0; e < 8; ++e) t8[e] = xn[8 * i + e];
            *(v4u*)(kp + 32 * q + 8 * i) = pack8(t8); }
#pragma unroll
        for (int i = 0; i < 2; ++i) { float t8[8];
#pragma unroll
            for (int e = 0; e < 8; ++e) t8[e] = xp[8 * i + e];
            *(v4u*)(kp + 128 + 16 * q + 8 * i) = pack8(t8); }
        }
    }
}
__device__ __forceinline__ void phase6_vt(const Args& a, LAS unsigned char* lds, int vcu, int G) {
    const int tid = threadIdx.x, lane = tid & 63, wave = __builtin_amdgcn_readfirstlane(tid >> 6); unsigned char* ws = a.ws;
    const bf16* VB = (const bf16*)(ws + WS_VB); const bf16* GV = (const bf16*)(ws + WS_GV); unsigned char* VT8 = ws + WS_VT8;
    LAS unsigned short* scr = (LAS unsigned short*)(lds + RING_OFF + wave * 16384);
    const int gw = vcu * NWAVES + wave, NGW = G * NWAVES;
    for (int it4 = gw; it4 < (KVROWS / 64) * 4; it4 += NGW) {
        const int T = it4 >> 2, hd = 16 + (it4 & 3), it = T * 20 + hd;
        const bf16* src = (hd < 16) ? VB + ((size_t)T * 64 * 16 + hd) * 128 : GV + ((size_t)T * 64 * 4 + (hd - 16)) * 128; const size_t rs = (hd < 16) ? 2048 : 512;
#pragma unroll 4
        for (int i = 0; i < 16; ++i) { const int row = 4 * i + (lane >> 4), c8 = (lane & 15) * 8; const v4u w = *(const v4u*)(src + (size_t)row * rs + c8); *(LAS v4u*)(scr + row * 128 + c8) = w; }
        LDS_WAIT(); asm volatile("" ::: "memory");
        unsigned char* dst = VT8 + (size_t)it * 10240;
#pragma unroll
        for (int cc = 0; cc < 2; ++cc) { const int c = lane + 64 * cc;
#pragma unroll
            for (int k4 = 0; k4 < 4; ++k4) { unsigned wd[4];
#pragma unroll
                for (int q4 = 0; q4 < 4; ++q4) { const int q = 4 * k4 + q4, hi2 = q >> 3, b0 = (4 * q) & 31; float v[4];
#pragma unroll
                    for (int j = 0; j < 4; ++j) { const int b = b0 + j, key = 32 * (b >> 4) + 8 * ((b & 15) >> 2) + 4 * hi2 + (b & 3); v[j] = __uint_as_float(((unsigned)scr[key * 128 + c]) << 16) * 32.f; }
                    int tt = 0; tt = cvt_pk_fp8_sat(v[0], v[1], tt, false); tt = cvt_pk_fp8_sat(v[2], v[3], tt, true); wd[q4] = (unsigned)tt; }
                *(v4u*)(dst + c * 80 + 16 * k4) = (v4u){wd[0], wd[1], wd[2], wd[3]}; } }
        LDS_WAIT(); asm volatile("" ::: "memory");
    }
}
__device__ __forceinline__ void phase7(const Args& a, LAS unsigned char* ldsl, char* lds, int vcu, int G) {
    unsigned char* ws = a.ws;
    constexpr long KES = ATT_KF8 ? 1 : 2;
    const char* VT8 = (const char*)(ws + WS_VT8); constexpr long VTS = 20 * 10240;
    const bf16* QRAW = (const bf16*)(ws + WS_QRAW); const char* KB = (const char*)(ws + (ATT_KF8 ? WS_K8 : WS_KB)); const bf16* VB = (const bf16*)(ws + WS_VB);
    const bf16* GQ = (const bf16*)(ws + WS_GQ); const char* GK = (const char*)(ws + WS_GK); const bf16* GV = (const bf16*)(ws + WS_GV);
    constexpr long MIXS = MIX_FP8 ? 1 : 2; constexpr long LDO = DM;
    bf16* MIX = (bf16*)(ws + WS_HB); const float* T16 = (const float*)(ws + WS_ROPE16); const float* gmq = a.in[17]; const float* sink = a.in[21];
    constexpr float NOSINK = -1e30f, L2E = 1.4426950408889634f;
    constexpr int U_ML = NLAT * MLAH * (LSEQ / 256), U_GL = NLAT * GKVH * (LSEQ / 128) * 2, U_MC = NPROMPT * MLAH, U_GC = NPROMPT * GQH;
#ifndef ATT_ONLY
#define ATT_ONLY 15
#endif
#define ATT_TID() int tid = threadIdx.x; asm volatile("" : "+v"(tid)); const int wave = __builtin_amdgcn_readfirstlane(tid >> 6), r32 = tid & 31
    if (ATT_ONLY & 1) for (int u = vcu; u < U_ML; u += G) {
        ATT_TID();
        const int qt = u & 15, h = (u >> 4) & 15, b = u >> 8; const int qpos = qt * 256 + wave * 32 + r32; const size_t trow = (size_t)TP + (size_t)b * LSEQ + qpos;
        const size_t kr0 = (size_t)TP + (size_t)b * (PAST + LSEQ);
        att::attn_body<192, true, false, MIX_FP8, ATT_KF8, ATT_VF8>(QRAW + trow * 3072 + h * 192, gmq, T16, qpos >> 6, qpos & 63, (const bf16*)(KB + (kr0 * 16 + h) * 192 * KES), 3072, ATT_VF8 ? (const bf16*)(VT8 + ((kr0 >> 6) * 20 + h) * 10240) : VB + (kr0 * 16 + h) * 128, ATT_VF8 ? VTS : 2048,
                                         0, (PAST + LSEQ) / 64, 0, 0, 0, 0, NOSINK, (bf16*)((char*)MIX + (((size_t)TP + (size_t)b * LSEQ + qt * 256 + wave * 32) * DM + h * 128) * MIXS), LDO, lds, ldsl, tid);
    }
    if (ATT_ONLY & 2) for (int v = vcu; v < U_GL; v += G) {
        ATT_TID();
        const int gp = v & 1, c = (v >> 1) & 31, n = (v >> 6) & 3, b = v >> 8; const int h = 4 * n + 2 * gp + (wave >> 2);
        const int q0 = 128 * c + 32 * (wave & 3), qi = q0 + r32; const size_t trow = (size_t)TP + (size_t)b * LSEQ + qi;
        const size_t kr0 = (size_t)TP + (size_t)b * (PAST + LSEQ);
        const int js = c > 0 ? 128 * (c - 1) : 0, je = (c < 31) ? 128 * (c + 2) : LSEQ;
        att::attn_body<128, false, true, MIX_FP8, ATT_KF8, ATT_VF8, (GQ_FP8 && ATT_KF8)>((GQ_FP8 && ATT_KF8) ? (const bf16*)((const unsigned char*)GQ + (trow * 16 + h) * 128) : GQ + (trow * 16 + h) * 128, nullptr, nullptr, 0, 0, (const bf16*)(GK + (kr0 * 4 + n) * 128 * KES), 512, ATT_VF8 ? (const bf16*)(VT8 + ((kr0 >> 6) * 20 + 16 + n) * 10240) : GV + (kr0 * 4 + n) * 128, ATT_VF8 ? VTS : 512,
                                         0, PAST / 64, PAST + js, (je - js) / 64, js, qi, sink[h] * L2E, (bf16*)((char*)MIX + (((size_t)TP + (size_t)b * LSEQ + q0) * DM + 2048 + h * 128) * MIXS), LDO, lds, ldsl, tid);
    }
    if (ATT_ONLY & 4) for (int v = vcu; v < U_MC; v += G) {
        ATT_TID();
        const int h = v & 15, p = v >> 4; const size_t trow = (size_t)p * SEQ + wave * 32 + r32; const size_t kr0 = (size_t)p * SEQ;
        att::attn_body<192, true, false, MIX_FP8, ATT_KF8, ATT_VF8>(QRAW + trow * 3072 + h * 192, gmq, nullptr, 0, 0, (const bf16*)(KB + (kr0 * 16 + h) * 192 * KES), 3072, ATT_VF8 ? (const bf16*)(VT8 + ((kr0 >> 6) * 20 + h) * 10240) : VB + (kr0 * 16 + h) * 128, ATT_VF8 ? VTS : 2048,
                                         0, SEQ / 64, 0, 0, 0, 0, NOSINK, (bf16*)((char*)MIX + (((size_t)p * SEQ + wave * 32) * DM + h * 128) * MIXS), LDO, lds, ldsl, tid);
    }
    if (ATT_ONLY & 8) for (int v = vcu; v < U_GC; v += G) {
        ATT_TID();
        const int h = v & 15, p = v >> 4; const size_t trow = (size_t)p * SEQ + wave * 32 + r32; const size_t kr0 = (size_t)p * SEQ;
        att::attn_body<128, false, false, MIX_FP8, ATT_KF8, ATT_VF8, (GQ_FP8 && ATT_KF8)>((GQ_FP8 && ATT_KF8) ? (const bf16*)((const unsigned char*)GQ + (trow * 16 + h) * 128) : GQ + (trow * 16 + h) * 128, nullptr, nullptr, 0, 0, (const bf16*)(GK + (kr0 * 4 + (h >> 2)) * 128 * KES), 512, ATT_VF8 ? (const bf16*)(VT8 + ((kr0 >> 6) * 20 + 16 + (h >> 2)) * 10240) : GV + (kr0 * 4 + (h >> 2)) * 128, ATT_VF8 ? VTS : 512,
                                          0, SEQ / 64, 0, 0, 0, 0, sink[h] * L2E, (bf16*)((char*)MIX + (((size_t)p * SEQ + wave * 32) * DM + 2048 + h * 128) * MIXS), LDO, lds, ldsl, tid);
    }
}
#undef ATT_TID
__device__ __forceinline__ void wup_convert_dyn(const Args& a, LAS unsigned char* lds, unsigned* ctr, unsigned lo, unsigned hi) {
    const int tid = threadIdx.x, lane = tid & 63, wave = __builtin_amdgcn_readfirstlane(tid >> 6); unsigned char* ws = a.ws;
    LAS float* scr = (LAS float*)(lds + RING_OFF + wave * 16384);
    for (;;) { unsigned it0 = 0; if (lane == 0) it0 = atomicAdd(ctr, 4u); it0 = lo + __builtin_amdgcn_readfirstlane(it0); if (it0 >= hi) break;
        for (unsigned it = it0; it < it0 + 4u && it < hi; ++it)
            p0_transpose_item_i8(a.in[23], DM, 22016, (signed char*)(ws + WS_WUP), MapUpPerm{(const unsigned*)(ws + WS_RANK)}, (const unsigned*)(ws + WS_COLMAX), (float*)(ws + WS_COLSC), scr, (int)it, lane); }
}
__device__ __forceinline__ void wqo_convert_dyn(const Args& a, LAS unsigned char* lds, unsigned* ctr) {
    const int tid = threadIdx.x, lane = tid & 63, wave = __builtin_amdgcn_readfirstlane(tid >> 6); unsigned char* ws = a.ws;
    LAS float* scr = (LAS float*)(lds + RING_OFF + wave * 16384);
    constexpr unsigned NQ = (QRANK / 64) * (3072 / 32), NO = (DM / 64) * (DM / 32);
    for (;;) { unsigned it0 = 0; if (lane == 0) it0 = atomicAdd(ctr, 4u); it0 = __builtin_amdgcn_readfirstlane(it0); if (it0 >= NQ + NO) break;
        for (unsigned it = it0; it < it0 + 4u && it < NQ + NO; ++it) {
            if (it < NQ) p0_transpose_item_fp8(a.in[14], QRANK, 3072, (unsigned char*)(ws + WS_WQUP), scr, (int)it, lane);
            else p0_transpose_item_fp8(a.in[22], DM, DM, (unsigned char*)(ws + WS_WOUT), scr, (int)(it - NQ), lane); } }
}
__device__ __forceinline__ void wdown_convert_dyn(const Args& a, LAS unsigned char* lds, unsigned* ctr) {
    const int tid = threadIdx.x, lane = tid & 63, wave = __builtin_amdgcn_readfirstlane(tid >> 6); unsigned char* ws = a.ws;
    LAS float* scr = (LAS float*)(lds + RING_OFF + wave * 16384); const unsigned* sigma = (const unsigned*)(ws + WS_SIGMA);
    constexpr unsigned NIT = (DFF / 64) * (DM / 32);
    for (;;) { unsigned it0 = 0; if (lane == 0) it0 = atomicAdd(ctr, 4u); it0 = __builtin_amdgcn_readfirstlane(it0); if (it0 >= NIT) break;
        for (unsigned it = it0; it < it0 + 4u && it < NIT; ++it) { const int k0 = 64 * (int)(it / (DM / 32));
            if (k0 < GK8) p0_transpose_item_fp8(a.in[26], GPB, DM, (unsigned char*)(ws + WS_WDOWN), scr, (int)it, lane, 0, sigma);
            else p0_transpose_item(a.in[26], GPB / 2, DM, (bf16*)(ws + WS_WDOWN) - GK8 / 2, MapId(), scr, (int)it, lane, sigma); } }
}
__device__ __forceinline__ void phase11(const Args& a, int vcu, int G) {
    const int tid = threadIdx.x; unsigned char* ws = a.ws;
    const float* edge = (const float*)(ws + WS_EDGE); bf16* Gb = (bf16*)(ws + WS_G); const float* cw = FFN_SORT ? (const float*)(ws + WS_CWP) : a.in[24];
    const int nrun = MTOK / 64; const size_t total = (size_t)nrun * 2 * (DFF / 4);
    for (size_t i = (size_t)vcu * NTHREADS + tid; i < total; i += (size_t)G * NTHREADS) {
        const int c4 = (int)(i % (DFF / 4)); const int rr = (int)(i / (DFF / 4)); const int rho = rr >> 1, last = rr & 1; const int c = c4 * 4;
        const int t = rho * 64 + (last ? 63 : 0); const int L = (t < TP) ? SEQ : LSEQ;
        const float* e = edge + ((size_t)rho * 4 + (last ? 2 : 0)) * 22016;
        f32x4 pg = *(const f32x4*)(e + c), pv = *(const f32x4*)(e + DFF + c);
        const bool has = last ? (((t + 1) % L) != 0) : ((t % L) != 0);
        if (has) { const float* ne = edge + ((size_t)(last ? rho + 1 : rho - 1) * 4 + (last ? 1 : 3)) * 22016; const float* w = cw + (last ? 2 * 22016 : 0);
            pg += *(const f32x4*)(w + c) * *(const f32x4*)(ne + c); pv += *(const f32x4*)(w + DFF + c) * *(const f32x4*)(ne + DFF + c); }
        auto gate = [](float a_, float b_) __attribute__((always_inline)) { return (TAP_FOLD && FFN_SORT) ? (a_ * __builtin_amdgcn_rcpf(1.0f + __builtin_amdgcn_exp2f(a_))) * b_ : silu_f(a_) * b_; };
        const float g0 = gate(pg.x, pv.x), g1 = gate(pg.y, pv.y), g2 = gate(pg.z, pv.z), g3 = gate(pg.w, pv.w);
        unsigned char* grow = (unsigned char*)Gb + (size_t)t * GPB; const float s8 = (TAP_FOLD && FFN_SORT) ? 1.0f : SG8;
        if (c < GK8) { int tt = 0; tt = cvt_pk_fp8_sat(g0 * s8, g1 * s8, tt, false); tt = cvt_pk_fp8_sat(g2 * s8, g3 * s8, tt, true); *(unsigned*)(grow + c) = (unsigned)tt; }
        else { v2u o; o.x = pk2(g0, g1); o.y = pk2(g2, g3); *(v2u*)(grow + GK8 + (size_t)(c - GK8) * 2) = o; }
    }
}

#ifndef LB2
#define LB2 2
#endif
__global__ void __launch_bounds__(NTHREADS, LB2) mk_fwd(Args args) {
    extern __shared__ __attribute__((aligned(16))) unsigned char lds_raw[];
    LAS unsigned char* lds = (LAS unsigned char*)lds_raw;
    volatile LAS unsigned* MISC = (volatile LAS unsigned*)(lds + MISC_OFF);
    const int tid = threadIdx.x;
    const int G = gridDim.x; const int bx = blockIdx.x; const int vcu = (G % 8 == 0) ? (bx % 8) * (G / 8) + bx / 8 : bx;
    unsigned char* ws = args.ws;
    unsigned* ctl = (unsigned*)(ws + WS_CTL);
    { int tz = tid; asm volatile("" : "+v"(tz));
      for (int u = tz; u < (LDS_BYTES - RING_BYTES) / 4; u += NTHREADS) ((LAS unsigned*)(lds + RING_BYTES))[u] = 0u; }
    __syncthreads();
    XcdBarrier bar; bar.bar = ctl + CW_BAR; bar.x = 0; bar.st = nullptr;
    if (MK_ONE_LAUNCH) bar = xcd_barrier_post(ctl + CW_BAR, MISC + 8);
    const int lo = args.ph_lo, hi = args.ph_hi;
#ifndef PH_MASK
#define PH_MASK 0x1fff
#endif
#define IN(k) (((PH_MASK >> (k)) & 1) && lo <= (k) && (k) < hi)
#ifndef DUP_MASK
#define DUP_MASK 0
#endif
#define DUPQ(k) ((DUP_MASK >> (k)) & 1)
#define SEAM(k) do { if (IN(k) && IN((k) + 1)) xcd_barrier(bar); } while (0)
    const float* mod = (const float*)(ws + WS_MOD);
    bf16* HB = (bf16*)(ws + WS_HB);
    float* Y = args.out + OUT_Y; bf16* X1 = (bf16*)(ws + WS_X1);

    auto run3 = [&]() __attribute__((always_inline)) {
        { pg8::Gemm g{HB, (const bf16*)(ws + WS_WIN), MTOK, ZBW, DM}; pg8::StaticOrder S; S.init(MTOK, ZBW, G, bx, W_P3B);
          pg8::EpiBf16 E{(bf16*)(ws + WS_ZB), ZBW, 1.0f};
          pg8::gemm_phase<pg8::EpiBf16, pg8::StaticOrder, GEMM_ALIGN, GEMM_SP2>(lds + RING_OFF, g, S, E); }
        __syncthreads();
        { pg8::Gemm g{(const bf16*)(ws + WS_H8), (const bf16*)(ws + WS_WINQ), MTOK, ZQW, DM / 2}; pg8::StaticOrder S; S.init(MTOK, ZQW, G, bx, W_P3Q);
          pg8::EpiBf16T<true> E{(bf16*)(ws + WS_Z), ZQW, 1.0f / 4096.0f};
          pg8::gemm_phase<pg8::EpiBf16T<true>, pg8::StaticOrder, GEMM_ALIGN, GEMM_SP2>(lds + RING_OFF, g, S, E); } };
    auto run5 = [&]() __attribute__((always_inline)) {
        { pg8::Gemm g{(const bf16*)(ws + WS_CKV), (const bf16*)(ws + WS_WKVUP), KVROWS, 4096, (KVUP_FP8 || KVUP_I8) ? KVRANK / 2 : KVRANK}; pg8::StaticOrder S; S.init(KVROWS, 4096, G, bx, W_P5K);
          if constexpr (KV_FUSE) { static_assert(!KV_FUSE || (KVUP_I8 && ATT_VF8 && ATT_KF8 && GEMM_ALIGN), "KV_FUSE needs the int8 kv-up GEMM, fp8 keys / V images and aligned epilogues");
            typedef pg8::EpiKVFuse<WS_K8, WS_VT8, WS_CKVS, WS_KVCS, WS_KPESS, WS_KPE> EKF;
            EKF E{ws, args.in[18], (LAS float*)(lds + RING_BYTES + 4096), ATT_KS8};
            pg8::gemm_phase<EKF, pg8::StaticOrder, GEMM_ALIGN, GEMM_SP2>(lds + RING_OFF, g, S, E); }
          else {
          typedef pg8::EpiKVT<ATT_VF8, KVUP_FP8 && !KVUP_I8, KVUP_I8> EKV;
          EKV E{(bf16*)(ws + WS_KB), (bf16*)(ws + WS_VB), ws + WS_VT8, (const float*)(ws + WS_CKVS), (const float*)(ws + WS_KVCS)};
          pg8::gemm_phase<EKV, pg8::StaticOrder, GEMM_ALIGN, GEMM_SP2>(lds + RING_OFF, g, S, E); } }
        __syncthreads();
        { pg8::Gemm g{(const bf16*)(ws + WS_QN), (const bf16*)(ws + WS_WQUP), MTOK, 3072, (QUP_FP8 || QUP_I8) ? QRANK / 2 : QRANK}; pg8::StaticOrder S; S.init(MTOK, 3072, G, bx, W_P5Q);
          pg8::EpiBf16T<QUP_FP8 && !QUP_I8, QUP_I8> E{(bf16*)(ws + WS_QRAW), 3072, QUP_I8 ? (1.0f / 16.0f) * (0.15875f / 127.0f) : (QUP_FP8 ? 1.0f / 4096.0f : 1.0f)};
          pg8::gemm_phase<pg8::EpiBf16T<QUP_FP8 && !QUP_I8, QUP_I8>, pg8::StaticOrder, GEMM_ALIGN, GEMM_SP2>(lds + RING_OFF, g, S, E); } };
    auto run8 = [&]() __attribute__((always_inline)) {
        pg8::Gemm g{HB, (const bf16*)(ws + WS_WOUT), MTOK, DM, MIX_FP8 ? DM / 2 : DM}; pg8::StaticOrder S; S.init(MTOK, DM, G, bx, W_P8);
        pg8::EpiResT<MIX_FP8, false, true> E{args.in[0], args.in[1], X1, mod + 2 * 4096, MIX_FP8 ? PROBE_GSCALE * (1.0f / 8192.0f) : PROBE_GSCALE, 1.0f};
        pg8::gemm_phase<pg8::EpiResT<MIX_FP8, false, true>, pg8::StaticOrder, GEMM_ALIGN, GEMM_SP2>(lds + RING_OFF, g, S, E); };
    auto run10 = [&]() __attribute__((always_inline)) {
        pg8::Gemm g{HB, (const bf16*)(ws + WS_WUP), MTOK, 22016, UP_I8 ? DM / 2 : DM}; pg8::StaticOrder S; S.init(MTOK, 22016, G, bx, W_P10);
        pg8::EpiUpT<(UP_I8 && !PROBE_UPF8), (TAP_FOLD && FFN_SORT)> E{(LAS float*)(lds + RING_BYTES + 4096), (unsigned char*)(ws + WS_G), FFN_SORT ? (const float*)(ws + WS_CWP) : args.in[24], FFN_SORT ? (const float*)(ws + WS_CBP) : args.in[25], (float*)(ws + WS_EDGE), GK8, GPB, SG8, (const float*)(ws + WS_ROWSC), (const float*)(ws + WS_COLSC)};
        pg8::gemm_phase<pg8::EpiUpT<(UP_I8 && !PROBE_UPF8), (TAP_FOLD && FFN_SORT)>, pg8::StaticOrder, GEMM_ALIGN, GEMM_SP2>(lds + RING_OFF, g, S, E); };
    auto run12 = [&]() __attribute__((always_inline)) {
        pg8::Gemm g{(const bf16*)(ws + WS_G), (const bf16*)(ws + WS_WDOWN), MTOK, DM, GPB / 2}; pg8::StaticOrder S; S.init(MTOK, DM, G, bx, W_P12);
        pg8::EpiResT<false, true, false, DOWN_NT8> E{X1, X1 + (size_t)TP * DM, Y, mod + 5 * 4096, PROBE_GSCALE2, 1.0f / (SG8 * SW8)};
        pg8::gemm_phase<pg8::EpiResT<false, true, false, DOWN_NT8>, pg8::StaticOrder, GEMM_ALIGN, GEMM_SP2>(lds + RING_OFF, g, S, E); };
    if (IN(0)) { phase0(args, lds, vcu, G); if (DUPQ(0)) { __syncthreads(); phase0(args, lds, vcu, G); } } SEAM(0);
    if (IN(1)) { phase1(args, lds, vcu, G); if (DUPQ(1)) phase1(args, lds, vcu, G); } SEAM(1);
    if (IN(2)) { phase_norm<false>(args.in[0], args.in[1], args.in[8], mod, 0, 4096, HB, (unsigned char*)(ws + WS_H8), nullptr, lds, vcu, G); if (DUPQ(2)) phase_norm<false>(args.in[0], args.in[1], args.in[8], mod, 0, 4096, HB, (unsigned char*)(ws + WS_H8), nullptr, lds, vcu, G); } SEAM(2);
    constexpr unsigned UP_ITEMS = (DM / 64) * (22016 / 32);
    if (IN(3)) { run3(); if (DUPQ(3)) { __syncthreads(); run3(); }
        if (UP_TAIL && UP_I8 && FFN_SORT) { __syncthreads(); wup_convert_dyn(args, lds, ctl + 16448, 0u, UPT_A); }
        if (W_TAIL3 && QUP_FP8 && !QUP_I8 && MIX_FP8) { __syncthreads(); wqo_convert_dyn(args, lds, ctl + 16640); } } SEAM(3);
    if (IN(4)) { phase4(args, vcu, G); if (DUPQ(4)) phase4(args, vcu, G); } SEAM(4);
    if (IN(5)) { run5(); if (DUPQ(5)) { __syncthreads(); run5(); }
        if (KV_FUSE && ATT_VF8 && ((PH_MASK >> 6) & 1)) { __syncthreads(); phase6_vt(args, lds, vcu, G); }
        if (UP_TAIL && UP_I8 && FFN_SORT) { __syncthreads(); wup_convert_dyn(args, lds, ctl + 16512, UPT_A, UPT_B); } }
    if (!KV_FUSE) SEAM(5);
    if (IN(6)) { if (!KV_FUSE) { phase6(args, lds, vcu, G); if (ATT_VF8) phase6_vt(args, lds, vcu, G); if (DUPQ(6)) { phase6(args, lds, vcu, G); if (ATT_VF8) phase6_vt(args, lds, vcu, G); } } } SEAM(6);
    if (IN(7)) { phase7(args, lds, (char*)lds_raw, vcu, G); if (DUPQ(7)) { __syncthreads(); phase7(args, lds, (char*)lds_raw, vcu, G); } } SEAM(7);
    if (IN(8)) { run8(); if (DUPQ(8)) { __syncthreads(); run8(); } } SEAM(8);
    if (IN(9)) { phase_norm<true>(X1, X1, args.in[9], mod, 3 * 4096, 4 * 4096, HB, UP_I8 ? (unsigned char*)HB : nullptr, UP_I8 ? (float*)(ws + WS_ROWSC) : nullptr, lds, vcu, G); if (DUPQ(9)) phase_norm<true>(X1, X1, args.in[9], mod, 3 * 4096, 4 * 4096, HB, UP_I8 ? (unsigned char*)HB : nullptr, UP_I8 ? (float*)(ws + WS_ROWSC) : nullptr, lds, vcu, G);
        if (UP_TAIL && UP_I8 && FFN_SORT) { __syncthreads(); wup_convert_dyn(args, lds, ctl + 16576, UPT_B, UP_ITEMS); } } SEAM(9);
    if (IN(10)) { run10(); if (DUPQ(10)) { __syncthreads(); run10(); }
        if (DOWN_TAIL && FFN_SORT) { __syncthreads(); wdown_convert_dyn(args, lds, ctl + 16384); } } SEAM(10);
    if (IN(11)) { phase11(args, vcu, G); if (DUPQ(11)) phase11(args, vcu, G); } SEAM(11);
    if (IN(12)) { run12(); if (DUPQ(12)) { __syncthreads(); run12(); } }
#undef IN
#undef SEAM
}

extern "C" void kernel_launch(void* const* d_in, const int* in_sizes, int n_in, void* d_out, int out_size, void* d_ws, size_t ws_size, hipStream_t stream) {
    static int grid = 0;
    if (grid == 0) {
        if (n_in != 27 || in_sizes[0] != TP * DM || in_sizes[1] != TL * DM || (size_t)out_size != OUT_END || ws_size < WS_END) {
            fprintf(stderr, "kernel_launch: shape mismatch: n_in %d in0 %d in1 %d out %d ws %zu (need >= %zu); nothing launched\n", n_in, n_in > 0 ? in_sizes[0] : -1, n_in > 1 ? in_sizes[1] : -1, out_size, ws_size, (size_t)WS_END); grid = -1; return; }
        int dev = 0, cus = 0, per_cu = 0;
        if (hipGetDevice(&dev) != hipSuccess || hipDeviceGetAttribute(&cus, hipDeviceAttributeMultiprocessorCount, dev) != hipSuccess) { fprintf(stderr, "kernel_launch: device query failed\n"); grid = -1; return; }
        if (hipFuncSetAttribute((const void*)mk_fwd, hipFuncAttributeMaxDynamicSharedMemorySize, LDS_BYTES) != hipSuccess) { fprintf(stderr, "kernel_launch: hipFuncSetAttribute failed\n"); grid = -1; return; }
        if (hipOccupancyMaxActiveBlocksPerMultiprocessor(&per_cu, (const void*)mk_fwd, NTHREADS, LDS_BYTES) != hipSuccess || per_cu < 1) { fprintf(stderr, "kernel_launch: occupancy query says %d blocks per CU\n", per_cu); }
        (void)hipGetLastError();
        grid = cus;
    }
    if (grid < 0) return;
    if (hipMemsetAsync((char*)d_ws + WS_CTL, 0, CTL_ZERO_BYTES, stream) != hipSuccess) { fprintf(stderr, "kernel_launch: memset failed\n"); return; }
    Args a{};
    for (int i = 0; i < 27; ++i) a.in[i] = (const float*)d_in[i];
    a.out = (float*)d_out; a.ws = (unsigned char*)d_ws;
#if MK_ONE_LAUNCH
    a.ph_lo = 0; a.ph_hi = N_PHASES;
    hipLaunchKernelGGL(mk_fwd, dim3(grid), dim3(NTHREADS), LDS_BYTES, stream, a);
#else
    for (int p = 0; p < N_PHASES; ++p) { a.ph_lo = p; a.ph_hi = p + 1; hipLaunchKernelGGL(mk_fwd, dim3(grid), dim3(NTHREADS), LDS_BYTES, stream, a); }
#endif
    const hipError_t le = hipPeekAtLastError();
    if (le != hipSuccess) fprintf(stderr, "kernel_launch: launch failed: %s\n", hipGetErrorName(le));
}
```
